# Optimizing an MI355X kernel written in HIP

```python
import math
import jax, jax.numpy as jnp
from jax import lax
import numpy as np

D_MODEL = 1024
BATCH = 4
SEQ = 4096
DEPTH = 1

HEAD_DIM = 64
DIFF_HEADS = 8
DIFF_VDIM = 2 * HEAD_DIM
NSA_HEADS = 16
NSA_GROUPS = 4
NSA_HPG = NSA_HEADS // NSA_GROUPS
CMP_BLOCK = 32
CMP_STRIDE = 16
CMP_HIDDEN = 256
SEL_BLOCK = 64
SEL_TOP = 16
WINDOW = 512
FORCED_SCORE = 1e4
D_FF = 4 * D_MODEL
ROPE_THETA = 10000.0
EPS = 1e-6
Q_BLOCK = 128

DIFF_QK = DIFF_HEADS * 2 * HEAD_DIM
DIFF_V = DIFF_HEADS * DIFF_VDIM
NSA_Q = NSA_HEADS * HEAD_DIM
NSA_KV = NSA_GROUPS * HEAD_DIM
NSA_GATE = NSA_HEADS * 3
MERGE_GATE = 2 * D_MODEL
COLUMN_SPLITS = (DIFF_QK, DIFF_QK, DIFF_V, NSA_Q, NSA_KV, NSA_KV, NSA_KV, NSA_KV, NSA_KV, NSA_KV, NSA_GATE, MERGE_GATE)
D_IN = DIFF_QK * 2 + DIFF_V + NSA_Q + 6 * NSA_KV + NSA_GATE + MERGE_GATE

kernel_name = "hybrid_diffattn_nsa_gated_block"


def rmsnorm(x, g):
    xf = x.astype(jnp.float32)
    y = xf * lax.rsqrt(jnp.mean(xf * xf, axis=-1, keepdims=True) + EPS)
    return (y * g.astype(jnp.float32)).astype(x.dtype)


def rope(x, pos):
    half = x.shape[-1] // 2
    inv_freq = ROPE_THETA ** (-jnp.arange(half, dtype=jnp.float32) / half)
    ang = pos.astype(jnp.float32)[:, None] * inv_freq[None, :]
    bshape = (1, ang.shape[0]) + (1,) * (x.ndim - 3) + (half,)
    cos = jnp.cos(ang).reshape(bshape)
    sin = jnp.sin(ang).reshape(bshape)
    xf = x.astype(jnp.float32)
    x1, x2 = xf[..., :half], xf[..., half:]
    return jnp.concatenate([x1 * cos - x2 * sin, x2 * cos + x1 * sin], axis=-1).astype(x.dtype)


def masked_softmax(s, mask):
    s = jnp.where(mask, s.astype(jnp.float32), -jnp.inf)
    m = jnp.max(s, axis=-1, keepdims=True)
    m = jnp.where(jnp.isfinite(m), m, 0.0)
    e = jnp.where(mask, jnp.exp(s - m), 0.0)
    return e / jnp.maximum(jnp.sum(e, axis=-1, keepdims=True), 1e-30)


def diff_attention(q, k, v, lam, lambda_init, subln_g):
    B, S, H, _, Dh = q.shape
    scale = Dh ** -0.5
    kpos = jnp.arange(S)

    def block(i):
        q0 = i * Q_BLOCK
        qb = lax.dynamic_slice_in_dim(q, q0, Q_BLOCK, axis=1)
        s = jnp.einsum('bqhcd,bkhcd->bhcqk', qb, k).astype(jnp.float32) * scale
        qpos = q0 + jnp.arange(Q_BLOCK)
        causal = kpos[None, :] <= qpos[:, None]
        p = jax.nn.softmax(jnp.where(causal, s, -jnp.inf), axis=-1)
        a = p[:, :, 0] - lam * p[:, :, 1]
        return jnp.einsum('bhqk,bkhe->bqhe', a.astype(v.dtype), v)

    o = lax.map(block, jnp.arange(S // Q_BLOCK))
    o = o.transpose(1, 0, 2, 3, 4).reshape(B, S, H, -1)
    o = rmsnorm(o, subln_g) * (1.0 - lambda_init)
    return o.reshape(B, S, H * o.shape[-1])


def compress(kv, pos_emb, w1, w2):
    B, S, G, Dh = kv.shape
    n_cmp = (S - CMP_BLOCK) // CMP_STRIDE + 1
    idx = jnp.arange(n_cmp)[:, None] * CMP_STRIDE + jnp.arange(CMP_BLOCK)[None, :]
    blocks = kv[:, idx] + pos_emb[None, None, :, None, :]
    blocks = blocks.transpose(0, 1, 3, 2, 4).reshape(B, n_cmp, G, CMP_BLOCK * Dh)
    return jax.nn.gelu(blocks @ w1) @ w2


def nsa_attention(q, k_cmp, v_cmp, k_slc, v_slc, k_win, v_win, gates):
    B, S, Hq, Dh = q.shape
    G, Hg = NSA_GROUPS, NSA_HPG
    scale = Dh ** -0.5
    dt = v_slc.dtype
    n_cmp = k_cmp.shape[1]
    n_sel = S // SEL_BLOCK
    n_top = min(SEL_TOP, n_sel)
    cmp_start = jnp.arange(n_cmp) * CMP_STRIDE
    cmp_end = cmp_start + CMP_BLOCK - 1
    sel_start = jnp.arange(n_sel) * SEL_BLOCK
    sel_ids = jnp.arange(n_sel)
    overlap = ((cmp_start[:, None] < sel_start[None, :] + SEL_BLOCK)
               & (cmp_end[:, None] >= sel_start[None, :])).astype(jnp.float32)
    k_blk = k_slc.reshape(B, n_sel, SEL_BLOCK, G, Dh).transpose(0, 3, 1, 2, 4)
    v_blk = v_slc.reshape(B, n_sel, SEL_BLOCK, G, Dh).transpose(0, 3, 1, 2, 4)
    kw_pad = jnp.pad(k_win, ((0, 0), (WINDOW, 0), (0, 0), (0, 0)))
    vw_pad = jnp.pad(v_win, ((0, 0), (WINDOW, 0), (0, 0), (0, 0)))
    b_idx = jnp.arange(B)[:, None, None, None]
    g_idx = jnp.arange(G)[None, :, None, None]

    def block(i):
        q0 = i * Q_BLOCK
        qpos = q0 + jnp.arange(Q_BLOCK)
        qb = lax.dynamic_slice_in_dim(q, q0, Q_BLOCK, axis=1).reshape(B, Q_BLOCK, G, Hg, Dh)
        gb = lax.dynamic_slice_in_dim(gates, q0, Q_BLOCK, axis=1)
        s = jnp.einsum('bqghd,bngd->bghqn', qb, k_cmp) * scale
        p_cmp = masked_softmax(s, cmp_end[None, :] <= qpos[:, None])
        o_cmp = jnp.einsum('bghqn,bngd->bqghd', p_cmp.astype(dt), v_cmp)
        imp = jnp.einsum('bghqn,nj->bgqj', p_cmp, overlap)
        cur = qpos // SEL_BLOCK
        forced = (sel_ids[None, :] == 0) | (sel_ids[None, :] == cur[:, None]) | (sel_ids[None, :] == cur[:, None] - 1)
        imp = jnp.where(forced, FORCED_SCORE, imp)
        imp = jnp.where(sel_start[None, :] <= qpos[:, None], imp, -jnp.inf)
        top_val, top_idx = lax.top_k(imp, n_top)
        sel_ok = jnp.isfinite(top_val)
        ks = k_blk[b_idx, g_idx, top_idx]
        vs = v_blk[b_idx, g_idx, top_idx]
        s = jnp.einsum('bqghd,bgqnld->bghqnl', qb, ks) * scale
        tok_pos = top_idx[..., None] * SEL_BLOCK + jnp.arange(SEL_BLOCK)
        m = sel_ok[..., None] & (tok_pos <= qpos[None, None, :, None, None])
        p = masked_softmax(s.reshape(B, G, Hg, Q_BLOCK, n_top * SEL_BLOCK),
                           m.reshape(B, G, 1, Q_BLOCK, n_top * SEL_BLOCK))
        p = p.reshape(B, G, Hg, Q_BLOCK, n_top, SEL_BLOCK)
        o_slc = jnp.einsum('bghqnl,bgqnld->bqghd', p.astype(dt), vs)
        kw = lax.dynamic_slice_in_dim(kw_pad, q0, WINDOW + Q_BLOCK, axis=1)
        vw = lax.dynamic_slice_in_dim(vw_pad, q0, WINDOW + Q_BLOCK, axis=1)
        kwpos = q0 - WINDOW + jnp.arange(WINDOW + Q_BLOCK)
        dist = qpos[:, None] - kwpos[None, :]
        s = jnp.einsum('bqghd,bkgd->bghqk', qb, kw) * scale
        p = masked_softmax(s, (dist >= 0) & (dist < WINDOW) & (kwpos[None, :] >= 0))
        o_win = jnp.einsum('bghqk,bkgd->bqghd', p.astype(dt), vw)
        shp = (B, Q_BLOCK, Hq, Dh)
        return (gb[..., 0:1] * o_cmp.reshape(shp) + gb[..., 1:2] * o_slc.reshape(shp)
                + gb[..., 2:3] * o_win.reshape(shp))

    o = lax.map(block, jnp.arange(S // Q_BLOCK))
    return o.transpose(1, 0, 2, 3, 4).reshape(B, S, Hq * Dh)


def setup_inputs(seed: int = 0) -> dict:
    key = jax.random.key(seed)
    k = jax.random.split(key, 26)
    f32 = jnp.float32
    nrm = lambda kk, shape, sc: jax.random.normal(kk, shape, f32) * sc
    gain = lambda kk, shape: 1.0 + 0.02 * jax.random.normal(kk, shape, f32)
    L = DEPTH
    return {
        "x": jax.random.normal(k[0], (BATCH, SEQ, D_MODEL), f32),
        "ln_mix_g": gain(k[1], (L, D_MODEL)),
        "w_in": nrm(k[2], (L, D_MODEL, D_IN), D_MODEL ** -0.5),
        "diff_q_norm_g": gain(k[3], (L, HEAD_DIM)),
        "diff_k_norm_g": gain(k[4], (L, HEAD_DIM)),
        "diff_lambda_q1": nrm(k[5], (L, HEAD_DIM), 0.1),
        "diff_lambda_k1": nrm(k[6], (L, HEAD_DIM), 0.1),
        "diff_lambda_q2": nrm(k[7], (L, HEAD_DIM), 0.1),
        "diff_lambda_k2": nrm(k[8], (L, HEAD_DIM), 0.1),
        "diff_subln_g": gain(k[9], (L, DIFF_VDIM)),
        "nsa_q_norm_g": gain(k[10], (L, HEAD_DIM)),
        "nsa_k_norm_g": gain(k[11], (L, 3, HEAD_DIM)),
        "cmp_pos_k": nrm(k[12], (L, CMP_BLOCK, HEAD_DIM), 0.1),
        "cmp_pos_v": nrm(k[13], (L, CMP_BLOCK, HEAD_DIM), 0.1),
        "cmp_k_w1": nrm(k[14], (L, CMP_BLOCK * HEAD_DIM, CMP_HIDDEN), (CMP_BLOCK * HEAD_DIM) ** -0.5),
        "cmp_k_w2": nrm(k[15], (L, CMP_HIDDEN, HEAD_DIM), CMP_HIDDEN ** -0.5),
        "cmp_v_w1": nrm(k[16], (L, CMP_BLOCK * HEAD_DIM, CMP_HIDDEN), (CMP_BLOCK * HEAD_DIM) ** -0.5),
        "cmp_v_w2": nrm(k[17], (L, CMP_HIDDEN, HEAD_DIM), CMP_HIDDEN ** -0.5),
        "w_proj_diff": nrm(k[18], (L, DIFF_V, D_MODEL), DIFF_V ** -0.5),
        "w_proj_nsa": nrm(k[19], (L, NSA_Q, D_MODEL), NSA_Q ** -0.5),
        "w_out": nrm(k[20], (L, D_MODEL, D_MODEL), D_MODEL ** -0.5),
        "ln_mlp_g": gain(k[21], (L, D_MODEL)),
        "w_mlp_up": nrm(k[22], (L, D_MODEL, D_FF), D_MODEL ** -0.5),
        "w_mlp_down": nrm(k[23], (L, D_FF, D_MODEL), D_FF ** -0.5),
    }


def reference(x, ln_mix_g, w_in, diff_q_norm_g, diff_k_norm_g, diff_lambda_q1, diff_lambda_k1,
              diff_lambda_q2, diff_lambda_k2, diff_subln_g, nsa_q_norm_g, nsa_k_norm_g,
              cmp_pos_k, cmp_pos_v, cmp_k_w1, cmp_k_w2, cmp_v_w1, cmp_v_w2,
              w_proj_diff, w_proj_nsa, w_out, ln_mlp_g, w_mlp_up, w_mlp_down):
    B, S, D = x.shape
    G = NSA_GROUPS
    pos = jnp.arange(S)
    n_cmp = (S - CMP_BLOCK) // CMP_STRIDE + 1
    cmp_center = jnp.arange(n_cmp) * CMP_STRIDE + (CMP_BLOCK - 1) / 2.0
    split_at = [int(c) for c in np.cumsum(COLUMN_SPLITS)[:-1]]
    for l in range(DEPTH):
        h = rmsnorm(x, ln_mix_g[l])
        proj = h @ w_in[l]
        (dq, dk, dv, nq, kc, vc, ksl, vsl, kwn, vwn, ng, mg) = jnp.split(proj, split_at, axis=-1)
        dq = rope(rmsnorm(dq.reshape(B, S, DIFF_HEADS, 2, HEAD_DIM), diff_q_norm_g[l]), pos)
        dk = rope(rmsnorm(dk.reshape(B, S, DIFF_HEADS, 2, HEAD_DIM), diff_k_norm_g[l]), pos)
        dv = dv.reshape(B, S, DIFF_HEADS, DIFF_VDIM)
        lambda_init = 0.8 - 0.6 * math.exp(-0.3 * l)
        lam = (jnp.exp(jnp.sum(diff_lambda_q1[l].astype(jnp.float32) * diff_lambda_k1[l].astype(jnp.float32)))
               - jnp.exp(jnp.sum(diff_lambda_q2[l].astype(jnp.float32) * diff_lambda_k2[l].astype(jnp.float32)))
               + lambda_init)
        y_diff = diff_attention(dq, dk, dv, lam, lambda_init, diff_subln_g[l])
        nq = rope(rmsnorm(nq.reshape(B, S, NSA_HEADS, HEAD_DIM), nsa_q_norm_g[l]), pos)
        k_cmp = compress(kc.reshape(B, S, G, HEAD_DIM), cmp_pos_k[l], cmp_k_w1[l], cmp_k_w2[l])
        k_cmp = rope(rmsnorm(k_cmp, nsa_k_norm_g[l, 0]), cmp_center)
        v_cmp = compress(vc.reshape(B, S, G, HEAD_DIM), cmp_pos_v[l], cmp_v_w1[l], cmp_v_w2[l])
        k_slc = rope(rmsnorm(ksl.reshape(B, S, G, HEAD_DIM), nsa_k_norm_g[l, 1]), pos)
        k_win = rope(rmsnorm(kwn.reshape(B, S, G, HEAD_DIM), nsa_k_norm_g[l, 2]), pos)
        nsa_gates = jax.nn.sigmoid(ng).reshape(B, S, NSA_HEADS, 3)
        y_nsa = nsa_attention(nq, k_cmp, v_cmp, k_slc, vsl.reshape(B, S, G, HEAD_DIM), k_win,
                              vwn.reshape(B, S, G, HEAD_DIM), nsa_gates)
        merge = jax.nn.sigmoid(mg).reshape(B, S, 2, D)
        mixed = merge[:, :, 0] * (y_diff @ w_proj_diff[l]) + merge[:, :, 1] * (y_nsa @ w_proj_nsa[l])
        x = x + mixed @ w_out[l]
        h = rmsnorm(x, ln_mlp_g[l])
        x = x + jnp.square(jax.nn.relu(h @ w_mlp_up[l])) @ w_mlp_down[l]
    return x
```

```cpp
#include <hip/hip_runtime.h>
#include <hip/hip_cooperative_groups.h>
#include <cstdio>
#include <cstdint>
#include <cmath>
namespace cg = cooperative_groups;

namespace pg8 {
#define PG8_LAS __attribute__((address_space(3)))
typedef unsigned short bf16_t;
typedef short bf16x8 __attribute__((ext_vector_type(8)));
typedef float f32x4 __attribute__((ext_vector_type(4)));
typedef unsigned u32x4 __attribute__((ext_vector_type(4)));
constexpr int BM = 256, BK = 64, HALF = 128, HTB = HALF * BK * 2  , STAGE_BYTES = 8 * HTB, NXCD = 8, WGM = 8;

__host__ __device__ __forceinline__ int lds_byte(int r, int c) { const int st = (r >> 4) * 2 + (c >> 5), rr = r & 15, cc = c & 31, ob = rr * 64 + cc * 2; return st * 1024 + (ob ^ (((ob >> 9) & 1) << 5)); }
__host__ __device__ __forceinline__ void stage_rc(int b, int& R, int& C) { const int st = b / 1024, sb = b % 1024, swz = sb ^ (((sb >> 9) & 1) << 5); R = (st >> 1) * 16 + swz / 64; C = (st & 1) * 32 + (swz % 64) / 2; }
__host__ __device__ __forceinline__ int perm32(int rho) { const int n = rho >> 4, i = rho & 15; return 8 * (i >> 2) + 4 * n + (i & 3); }

struct Unit { int pm, pn; };
struct Gemm { const bf16_t* A; const bf16_t* Bt; int M, N, K; int lda; int kstepA; int a_sh; size_t a_lo, a_hi; };
__host__ __device__ __forceinline__ Gemm make_gemm(const bf16_t* A, const bf16_t* Bt, int M, int N, int K) { Gemm g; g.A = A; g.Bt = Bt; g.M = M; g.N = N; g.K = K; g.lda = K; g.kstepA = BK * 2; g.a_sh = 24; g.a_lo = (size_t)BM * K * 2; g.a_hi = 0; return g; }
__device__ __forceinline__ const char* a_tile(const Gemm& g, int pm) { return (const char*)g.A + (size_t)(pm >> g.a_sh) * g.a_hi + (size_t)(pm & ((1 << g.a_sh) - 1)) * g.a_lo; }

struct StaticOrder {
    int nM, nN, nwg, G, c;
    __host__ __device__ void init(int M, int N, int G_, int c_) { nM = M / BM; nN = N / BM; nwg = nM * nN; G = G_; c = c_; }
    __host__ __device__ bool next(int i, Unit& u) const {
        const long L = (long)i * G + c; if (L >= nwg) return false;
        int wgid = (int)L; { const int q = nwg / NXCD, r = nwg % NXCD, xcd = wgid % NXCD, off = wgid / NXCD; wgid = (xcd < r ? xcd * (q + 1) : r * (q + 1) + (xcd - r) * q) + off; }
        const int nig = WGM * nN, gid = wgid / nig, fm = gid * WGM, gsz = (nM - fm) < WGM ? (nM - fm) : WGM;
        u.pm = fm + ((wgid % nig) % gsz); u.pn = (wgid % nig) / gsz; return true;
    }
    __device__ __forceinline__ void a_ready(const Unit&) const {}
    __device__ __forceinline__ void done(const Unit&) const {}
};


template <class Epi, class Sched, bool ALIGN_EPI = false, bool SP2 = false>
__device__ __forceinline__ void gemm_phase(PG8_LAS unsigned char* lds, const Gemm g, const Sched& S, const Epi& E) {
    const int tid = threadIdx.x, wid = __builtin_amdgcn_readfirstlane(tid >> 6), lane = tid & 63, wr = wid >> 2, wc = wid & 3, fr = lane & 15, fq = lane >> 4;
    const int K = g.K, nt = K / BK;
    unsigned voffA[2], voffB[2];
#pragma unroll
    for (int i = 0; i < 2; ++i) { int R, C; stage_rc(tid * 16 + i * 8192, R, C); const int Rb = Epi::PERM ? ((R & ~31) + perm32(R & 31)) : R;
        voffA[i] = (unsigned)(R * g.lda + C) * 2u; voffB[i] = (unsigned)(Rb * K + C) * 2u; }
    const size_t kstep = (size_t)(BK * 2); const size_t kstepA = (size_t)g.kstepA; const size_t hstepA = (size_t)HALF * g.lda * 2;
    const size_t hstep = (size_t)HALF * K * 2;
    const size_t tstep = 2 * hstep;
    const unsigned ldsw = (unsigned)wid * 1024u;
    const int aoff = lds_byte(wr * 64 + fr, fq * 8), boff = lds_byte(wc * 32 + fr, fq * 8);
#define PG8_SA(b, h) (((b) * 2 + (h)) * HTB)
#define PG8_SB(b, h) ((4 + (b) * 2 + (h)) * HTB)
#define PG8_STAGE(bufoff, gbase, voff) do { _Pragma("unroll") for (int _i = 0; _i < 2; ++_i) \
        __builtin_amdgcn_global_load_lds((const unsigned*)((const char*)(gbase) + (voff)[_i]), (PG8_LAS unsigned*)(lds + (bufoff) + ldsw + _i * 8192), 16, 0, 0); } while (0)
#define PG8_LDA(dst, b, h) do { _Pragma("unroll") for (int m = 0; m < 4; ++m) _Pragma("unroll") for (int k = 0; k < 2; ++k) dst[m][k] = *(const PG8_LAS bf16x8*)(lds + PG8_SA(b, h) + aoff + m * 2048 + k * 1024); } while (0)
#define PG8_LDB(dst, b, h) do { _Pragma("unroll") for (int n = 0; n < 2; ++n) _Pragma("unroll") for (int k = 0; k < 2; ++k) dst[n][k] = *(const PG8_LAS bf16x8*)(lds + PG8_SB(b, h) + boff + n * 2048 + k * 1024); } while (0)
#define PG8_MMA(ai, bj, At, Bt) do { __builtin_amdgcn_s_setprio(1); _Pragma("unroll") for (int m = 0; m < 4; ++m) _Pragma("unroll") for (int n = 0; n < 2; ++n) _Pragma("unroll") for (int k = 0; k < 2; ++k) \
        acc[ai][bj][m][n] = __builtin_amdgcn_mfma_f32_16x16x32_bf16(Bt[n][k], At[m][k], acc[ai][bj][m][n], 0, 0, 0); __builtin_amdgcn_s_setprio(0); } while (0)
#define PG8_WAIT_V(n) asm volatile("s_waitcnt vmcnt(" #n ")" ::: "memory")
#define PG8_WAIT_L(n) asm volatile("s_waitcnt lgkmcnt(" #n ")" ::: "memory")
#define PG8_BAR __builtin_amdgcn_s_barrier()
#define PG8_SCHED __builtin_amdgcn_sched_barrier(0)
    Unit cur, nxt; int ui = 0;
    if (!S.next(0, cur)) return;
    f32x4 acc[2][2][4][2];
#pragma unroll
    for (int a = 0; a < 2; ++a)
#pragma unroll
        for (int b = 0; b < 2; ++b)
#pragma unroll
            for (int m = 0; m < 4; ++m)
#pragma unroll
                for (int n = 0; n < 2; ++n) acc[a][b][m][n] = (f32x4){0.f, 0.f, 0.f, 0.f};
    bf16x8 At[4][2], B0[2][2], B1[2][2];
    const char* cA = a_tile(g, cur.pm); const char* cB = (const char*)g.Bt + (size_t)cur.pn * tstep;
    S.a_ready(cur);
    if constexpr (SP2) {
        PG8_STAGE(PG8_SB(0, 0), cB, voffB); PG8_STAGE(PG8_SB(0, 1), cB + hstep, voffB); PG8_STAGE(PG8_SA(0, 0), cA, voffA); PG8_STAGE(PG8_SA(0, 1), cA + hstepA, voffA);
        if (wr == 1) PG8_BAR;
        PG8_WAIT_V(2); PG8_BAR;
        PG8_STAGE(PG8_SB(1, 0), cB + kstep, voffB); PG8_STAGE(PG8_SA(1, 0), cA + kstepA, voffA); PG8_STAGE(PG8_SB(1, 1), cB + hstep + kstep, voffB);
        PG8_WAIT_V(6); PG8_BAR;
    } else {
        PG8_STAGE(PG8_SB(0, 0), cB, voffB); PG8_STAGE(PG8_SA(0, 0), cA, voffA); PG8_STAGE(PG8_SB(0, 1), cB + hstep, voffB); PG8_STAGE(PG8_SA(0, 1), cA + hstepA, voffA);
        if (wr == 1) PG8_BAR;
        PG8_WAIT_V(4); PG8_BAR;
        PG8_STAGE(PG8_SB(1, 0), cB + kstep, voffB); PG8_STAGE(PG8_SA(1, 0), cA + kstepA, voffA); PG8_STAGE(PG8_SB(1, 1), cB + hstep + kstep, voffB);
        PG8_WAIT_V(6); PG8_BAR;
    }
    for (;;) {
        const bool has_next = S.next(ui + 1, nxt);
        const char* nA = has_next ? a_tile(g, nxt.pm) : cA; const char* nB = has_next ? (const char*)g.Bt + (size_t)nxt.pn * tstep : cB;
        for (int t = 0; t < nt; t += 2) {
            const bool last = (t == nt - 2);
            const char* a1 = cA + (size_t)(t + 1) * kstepA;
            const char* a2 = last ? nA : cA + (size_t)(t + 2) * kstepA; const char* b2 = last ? nB : cB + (size_t)(t + 2) * kstep;
            const char* a3 = a2 + kstepA; const char* b3 = b2 + kstep;
            if (last && has_next) S.a_ready(nxt);
            if constexpr (SP2) {
            PG8_LDB(B0, 0, 0); PG8_LDB(B1, 0, 1); PG8_SCHED; PG8_LDA(At, 0, 0); PG8_STAGE(PG8_SA(1, 1), a1 + hstepA, voffA);
            PG8_WAIT_V(8); PG8_WAIT_L(0); PG8_BAR; PG8_MMA(0, 0, At, B0); PG8_MMA(0, 1, At, B1); PG8_BAR; PG8_SCHED;
            PG8_LDA(At, 0, 1); PG8_STAGE(PG8_SB(0, 0), b2, voffB); PG8_STAGE(PG8_SB(0, 1), b2 + hstep, voffB); PG8_STAGE(PG8_SA(0, 0), a2, voffA);
            PG8_WAIT_V(8); PG8_WAIT_L(0); PG8_BAR; PG8_MMA(1, 0, At, B0); PG8_MMA(1, 1, At, B1); PG8_BAR; PG8_SCHED;
            PG8_LDB(B0, 1, 0); PG8_LDB(B1, 1, 1); PG8_SCHED; PG8_LDA(At, 1, 0); PG8_STAGE(PG8_SA(0, 1), a2 + hstepA, voffA);
            PG8_WAIT_V(8); PG8_WAIT_L(0); PG8_BAR; PG8_MMA(0, 0, At, B0); PG8_MMA(0, 1, At, B1); PG8_BAR; PG8_SCHED;
            PG8_LDA(At, 1, 1); PG8_STAGE(PG8_SB(1, 0), b3, voffB); PG8_STAGE(PG8_SB(1, 1), b3 + hstep, voffB); PG8_STAGE(PG8_SA(1, 0), a3, voffA);
            PG8_WAIT_V(8); PG8_WAIT_L(0); PG8_BAR; PG8_MMA(1, 0, At, B0); PG8_MMA(1, 1, At, B1); PG8_BAR; PG8_SCHED;
            } else {
            PG8_LDB(B0, 0, 0); PG8_SCHED; PG8_LDA(At, 0, 0); PG8_STAGE(PG8_SA(1, 1), a1 + hstepA, voffA);
            PG8_WAIT_L(8); PG8_BAR; PG8_WAIT_L(0); PG8_MMA(0, 0, At, B0); PG8_BAR; PG8_SCHED;
            PG8_LDB(B1, 0, 1); PG8_STAGE(PG8_SB(0, 0), b2, voffB);
            PG8_BAR; PG8_WAIT_L(0); PG8_MMA(0, 1, At, B1); PG8_BAR;
            PG8_LDA(At, 0, 1); PG8_STAGE(PG8_SA(0, 0), a2, voffA);
            PG8_BAR; PG8_WAIT_L(0); PG8_MMA(1, 0, At, B0); PG8_BAR; PG8_SCHED;
            PG8_STAGE(PG8_SB(0, 1), b2 + hstep, voffB);
            PG8_WAIT_V(6); PG8_BAR; PG8_MMA(1, 1, At, B1); PG8_BAR;
            PG8_LDB(B0, 1, 0); PG8_SCHED; PG8_LDA(At, 1, 0); PG8_STAGE(PG8_SA(0, 1), a2 + hstepA, voffA);
            PG8_WAIT_L(8); PG8_BAR; PG8_WAIT_L(0); PG8_MMA(0, 0, At, B0); PG8_BAR; PG8_SCHED;
            PG8_LDB(B1, 1, 1); PG8_STAGE(PG8_SB(1, 0), b3, voffB);
            PG8_BAR; PG8_WAIT_L(0); PG8_MMA(0, 1, At, B1); PG8_BAR;
            PG8_LDA(At, 1, 1); PG8_STAGE(PG8_SA(1, 0), a3, voffA);
            PG8_BAR; PG8_WAIT_L(0); PG8_MMA(1, 0, At, B0); PG8_BAR; PG8_SCHED;
            PG8_STAGE(PG8_SB(1, 1), b3 + hstep, voffB);
            PG8_WAIT_V(6); PG8_BAR; PG8_MMA(1, 1, At, B1); PG8_BAR;
            }
        }
        if constexpr (ALIGN_EPI) { if (wr == 0) PG8_BAR; }
        if constexpr (!Epi::AFTER_DRAIN) { E(acc, cur, wr, wc, fr, fq); S.done(cur); }
        if (!has_next) break;
#pragma unroll
        for (int a = 0; a < 2; ++a)
#pragma unroll
            for (int b = 0; b < 2; ++b)
#pragma unroll
                for (int m = 0; m < 4; ++m)
#pragma unroll
                    for (int n = 0; n < 2; ++n) acc[a][b][m][n] = (f32x4){0.f, 0.f, 0.f, 0.f};
        cur = nxt; cA = nA; cB = nB; ++ui;
        if constexpr (ALIGN_EPI) { if (wr == 1) PG8_BAR; }
    }
    PG8_WAIT_V(0);
    if constexpr (!ALIGN_EPI) { if (wr == 0) PG8_BAR; }
    PG8_BAR;
    if constexpr (Epi::AFTER_DRAIN) { E.fused(acc, cur, wr, wc, fr, fq, lds, wid, lane); S.done(cur); }
#undef PG8_SA
#undef PG8_SB
#undef PG8_STAGE
#undef PG8_LDA
#undef PG8_LDB
#undef PG8_MMA
#undef PG8_WAIT_V
#undef PG8_WAIT_L
#undef PG8_BAR
#undef PG8_SCHED
}
}

#define LAS __attribute__((address_space(3)))
typedef unsigned short bf16_t;
typedef short bf16x8 __attribute__((ext_vector_type(8)));
typedef float f32x4 __attribute__((ext_vector_type(4)));
typedef float f32x16 __attribute__((ext_vector_type(16)));
typedef unsigned u32x4 __attribute__((ext_vector_type(4)));
typedef unsigned u32x2 __attribute__((ext_vector_type(2)));
typedef float f32x2_t __attribute__((ext_vector_type(2)));
typedef __bf16 bf16x2_t __attribute__((ext_vector_type(2)));

constexpr int NB = 4, SEQ = 4096, DM = 1024, MTOK = NB * SEQ, DIN = 7728, NPAD = 7936, DFF = 4096;
constexpr float QSCALE = 0.125f * 1.4426950408889634f;
constexpr float EPS = 1e-6f;
constexpr int NTHREADS = 512, NWAVES = 8;

constexpr size_t MiB = 1u << 20;
constexpr size_t WS_CTL = 0, CTL_BYTES = 4096;
constexpr size_t WS_COS = 1 * MiB, WS_SIN = WS_COS + 4096 * 32 * 4, WS_CCOS = WS_SIN + 4096 * 32 * 4, WS_CSIN = WS_CCOS + 256 * 32 * 4;
constexpr size_t WS_PB = 3 * MiB;
constexpr size_t WS_W2T = 3 * MiB + 65536;
constexpr size_t WS_W1T = 4 * MiB;
constexpr size_t WS_WPD = 6 * MiB, WS_WPN = 8 * MiB, WS_WOUT = 10 * MiB, WS_WUP = 12 * MiB, WS_WDN = 20 * MiB, WS_WIN = 28 * MiB;
constexpr size_t WS_XN = 45 * MiB;
constexpr size_t WS_HID = WS_XN, WS_KCMP = WS_XN + 4 * MiB, WS_VCMPT = WS_XN + 5 * MiB, WS_MIXED = WS_XN;
constexpr size_t WS_DQ = 77 * MiB, WS_DK = 109 * MiB, WS_DVT = 141 * MiB, WS_NQ = 173 * MiB;
constexpr size_t WS_KC = 205 * MiB, WS_VC = 213 * MiB, WS_KSL = 221 * MiB, WS_KWN = 229 * MiB, WS_VSLT = 237 * MiB, WS_VWNT = 245 * MiB, WS_NG = 253 * MiB;
constexpr size_t WS_T1 = WS_DK;
constexpr size_t WS_XB1 = WS_KC;
constexpr size_t WS_PART = WS_NG;
constexpr size_t WS_HB = WS_DQ;
constexpr size_t WS_END = 256 * MiB;

constexpr int LDS_BYTES = 147456;
constexpr int TROW = 72;
constexpr int ABUF = 64 * TROW * 2 + 128 * TROW * 2;
constexpr int L_CK = 57344, CKROW = 72;
constexpr int L_CV = L_CK + 256 * CKROW * 2, CVROW = 264;
constexpr int L_IMP = L_CV + 64 * CVROW * 2;
constexpr int L_SEL = L_IMP + 16384;
constexpr int L_SLOT = L_SEL + 512;
static_assert(L_SLOT + 64 <= LDS_BYTES, "lds map");

struct Params { const float* in[24]; float* out; unsigned char* ws; double invfreq[32]; int ph_lo, ph_hi; };

__device__ __forceinline__ unsigned cvtpk(float lo, float hi) { f32x2_t v = {lo, hi}; bf16x2_t b = __builtin_convertvector(v, bf16x2_t); return __builtin_bit_cast(unsigned, b); }
__device__ __forceinline__ bf16_t f2bf(float f) { return (bf16_t)(cvtpk(f, 0.f) & 0xffffu); }
__device__ __forceinline__ int crow(int r, int hi) { return (r & 3) + 8 * (r >> 2) + 4 * hi; }
__device__ __forceinline__ int perm16(int t) { return (t & ~12) | ((t & 4) << 1) | ((t & 8) >> 1); }
__device__ __forceinline__ float wave_sum(float v) {
#pragma unroll
    for (int o = 1; o < 64; o <<= 1) v += __shfl_xor(v, o);
    return v;
}
__device__ __forceinline__ float sigmoidf_(float v) { return 1.0f / (1.0f + __expf(-v)); }
__device__ __forceinline__ float gelu_tanh(float x) { const float u = 0.7978845608028654f * (x + 0.044715f * x * x * x); return x / (1.0f + __expf(-2.0f * u)); }

__device__ __forceinline__ void tr_item(const float* W, int ldw, int col0, int nvalid, const float* kscale, bf16_t* WT, int ldt, int row0, int k0, LAS float* scr, int lane) {
    const int cl = lane & 31;
#pragma unroll 8
    for (int i = 0; i < 32; ++i) { const int kk = 2 * i + (lane >> 5); float v = 0.f; if (cl < nvalid) { v = W[(size_t)(k0 + kk) * ldw + col0 + cl]; if (kscale) v *= kscale[k0 + kk]; } scr[kk * 33 + cl] = v; }
    asm volatile("s_waitcnt lgkmcnt(0)" ::: "memory");
    const int c = lane & 7;
#pragma unroll
    for (int j = 0; j < 4; ++j) { const int n = (lane >> 3) + 8 * j; const LAS float* s = scr + (8 * c) * 33 + n;
        u32x4 o; o.x = cvtpk(s[0 * 33], s[1 * 33]); o.y = cvtpk(s[2 * 33], s[3 * 33]); o.z = cvtpk(s[4 * 33], s[5 * 33]); o.w = cvtpk(s[6 * 33], s[7 * 33]);
        *(u32x4*)(WT + (size_t)(row0 + n) * ldt + k0 + 8 * c) = o; }
    asm volatile("s_waitcnt lgkmcnt(0)" ::: "memory");
}
__device__ __forceinline__ void tr_plain(const float* W, int K, int N, const float* kscale, bf16_t* WT, LAS float* scr, int item, int lane) {
    const int nblk = N / 32, kb = item / nblk, nb = item % nblk;
    tr_item(W, N, 32 * nb, 32, kscale, WT, K, 32 * nb, 64 * kb, scr, lane);
}
__device__ __forceinline__ void sincos_d(double ang, float& s, float& c) {
    const double k = rint(ang * 0.15915494309189535);
    double r = fma(-k, 6.283185307179586, ang); r = fma(-k, 2.4492935982947064e-16, r);
    const double r2 = r * r; double ts = r, tc = 1.0, ss = r, cs = 1.0;
#pragma unroll
    for (int n = 1; n <= 14; ++n) { tc *= -r2 * (1.0 / ((2.0 * n - 1.0) * (2.0 * n))); cs += tc; ts *= -r2 * (1.0 / ((2.0 * n) * (2.0 * n + 1.0))); ss += ts; }
    s = (float)ss; c = (float)cs;
}

__device__ __forceinline__ void p0_prologue(const Params& P, LAS unsigned char* lds, int vb, int G) {
    const int tid = threadIdx.x, lane = tid & 63, wave = tid >> 6;
    LAS float* scr = (LAS float*)(lds + wave * 16384);
    const int gw = vb * NWAVES + wave, NGW = G * NWAVES;
    unsigned char* ws = P.ws;
    for (int it = gw; it < 16 * 248; it += NGW) {
        const int kb = it / 248, nb = it % 248, n0 = 32 * nb, pn = n0 >> 8, p = n0 & 255, bj = p >> 7, wc = (p >> 5) & 3, L0 = 64 * wc + 32 * bj;
        const int srcbase = pn < 22 ? 256 * pn : (pn < 30 ? 5680 + 256 * (pn - 22) : 5632), tv = pn < 30 ? 256 : 48;
        int nv = tv - L0; nv = nv < 0 ? 0 : (nv > 32 ? 32 : nv);
        tr_item(P.in[2], DIN, srcbase + L0, nv, nullptr, (bf16_t*)(ws + WS_WIN), 1024, n0, 64 * kb, scr, lane);
    }
    for (int it = gw; it < 16 * 32; it += NGW) tr_plain(P.in[18], 1024, 1024, nullptr, (bf16_t*)(ws + WS_WPD), scr, it, lane);
    for (int it = gw; it < 16 * 32; it += NGW) tr_plain(P.in[19], 1024, 1024, nullptr, (bf16_t*)(ws + WS_WPN), scr, it, lane);
    for (int it = gw; it < 16 * 32; it += NGW) tr_plain(P.in[20], 1024, 1024, nullptr, (bf16_t*)(ws + WS_WOUT), scr, it, lane);
    for (int it = gw; it < 16 * 128; it += NGW) tr_plain(P.in[22], 1024, 4096, P.in[21], (bf16_t*)(ws + WS_WUP), scr, it, lane);
    for (int it = gw; it < 64 * 32; it += NGW) tr_plain(P.in[23], 4096, 1024, nullptr, (bf16_t*)(ws + WS_WDN), scr, it, lane);
    for (int it = gw; it < 32 * 8; it += NGW) tr_plain(P.in[14], 2048, 256, nullptr, (bf16_t*)(ws + WS_W1T), scr, it, lane);
    for (int it = gw; it < 32 * 8; it += NGW) tr_plain(P.in[16], 2048, 256, nullptr, (bf16_t*)(ws + WS_W1T) + 256 * 2048, scr, it, lane);
    for (int it = gw; it < 4 * 2; it += NGW) tr_plain(P.in[15], 256, 64, nullptr, (bf16_t*)(ws + WS_W2T), scr, it, lane);
    for (int it = gw; it < 4 * 2; it += NGW) tr_plain(P.in[17], 256, 64, nullptr, (bf16_t*)(ws + WS_W2T) + 64 * 256, scr, it, lane);
    for (int it = NGW - 1 - gw; it < 8; it += NGW) {
        const int which = it >> 2, j = 64 * (it & 3) + lane; const float* pos = P.in[which ? 13 : 12]; const float* W1 = P.in[which ? 16 : 14];
        float a0 = 0.f, a1 = 0.f, a2 = 0.f, a3 = 0.f;
        for (int k = 0; k < 2048; k += 4) { a0 += pos[k] * W1[(size_t)k * 256 + j]; a1 += pos[k + 1] * W1[(size_t)(k + 1) * 256 + j]; a2 += pos[k + 2] * W1[(size_t)(k + 2) * 256 + j]; a3 += pos[k + 3] * W1[(size_t)(k + 3) * 256 + j]; }
        ((float*)(ws + WS_PB))[which * 256 + j] = (a0 + a1) + (a2 + a3);
    }
    for (int idx = vb * NTHREADS + tid; idx < (4096 + 256) * 32; idx += G * NTHREADS) {
        const int i = idx & 31, p = idx >> 5; float s, c;
        if (p < 4096) { sincos_d((double)p * P.invfreq[i], s, c); ((float*)(ws + WS_COS))[p * 32 + i] = c; ((float*)(ws + WS_SIN))[p * 32 + i] = s; }
        else { const int n = p - 4096; sincos_d(((double)n * 16.0 + 15.5) * P.invfreq[i], s, c); ((float*)(ws + WS_CCOS))[n * 32 + i] = c; ((float*)(ws + WS_CSIN))[n * 32 + i] = s; }
    }
    const float* x = P.in[0]; const float* g = P.in[1]; bf16_t* XN = (bf16_t*)(ws + WS_XN);
    f32x4 gv[4];
#pragma unroll
    for (int j = 0; j < 4; ++j) gv[j] = ((const f32x4*)g)[lane + 64 * j];
    for (int m = gw; m < MTOK; m += NGW) {
        const f32x4* xr = (const f32x4*)(x + (size_t)m * DM) + lane; f32x4 v[4]; float s = 0.f;
#pragma unroll
        for (int j = 0; j < 4; ++j) { v[j] = xr[64 * j]; s += (v[j].x * v[j].x + v[j].y * v[j].y) + (v[j].z * v[j].z + v[j].w * v[j].w); }
        const float rstd = rsqrtf(wave_sum(s) * (1.f / DM) + EPS);
        u32x2* o8 = (u32x2*)(XN + (size_t)m * DM) + lane;
#pragma unroll
        for (int j = 0; j < 4; ++j) { const f32x4 y = v[j] * rstd * gv[j]; u32x2 w; w.x = cvtpk(y.x, y.y); w.y = cvtpk(y.z, y.w); o8[64 * j] = w; }
    }
}

struct EpiProj {
    static constexpr bool PERM = true, AFTER_DRAIN = false;
    unsigned char* ws; const float *gq, *gk, *gnq, *gnk;
    __device__ __forceinline__ void operator()(const f32x4 (&acc)[2][2][4][2], const pg8::Unit& u, int wr, int wc, int fr, int fq) const {
        const int pn = u.pn; const int row0 = u.pm * 256 + wr * 64 + fr;
        int type, ld = 1024, cb = 0; bf16_t* dst = nullptr; const float* gain = nullptr; float qs = 1.f;
        if (pn < 4) { type = 0; dst = (bf16_t*)(ws + WS_DQ); cb = 256 * pn; gain = gq; qs = QSCALE; }
        else if (pn < 8) { type = 0; dst = (bf16_t*)(ws + WS_DK); cb = 256 * (pn - 4); gain = gk; }
        else if (pn < 12) { type = 2; dst = (bf16_t*)(ws + WS_DVT); }
        else if (pn < 16) { type = 0; dst = (bf16_t*)(ws + WS_NQ); cb = 256 * (pn - 12); gain = gnq; qs = QSCALE; }
        else if (pn == 16) { type = 1; dst = (bf16_t*)(ws + WS_KC); ld = 256; }
        else if (pn == 17) { type = 1; dst = (bf16_t*)(ws + WS_VC); ld = 256; }
        else if (pn == 18) { type = 0; dst = (bf16_t*)(ws + WS_KSL); ld = 256; gain = gnk + 64; }
        else if (pn == 19) { type = 2; dst = (bf16_t*)(ws + WS_VSLT); }
        else if (pn == 20) { type = 0; dst = (bf16_t*)(ws + WS_KWN); ld = 256; gain = gnk + 128; }
        else if (pn == 21) { type = 2; dst = (bf16_t*)(ws + WS_VWNT); }
        else if (pn < 30) { type = 3; dst = (bf16_t*)P_MG(); ld = 2048; cb = 256 * (pn - 22); }
        else { type = 4; }
        const int lc = 64 * wc + 8 * fq;
        if (type == 0) {
            const float* COS = (const float*)(ws + WS_COS); const float* SIN = (const float*)(ws + WS_SIN);
            f32x4 g1[2], g2[2];
#pragma unroll
            for (int n = 0; n < 2; ++n) { g1[n] = *(const f32x4*)(gain + 8 * fq + 4 * n); g2[n] = *(const f32x4*)(gain + 32 + 8 * fq + 4 * n); }
#pragma unroll
            for (int ai = 0; ai < 2; ++ai)
#pragma unroll
                for (int m = 0; m < 4; ++m) {
                    const int row = row0 + ai * 128 + m * 16, pos = row & (SEQ - 1);
                    float ss = 0.f;
#pragma unroll
                    for (int bj = 0; bj < 2; ++bj)
#pragma unroll
                        for (int n = 0; n < 2; ++n) { const f32x4 v = acc[ai][bj][m][n]; ss += (v.x * v.x + v.y * v.y) + (v.z * v.z + v.w * v.w); }
                    ss += __shfl_xor(ss, 16); ss += __shfl_xor(ss, 32);
                    const float rstd = rsqrtf(ss * (1.f / 64.f) + EPS);
                    f32x4 o1[2], o2[2];
#pragma unroll
                    for (int n = 0; n < 2; ++n) {
                        const f32x4 c4 = *(const f32x4*)(COS + pos * 32 + 8 * fq + 4 * n), s4 = *(const f32x4*)(SIN + pos * 32 + 8 * fq + 4 * n);
                        const f32x4 x1 = acc[ai][0][m][n] * rstd * g1[n], x2 = acc[ai][1][m][n] * rstd * g2[n];
                        o1[n] = (x1 * c4 - x2 * s4) * qs; o2[n] = (x2 * c4 + x1 * s4) * qs;
                    }
                    bf16_t* rp = dst + (size_t)row * ld + cb + lc;
                    u32x4 w; w.x = cvtpk(o1[0].x, o1[0].y); w.y = cvtpk(o1[0].z, o1[0].w); w.z = cvtpk(o1[1].x, o1[1].y); w.w = cvtpk(o1[1].z, o1[1].w); *(u32x4*)rp = w;
                    w.x = cvtpk(o2[0].x, o2[0].y); w.y = cvtpk(o2[0].z, o2[0].w); w.z = cvtpk(o2[1].x, o2[1].y); w.w = cvtpk(o2[1].z, o2[1].w); *(u32x4*)(rp + 32) = w;
                }
        } else if (type == 1 || type == 3) {
#pragma unroll
            for (int ai = 0; ai < 2; ++ai)
#pragma unroll
                for (int m = 0; m < 4; ++m) {
                    const int row = row0 + ai * 128 + m * 16; bf16_t* rp = dst + (size_t)row * ld + cb + lc;
#pragma unroll
                    for (int bj = 0; bj < 2; ++bj) {
                        f32x4 a = acc[ai][bj][m][0], b = acc[ai][bj][m][1];
                        if (type == 3) { a.x = sigmoidf_(a.x); a.y = sigmoidf_(a.y); a.z = sigmoidf_(a.z); a.w = sigmoidf_(a.w); b.x = sigmoidf_(b.x); b.y = sigmoidf_(b.y); b.z = sigmoidf_(b.z); b.w = sigmoidf_(b.w); }
                        u32x4 w; w.x = cvtpk(a.x, a.y); w.y = cvtpk(a.z, a.w); w.z = cvtpk(b.x, b.y); w.w = cvtpk(b.z, b.w); *(u32x4*)(rp + 32 * bj) = w;
                    }
                }
        } else if (type == 2) {
            int nh, dv, vh, dbase;
            if (pn < 12) { nh = 8; dv = 128; vh = 2 * (pn - 8) + (wc >> 1); dbase = 64 * (wc & 1); } else { nh = 4; dv = 64; vh = wc; dbase = 0; }
#pragma unroll
            for (int ai = 0; ai < 2; ++ai)
#pragma unroll
                for (int m = 0; m < 4; ++m) {
                    const int row = row0 + ai * 128 + m * 16, b = row >> 12, t = row & (SEQ - 1);
                    bf16_t* bp = dst + ((size_t)(b * nh + vh) * dv + dbase + 8 * fq) * SEQ + perm16(t);
#pragma unroll
                    for (int bj = 0; bj < 2; ++bj)
#pragma unroll
                        for (int n = 0; n < 2; ++n) { const f32x4 v = acc[ai][bj][m][n]; bf16_t* q = bp + (size_t)(32 * bj + 4 * n) * SEQ;
                            q[0] = f2bf(v.x); q[SEQ] = f2bf(v.y); q[2 * SEQ] = f2bf(v.z); q[3 * SEQ] = f2bf(v.w); }
                }
        } else {
            float* NG = (float*)(ws + WS_NG);
            if (wc == 0) {
#pragma unroll
                for (int ai = 0; ai < 2; ++ai)
#pragma unroll
                    for (int m = 0; m < 4; ++m) {
                        const int row = row0 + ai * 128 + m * 16;
#pragma unroll
                        for (int bj = 0; bj < 2; ++bj)
#pragma unroll
                            for (int n = 0; n < 2; ++n) { const int L = 32 * bj + 8 * fq + 4 * n; if (L < 48) { const f32x4 v = acc[ai][bj][m][n];
                                f32x4 o; o.x = sigmoidf_(v.x); o.y = sigmoidf_(v.y); o.z = sigmoidf_(v.z); o.w = sigmoidf_(v.w); *(f32x4*)(NG + (size_t)row * 48 + L) = o; } }
                    }
            }
        }
    }
    unsigned char* mgp;
    __device__ __forceinline__ unsigned char* P_MG() const { return mgp; }
};
struct EpiHid {
    static constexpr bool PERM = true, AFTER_DRAIN = false;
    bf16_t* HID; const float* pb;
    __device__ __forceinline__ void operator()(const f32x4 (&acc)[2][2][4][2], const pg8::Unit& u, int wr, int wc, int fr, int fq) const {
        const int row0 = u.pm * 256 + wr * 64 + fr, col0 = wc * 32 + 8 * fq;
#pragma unroll
        for (int ai = 0; ai < 2; ++ai)
#pragma unroll
            for (int m = 0; m < 4; ++m) { bf16_t* rp = HID + (size_t)(row0 + ai * 128 + m * 16) * 256 + col0;
#pragma unroll
                for (int bj = 0; bj < 2; ++bj) { const f32x4 b0 = *(const f32x4*)(pb + col0 + 128 * bj), b1 = *(const f32x4*)(pb + col0 + 128 * bj + 4);
                    const f32x4 a = acc[ai][bj][m][0] + b0, b = acc[ai][bj][m][1] + b1;
                    u32x4 w; w.x = cvtpk(gelu_tanh(a.x), gelu_tanh(a.y)); w.y = cvtpk(gelu_tanh(a.z), gelu_tanh(a.w)); w.z = cvtpk(gelu_tanh(b.x), gelu_tanh(b.y)); w.w = cvtpk(gelu_tanh(b.z), gelu_tanh(b.w));
                    *(u32x4*)(rp + 128 * bj) = w; asm volatile("" ::: "memory"); } }
    }
};
template <int MODE> struct EpiMerge {
    static constexpr bool PERM = false, AFTER_DRAIN = false;
    const bf16_t* MG; float* T1; bf16_t* MIXED;
    __device__ __forceinline__ void operator()(const f32x4 (&acc)[2][2][4][2], const pg8::Unit& u, int wr, int wc, int fr, int fq) const {
        const int row0 = u.pm * 256 + wr * 64 + fr, col0 = u.pn * 256 + wc * 32 + 4 * fq;
#pragma unroll
        for (int ai = 0; ai < 2; ++ai)
#pragma unroll
            for (int m = 0; m < 4; ++m) { const size_t row = row0 + ai * 128 + m * 16;
#pragma unroll
                for (int bj = 0; bj < 2; ++bj)
#pragma unroll
                    for (int n = 0; n < 2; ++n) { const int col = col0 + 128 * bj + 16 * n;
                        const u32x2 gw = *(const u32x2*)(MG + row * 2048 + MODE * 1024 + col);
                        f32x4 gt; gt.x = __uint_as_float(gw.x << 16); gt.y = __uint_as_float(gw.x & 0xffff0000u); gt.z = __uint_as_float(gw.y << 16); gt.w = __uint_as_float(gw.y & 0xffff0000u);
                        if (MODE == 0) { *(f32x4*)(T1 + row * 1024 + col) = gt * acc[ai][bj][m][n]; }
                        else { const f32x4 v = *(const f32x4*)(T1 + row * 1024 + col) + gt * acc[ai][bj][m][n]; u32x2 w; w.x = cvtpk(v.x, v.y); w.y = cvtpk(v.z, v.w); *(u32x2*)(MIXED + row * 1024 + col) = w; }
                    } }
    }
};
struct EpiRes1 {
    static constexpr bool PERM = false, AFTER_DRAIN = false;
    const float* x; float* out; bf16_t* XB1; float* PART;
    __device__ __forceinline__ void operator()(const f32x4 (&acc)[2][2][4][2], const pg8::Unit& u, int wr, int wc, int fr, int fq) const {
        const int row0 = u.pm * 256 + wr * 64 + fr, col0 = u.pn * 256 + wc * 32 + 4 * fq;
#pragma unroll
        for (int ai = 0; ai < 2; ++ai)
#pragma unroll
            for (int m = 0; m < 4; ++m) { const size_t row = row0 + ai * 128 + m * 16; float ss = 0.f;
#pragma unroll
                for (int bj = 0; bj < 2; ++bj)
#pragma unroll
                    for (int n = 0; n < 2; ++n) { const int col = col0 + 128 * bj + 16 * n;
                        const f32x4 v = *(const f32x4*)(x + row * 1024 + col) + acc[ai][bj][m][n];
                        *(f32x4*)(out + row * 1024 + col) = v; u32x2 w; w.x = cvtpk(v.x, v.y); w.y = cvtpk(v.z, v.w); *(u32x2*)(XB1 + row * 1024 + col) = w;
                        ss += (v.x * v.x + v.y * v.y) + (v.z * v.z + v.w * v.w); }
                ss += __shfl_xor(ss, 16); ss += __shfl_xor(ss, 32);
                if (fq == 0) PART[row * 16 + u.pn * 4 + wc] = ss; }
    }
};
struct EpiUp {
    static constexpr bool PERM = true, AFTER_DRAIN = false;
    const float* PART; bf16_t* HB;
    __device__ __forceinline__ void operator()(const f32x4 (&acc)[2][2][4][2], const pg8::Unit& u, int wr, int wc, int fr, int fq) const {
        const int row0 = u.pm * 256 + wr * 64 + fr, col0 = u.pn * 256 + wc * 32 + 8 * fq;
#pragma unroll
        for (int ai = 0; ai < 2; ++ai)
#pragma unroll
            for (int m = 0; m < 4; ++m) { const size_t row = row0 + ai * 128 + m * 16;
                const f32x4* pp = (const f32x4*)(PART + row * 16); const f32x4 p0 = pp[0], p1 = pp[1], p2 = pp[2], p3 = pp[3];
                const float ss = ((p0.x + p0.y) + (p0.z + p0.w)) + ((p1.x + p1.y) + (p1.z + p1.w)) + ((p2.x + p2.y) + (p2.z + p2.w)) + ((p3.x + p3.y) + (p3.z + p3.w));
                const float rstd = rsqrtf(ss * (1.f / 1024.f) + EPS);
#pragma unroll
                for (int bj = 0; bj < 2; ++bj) { f32x4 a = acc[ai][bj][m][0] * rstd, b = acc[ai][bj][m][1] * rstd;
                    a.x = fmaxf(a.x, 0.f); a.y = fmaxf(a.y, 0.f); a.z = fmaxf(a.z, 0.f); a.w = fmaxf(a.w, 0.f); b.x = fmaxf(b.x, 0.f); b.y = fmaxf(b.y, 0.f); b.z = fmaxf(b.z, 0.f); b.w = fmaxf(b.w, 0.f);
                    a = a * a; b = b * b;
                    u32x4 w; w.x = cvtpk(a.x, a.y); w.y = cvtpk(a.z, a.w); w.z = cvtpk(b.x, b.y); w.w = cvtpk(b.z, b.w); *(u32x4*)(HB + row * 4096 + col0 + 128 * bj) = w; } }
    }
};
struct EpiRes2 {
    static constexpr bool PERM = false, AFTER_DRAIN = false;
    float* out;
    __device__ __forceinline__ void operator()(const f32x4 (&acc)[2][2][4][2], const pg8::Unit& u, int wr, int wc, int fr, int fq) const {
        const int row0 = u.pm * 256 + wr * 64 + fr, col0 = u.pn * 256 + wc * 32 + 4 * fq;
#pragma unroll
        for (int ai = 0; ai < 2; ++ai)
#pragma unroll
            for (int m = 0; m < 4; ++m) { const size_t row = row0 + ai * 128 + m * 16;
#pragma unroll
                for (int bj = 0; bj < 2; ++bj)
#pragma unroll
                    for (int n = 0; n < 2; ++n) { float* p = out + row * 1024 + col0 + 128 * bj + 16 * n; *(f32x4*)p = *(const f32x4*)p + acc[ai][bj][m][n]; } }
    }
};
struct OneUnit {
    int pm, pn;
    __device__ bool next(int i, pg8::Unit& u) const { if (i > 0) return false; u.pm = pm; u.pn = pn; return true; }
    __device__ __forceinline__ void a_ready(const pg8::Unit&) const {}
    __device__ __forceinline__ void done(const pg8::Unit&) const {}
};

#define MFMA32(a, b, c) __builtin_amdgcn_mfma_f32_32x32x16_bf16((a), (b), (c), 0, 0, 0)
#define EXP2(x) __builtin_amdgcn_exp2f(x)

__device__ __forceinline__ void load_q(const bf16_t* qrow, int hi, bf16x8 (&qf)[4]) {
#pragma unroll
    for (int ds = 0; ds < 4; ++ds) qf[ds] = *(const bf16x8*)(qrow + 16 * ds + 8 * hi);
}
template <int KROW>
__device__ __forceinline__ void qk_tile(const LAS bf16_t* Kt, const bf16x8 (&qf)[4], f32x16 (&s)[2], int r32, int hi) {
#pragma unroll
    for (int kb = 0; kb < 2; ++kb) {
        f32x16 a = {};
#pragma unroll
        for (int ds = 0; ds < 4; ++ds) { const bf16x8 kf = *(const LAS bf16x8*)(Kt + (32 * kb + r32) * KROW + 16 * ds + 8 * hi); a = MFMA32(kf, qf[ds], a); }
        s[kb] = a;
    }
}
template <int DV, int VROW>
__device__ __forceinline__ void pv_tile(const LAS bf16_t* Vt, const f32x16 (&p)[2], f32x16 (&o)[DV / 32], int r32, int hi) {
    bf16x8 pb[4];
#pragma unroll
    for (int j = 0; j < 4; ++j) { const int kb = j >> 1, r0 = 8 * (j & 1); u32x4 w; w.x = cvtpk(p[kb][r0], p[kb][r0 + 1]); w.y = cvtpk(p[kb][r0 + 2], p[kb][r0 + 3]); w.z = cvtpk(p[kb][r0 + 4], p[kb][r0 + 5]); w.w = cvtpk(p[kb][r0 + 6], p[kb][r0 + 7]); pb[j] = __builtin_bit_cast(bf16x8, w); }
#pragma unroll
    for (int db = 0; db < DV / 32; ++db) {
        bf16x8 vf[4];
#pragma unroll
        for (int j = 0; j < 4; ++j) vf[j] = *(const LAS bf16x8*)(Vt + (32 * db + r32) * VROW + 16 * j + 8 * hi);
#pragma unroll
        for (int j = 0; j < 4; ++j) o[db] = MFMA32(vf[j], pb[j], o[db]);
        __builtin_amdgcn_sched_barrier(0);
    }
}
template <int DV, class TF>
__device__ __forceinline__ void attn_loop(LAS unsigned char* lds, const bf16_t* Kg, int ldk, const bf16_t* VTg, int ldv, unsigned long long tmask,
                                          const bf16x8 (&qf)[4], f32x16 (&o)[DV / 32], float& m, float& l, const TF& tf) {
    const int tid = threadIdx.x, lane = tid & 63, r32 = lane & 31, hi = lane >> 5, srow = tid >> 3, sch = tid & 7;
    u32x4 kreg, vreg[DV / 64];
    int buf = 0;
    if (tmask) { const int t = __builtin_ctzll(tmask); kreg = *(const u32x4*)(Kg + (size_t)(64 * t + srow) * ldk + sch * 8);
#pragma unroll
        for (int i = 0; i < DV / 64; ++i) vreg[i] = *(const u32x4*)(VTg + (size_t)(srow + 64 * i) * ldv + 64 * t + sch * 8); }
    while (tmask) {
        const int t = __builtin_ctzll(tmask); tmask &= tmask - 1;
        LAS bf16_t* Kt = (LAS bf16_t*)(lds + buf * ABUF); LAS bf16_t* Vt = Kt + 64 * TROW;
        *(LAS u32x4*)(Kt + srow * TROW + sch * 8) = kreg;
#pragma unroll
        for (int i = 0; i < DV / 64; ++i) *(LAS u32x4*)(Vt + (srow + 64 * i) * TROW + sch * 8) = vreg[i];
        __syncthreads();
        if (tmask) { const int tn = __builtin_ctzll(tmask); kreg = *(const u32x4*)(Kg + (size_t)(64 * tn + srow) * ldk + sch * 8);
#pragma unroll
            for (int i = 0; i < DV / 64; ++i) vreg[i] = *(const u32x4*)(VTg + (size_t)(srow + 64 * i) * ldv + 64 * tn + sch * 8); }
        const int md = tf.mode(t);
        if (md) {
            f32x16 s[2];
            qk_tile<TROW>(Kt, qf, s, r32, hi);
            if (md == 2) {
#pragma unroll
                for (int kb = 0; kb < 2; ++kb)
#pragma unroll
                    for (int r = 0; r < 16; ++r) if (!tf.valid(t, 32 * kb + crow(r, hi))) s[kb][r] = -INFINITY;
            }
            float mx = fmaxf(s[0][0], s[1][0]);
#pragma unroll
            for (int r = 1; r < 16; ++r) mx = fmaxf(mx, fmaxf(s[0][r], s[1][r]));
            mx = fmaxf(mx, __shfl_xor(mx, 32));
            const float mn = fmaxf(m, mx), alpha = EXP2(m - mn); m = mn;
            float rs = 0.f;
#pragma unroll
            for (int kb = 0; kb < 2; ++kb)
#pragma unroll
                for (int r = 0; r < 16; ++r) { const float e = EXP2(s[kb][r] - mn); s[kb][r] = e; rs += e; }
            l = l * alpha + rs;
            if (!__all(alpha == 1.0f)) {
#pragma unroll
                for (int db = 0; db < DV / 32; ++db) o[db] = o[db] * alpha;
            }
            pv_tile<DV, TROW>(Vt, s, o, r32, hi);
        }
        buf ^= 1;
    }
    __syncthreads();
}

struct DiffTF { int qlo, qpos; __device__ __forceinline__ int mode(int t) const { return 64 * t > qlo + 31 ? 0 : (64 * t + 63 > qlo ? 2 : 1); } __device__ __forceinline__ bool valid(int t, int key) const { return 64 * t + key <= qpos; } };
__device__ __forceinline__ void diff_unit(const Params& P, LAS unsigned char* lds, int b, int h, int qb, float lam) {
    const int tid = threadIdx.x, lane = tid & 63, wave = tid >> 6, r32 = lane & 31, hi = lane >> 5;
    unsigned char* ws = P.ws;
    const int q0 = qb * 256, qpos = q0 + 32 * wave + r32;
    bf16_t* DQ = (bf16_t*)(ws + WS_DQ); const bf16_t* DK = (const bf16_t*)(ws + WS_DK); const bf16_t* DVT = (const bf16_t*)(ws + WS_DVT);
    bf16_t* qrow = DQ + (size_t)(b * SEQ + qpos) * 1024 + h * 128;
    const unsigned long long tmask = (qb == 15) ? ~0ull : ((1ull << (4 * qb + 4)) - 1ull);
    DiffTF tf; tf.qlo = q0 + 32 * wave; tf.qpos = qpos;
    LAS unsigned* o0p = (LAS unsigned*)(lds + L_CK) + wave * 32 * 64 + lane;
    f32x16 o0[4];
#pragma unroll
    for (int c = 0; c < 2; ++c) {
        bf16x8 qf[4]; load_q(qrow + 64 * c, hi, qf);
        f32x16 o[4];
#pragma unroll
        for (int db = 0; db < 4; ++db) o[db] = (f32x16){};
        float m = -1e30f, l = 0.f;
        attn_loop<128, DiffTF>(lds, DK + (size_t)b * SEQ * 1024 + (h * 2 + c) * 64, 1024, DVT + (size_t)((b * 8 + h) * 128) * SEQ, SEQ, tmask, qf, o, m, l, tf);
        l += __shfl_xor(l, 32);
        const float inv = 1.0f / fmaxf(l, 1e-30f);
        if (c == 0) {
#pragma unroll
            for (int db = 0; db < 4; ++db)
#pragma unroll
                for (int r = 0; r < 8; ++r) o0p[(db * 8 + r) * 64] = cvtpk(o[db][2 * r] * inv, o[db][2 * r + 1] * inv);
        } else {
            const float il = inv * lam;
#pragma unroll
            for (int db = 0; db < 4; ++db)
#pragma unroll
                for (int r = 0; r < 8; ++r) { const unsigned pw = o0p[(db * 8 + r) * 64]; o0[db][2 * r] = __uint_as_float(pw << 16) - o[db][2 * r] * il; o0[db][2 * r + 1] = __uint_as_float(pw & 0xffff0000u) - o[db][2 * r + 1] * il; }
        }
    }
    float ss = 0.f;
#pragma unroll
    for (int db = 0; db < 4; ++db)
#pragma unroll
        for (int r = 0; r < 16; ++r) ss += o0[db][r] * o0[db][r];
    ss += __shfl_xor(ss, 32);
    const float rstd = rsqrtf(ss * (1.f / 128.f) + EPS) * 0.8f;
    const float* sg = P.in[9];
#pragma unroll
    for (int db = 0; db < 4; ++db)
#pragma unroll
        for (int u = 0; u < 4; ++u) { const int d = 32 * db + 8 * u + 4 * hi; const f32x4 g4 = *(const f32x4*)(sg + d);
            u32x2 w; w.x = cvtpk(o0[db][4 * u] * rstd * g4.x, o0[db][4 * u + 1] * rstd * g4.y); w.y = cvtpk(o0[db][4 * u + 2] * rstd * g4.z, o0[db][4 * u + 3] * rstd * g4.w);
            *(u32x2*)(qrow + d) = w; }
}

__device__ __forceinline__ void compress_unit(const Params& P, LAS unsigned char* lds, int which, int pm) {
    unsigned char* ws = P.ws;
    bf16_t* HID = (bf16_t*)(ws + WS_HID) + (size_t)which * 4096 * 256;
    {
        pg8::Gemm g = pg8::make_gemm((const bf16_t*)(ws + (which ? WS_VC : WS_KC)), (const bf16_t*)(ws + WS_W1T) + (size_t)which * 256 * 2048, 4096, 256, 2048);
        g.lda = 4096; g.kstepA = 512; g.a_sh = 2; g.a_lo = (size_t)256 * 4096 * 2; g.a_hi = 128;
        OneUnit S{pm, 0}; EpiHid E{HID, (const float*)(ws + WS_PB) + which * 256};
        pg8::gemm_phase<EpiHid, OneUnit, false, true>((PG8_LAS unsigned char*)lds, g, S, E);
    }
    __threadfence(); __syncthreads(); __threadfence();
    int tid = threadIdx.x; asm volatile("" : "+v"(tid));
    const int lane = tid & 63, wave = tid >> 6, r32 = lane & 31, hi = lane >> 5;
    const bf16_t* W2T = (const bf16_t*)(ws + WS_W2T) + which * 64 * 256;
    const int rowl = 32 * wave + r32; const bf16_t* hrow = HID + (size_t)(pm * 256 + rowl) * 256;
    f32x16 c0 = {}, c1 = {};
#pragma unroll 2
    for (int ks = 0; ks < 16; ++ks) {
        const bf16x8 a0 = *(const bf16x8*)(W2T + r32 * 256 + 16 * ks + 8 * hi), a1 = *(const bf16x8*)(W2T + (32 + r32) * 256 + 16 * ks + 8 * hi), bf = *(const bf16x8*)(hrow + 16 * ks + 8 * hi);
        c0 = MFMA32(a0, bf, c0); c1 = MFMA32(a1, bf, c1);
    }
    const int g = pm >> 2, b = pm & 3, n = rowl;
    if (which == 0) {
        float ss = 0.f;
#pragma unroll
        for (int r = 0; r < 16; ++r) ss += c0[r] * c0[r] + c1[r] * c1[r];
        ss += __shfl_xor(ss, 32);
        const float rstd = (n < 255) ? rsqrtf(ss * (1.f / 64.f) + EPS) : 0.f;
        const float* gk = P.in[11]; const float* CC = (const float*)(ws + WS_CCOS) + n * 32; const float* CS = (const float*)(ws + WS_CSIN) + n * 32;
        bf16_t* kr = (bf16_t*)(ws + WS_KCMP) + (size_t)((b * 4 + g) * 256 + n) * 64;
#pragma unroll
        for (int u = 0; u < 4; ++u) { const int i = 8 * u + 4 * hi; const f32x4 g1 = *(const f32x4*)(gk + i), g2 = *(const f32x4*)(gk + 32 + i), cc = *(const f32x4*)(CC + i), sn = *(const f32x4*)(CS + i);
            float o1[4], o2[4];
#pragma unroll
            for (int j = 0; j < 4; ++j) { const float x1 = c0[4 * u + j] * rstd * g1[j], x2 = c1[4 * u + j] * rstd * g2[j]; o1[j] = x1 * cc[j] - x2 * sn[j]; o2[j] = x2 * cc[j] + x1 * sn[j]; }
            u32x2 w; w.x = cvtpk(o1[0], o1[1]); w.y = cvtpk(o1[2], o1[3]); *(u32x2*)(kr + i) = w; w.x = cvtpk(o2[0], o2[1]); w.y = cvtpk(o2[2], o2[3]); *(u32x2*)(kr + 32 + i) = w; }
    } else {
        bf16_t* vt = (bf16_t*)(ws + WS_VCMPT) + (size_t)((b * 4 + g) * 64) * 256 + perm16(n);
        const float z = (n < 255) ? 1.f : 0.f;
#pragma unroll
        for (int r = 0; r < 16; ++r) { const int d = crow(r, hi); vt[(size_t)d * 256] = f2bf(c0[r] * z); vt[(size_t)(d + 32) * 256] = f2bf(c1[r] * z); }
    }
}

struct SlcTF { unsigned long long mymask, wu; int qpos; __device__ __forceinline__ int mode(int t) const { return ((wu >> t) & 1ull) ? 2 : 0; }
    __device__ __forceinline__ bool valid(int t, int key) const { return ((mymask >> t) & 1ull) && (64 * t + key <= qpos); } };
struct WinTF { int c, qpos; __device__ __forceinline__ int mode(int t) const { return (t == c || t == c - 8) ? 2 : 1; }
    __device__ __forceinline__ bool valid(int t, int key) const { const int kp = 64 * t + key; return kp <= qpos && qpos - kp < 512; } };
__device__ __forceinline__ void nsa_unit(const Params& P, LAS unsigned char* lds, int b, int g, int c) {
    const int tid = threadIdx.x, lane = tid & 63, wave = tid >> 6, r32 = lane & 31, hi = lane >> 5;
    unsigned char* ws = P.ws;
    const int q0 = 64 * c, tk = r32 >> 2, hg = r32 & 3, tokl = 8 * wave + tk, qpos = q0 + tokl;
    bf16_t* qrow = (bf16_t*)(ws + WS_NQ) + (size_t)(b * SEQ + qpos) * 1024 + (g * 4 + hg) * 64;
    bf16x8 qf[4]; load_q(qrow, hi, qf);
    const float* ngp = (const float*)(ws + WS_NG) + (size_t)(b * SEQ + qpos) * 48 + (g * 4 + hg) * 3;
    const float gate0 = ngp[0], gate1 = ngp[1], gate2 = ngp[2];
    f32x16 yt[2]; yt[0] = (f32x16){}; yt[1] = (f32x16){};
    const int ntl = (4 * c + 2) / 64 + 1;
    LAS bf16_t* CK = (LAS bf16_t*)(lds + L_CK); LAS bf16_t* CV = (LAS bf16_t*)(lds + L_CV);
    LAS float* IMP = (LAS float*)(lds + L_IMP); LAS unsigned long long* SEL = (LAS unsigned long long*)(lds + L_SEL);
    {
        const bf16_t* kc = (const bf16_t*)(ws + WS_KCMP) + (size_t)((b * 4 + g) * 256) * 64; const bf16_t* vc = (const bf16_t*)(ws + WS_VCMPT) + (size_t)((b * 4 + g) * 64) * 256;
        for (int i = tid; i < ntl * 512; i += NTHREADS) { const int row = i >> 3, ch = i & 7; *(LAS u32x4*)(CK + row * CKROW + ch * 8) = *(const u32x4*)(kc + row * 64 + ch * 8); }
        for (int i = tid; i < 64 * 8 * ntl; i += NTHREADS) { const int d = i / (8 * ntl), ch = i % (8 * ntl); *(LAS u32x4*)(CV + d * CVROW + ch * 8) = *(const u32x4*)(vc + d * 256 + ch * 8); }
    }
    __syncthreads();
    {
        float m = -1e30f, l = 0.f;
        for (int T = 0; T < ntl; ++T) {
            f32x16 s[2]; qk_tile<CKROW>(CK + T * 64 * CKROW, qf, s, r32, hi);
            float mx = -INFINITY;
#pragma unroll
            for (int kb = 0; kb < 2; ++kb)
#pragma unroll
                for (int r = 0; r < 16; ++r) { const int n = 64 * T + 32 * kb + crow(r, hi); if (16 * n + 31 > qpos) s[kb][r] = -INFINITY; mx = fmaxf(mx, s[kb][r]); }
            mx = fmaxf(mx, __shfl_xor(mx, 32));
            const float mn = fmaxf(m, mx), alpha = EXP2(m - mn); m = mn; float rs = 0.f;
#pragma unroll
            for (int kb = 0; kb < 2; ++kb)
#pragma unroll
                for (int r = 0; r < 16; ++r) rs += EXP2(s[kb][r] - mn);
            l = l * alpha + rs;
        }
        l += __shfl_xor(l, 32);
        const float invl = 1.0f / fmaxf(l, 1e-30f);
        f32x16 o[2]; o[0] = (f32x16){}; o[1] = (f32x16){};
        float carry = 0.f;
        for (int T = 0; T < ntl; ++T) {
            f32x16 s[2]; qk_tile<CKROW>(CK + T * 64 * CKROW, qf, s, r32, hi);
#pragma unroll
            for (int kb = 0; kb < 2; ++kb)
#pragma unroll
                for (int r = 0; r < 16; ++r) { const int n = 64 * T + 32 * kb + crow(r, hi); s[kb][r] = (16 * n + 31 > qpos) ? 0.f : EXP2(s[kb][r] - m) * invl; }
#pragma unroll
            for (int kb = 0; kb < 2; ++kb)
#pragma unroll
                for (int u = 0; u < 4; ++u) {
                    const float qs = (s[kb][4 * u] + s[kb][4 * u + 1]) + (s[kb][4 * u + 2] + s[kb][4 * u + 3]);
                    const float x = __shfl_xor(s[kb][4 * u + 3], 32);
                    float iv = qs + (hi ? x : carry); carry = x;
                    iv += __shfl_xor(iv, 1); iv += __shfl_xor(iv, 2);
                    if (hg == 0) IMP[tokl * 64 + 16 * T + 8 * kb + 2 * u + hi] = iv;
                }
            pv_tile<64, CVROW>(CV + 64 * T, s, o, r32, hi);
        }
#pragma unroll
        for (int db = 0; db < 2; ++db) yt[db] = o[db] * gate0;
    }
    __syncthreads();
    for (int i = 0; i < 8; ++i) {
        const int tl = 8 * wave + i; const int j = lane;
        const bool forced = (j == 0) || (j == c) || (j == c - 1);
        float v = forced ? 1e4f : IMP[tl * 64 + j];
        if (j > c) v = -INFINITY;
        int rank = 0;
#pragma unroll 8
        for (int k = 0; k < 64; ++k) { const float vk = __uint_as_float(__builtin_amdgcn_readlane(__float_as_uint(v), k)); rank += (vk > v || (vk == v && k < j)) ? 1 : 0; }
        const unsigned long long msk = __ballot(rank < 16 && j <= c);
        if (lane == 0) SEL[tl] = msk;
    }
    __syncthreads();
    unsigned long long mymask = SEL[tokl], wu = 0ull;
#pragma unroll
    for (int i = 0; i < 8; ++i) wu |= SEL[8 * wave + i];
    {
        SlcTF tf; tf.mymask = mymask; tf.wu = wu; tf.qpos = qpos;
        const unsigned long long tmask = (c == 63) ? ~0ull : ((1ull << (c + 1)) - 1ull);
        f32x16 o[2]; o[0] = (f32x16){}; o[1] = (f32x16){}; float m = -1e30f, l = 0.f;
        attn_loop<64, SlcTF>(lds, (const bf16_t*)(ws + WS_KSL) + (size_t)b * SEQ * 256 + g * 64, 256, (const bf16_t*)(ws + WS_VSLT) + (size_t)((b * 4 + g) * 64) * SEQ, SEQ, tmask, qf, o, m, l, tf);
        l += __shfl_xor(l, 32); const float sc = gate1 / fmaxf(l, 1e-30f);
#pragma unroll
        for (int db = 0; db < 2; ++db) yt[db] = yt[db] + o[db] * sc;
    }
    {
        WinTF tf; tf.c = c; tf.qpos = qpos;
        const int tlo = c >= 8 ? c - 8 : 0;
        const unsigned long long hi_m = (c == 63) ? ~0ull : ((1ull << (c + 1)) - 1ull), tmask = hi_m & ~((1ull << tlo) - 1ull);
        f32x16 o[2]; o[0] = (f32x16){}; o[1] = (f32x16){}; float m = -1e30f, l = 0.f;
        attn_loop<64, WinTF>(lds, (const bf16_t*)(ws + WS_KWN) + (size_t)b * SEQ * 256 + g * 64, 256, (const bf16_t*)(ws + WS_VWNT) + (size_t)((b * 4 + g) * 64) * SEQ, SEQ, tmask, qf, o, m, l, tf);
        l += __shfl_xor(l, 32); const float sc = gate2 / fmaxf(l, 1e-30f);
#pragma unroll
        for (int db = 0; db < 2; ++db) yt[db] = yt[db] + o[db] * sc;
    }
#pragma unroll
    for (int db = 0; db < 2; ++db)
#pragma unroll
        for (int u = 0; u < 4; ++u) { const int d = 32 * db + 8 * u + 4 * hi; u32x2 w; w.x = cvtpk(yt[db][4 * u], yt[db][4 * u + 1]); w.y = cvtpk(yt[db][4 * u + 2], yt[db][4 * u + 3]); *(u32x2*)(qrow + d) = w; }
}

__device__ __forceinline__ int next_item(unsigned* counter, LAS int* slot) {
    __syncthreads();
    if (threadIdx.x == 0) *slot = (int)atomicAdd(counter, 1u);
    __syncthreads();
    return *slot;
}

__global__ void __launch_bounds__(NTHREADS) fwd_megakernel(Params P) {
    extern __shared__ __attribute__((aligned(16))) unsigned char lds_raw[];
    LAS unsigned char* lds = (LAS unsigned char*)lds_raw;
    cg::grid_group grid = cg::this_grid();
    const int G = gridDim.x, bx = blockIdx.x;
    const int vb = (G % 8 == 0) ? (bx % 8) * (G / 8) + bx / 8 : bx;
    unsigned char* ws = P.ws;
    unsigned* ctl = (unsigned*)(ws + WS_CTL);
    LAS int* slot = (LAS int*)(lds + L_SLOT);
    const int lo = P.ph_lo, hi = P.ph_hi;
#ifndef PHMASK
#define PHMASK 0xff
#endif
#define IN(k) (((PHMASK >> (k)) & 1) && lo <= (k) && (k) < hi)
#define SEAM(k) do { if (IN(k) && IN((k) + 1)) grid.sync(); } while (0)

    if (IN(0)) p0_prologue(P, lds, vb, G);
    SEAM(0);
    if (IN(1)) {
        pg8::Gemm g = pg8::make_gemm((const bf16_t*)(ws + WS_XN), (const bf16_t*)(ws + WS_WIN), MTOK, NPAD, 1024);
        pg8::StaticOrder S; S.init(MTOK, NPAD, G, bx);
        EpiProj E; E.ws = ws; E.gq = P.in[3]; E.gk = P.in[4]; E.gnq = P.in[10]; E.gnk = P.in[11]; E.mgp = (unsigned char*)P.out;
        pg8::gemm_phase<EpiProj, pg8::StaticOrder, true, true>((PG8_LAS unsigned char*)lds, g, S, E);
    }
    SEAM(1);
    if (IN(2)) {
        float lam;
        { const int lane = threadIdx.x & 63; const float a = wave_sum(P.in[5][lane] * P.in[6][lane]), b2 = wave_sum(P.in[7][lane] * P.in[8][lane]); lam = expf(a) - expf(b2) + 0.2f; }
#ifndef NO_CMP
        for (;;) {
            const int it = next_item(ctl + 128, slot);
            if (it >= 32) break;
            compress_unit(P, lds, it >> 4, it & 15);
        }
#endif
#ifndef NO_DIFF
        for (;;) {
            const int it = next_item(ctl + 0, slot);
            if (it >= 512) break;
            const int qb = 15 - (it >> 5), bh = it & 31; diff_unit(P, lds, bh >> 3, bh & 7, qb, lam);
        }
#endif
    }
    SEAM(2);
    if (IN(3)) {
        for (;;) {
            const int it = next_item(ctl + 64, slot);
            if (it >= 1024) break;
            const int c = 63 - (it >> 4), bg = it & 15; nsa_unit(P, lds, bg >> 2, bg & 3, c);
        }
    }
    SEAM(3);
    if (IN(4)) {
        pg8::StaticOrder S; S.init(MTOK, 1024, G, bx);
        { pg8::Gemm g = pg8::make_gemm((const bf16_t*)(ws + WS_DQ), (const bf16_t*)(ws + WS_WPD), MTOK, 1024, 1024);
          EpiMerge<0> E{(const bf16_t*)P.out, (float*)(ws + WS_T1), (bf16_t*)(ws + WS_MIXED)};
          pg8::gemm_phase<EpiMerge<0>, pg8::StaticOrder, true, true>((PG8_LAS unsigned char*)lds, g, S, E); }
        { pg8::Gemm g = pg8::make_gemm((const bf16_t*)(ws + WS_NQ), (const bf16_t*)(ws + WS_WPN), MTOK, 1024, 1024);
          EpiMerge<1> E{(const bf16_t*)P.out, (float*)(ws + WS_T1), (bf16_t*)(ws + WS_MIXED)};
          pg8::gemm_phase<EpiMerge<1>, pg8::StaticOrder, true, true>((PG8_LAS unsigned char*)lds, g, S, E); }
    }
    SEAM(4);
    if (IN(5)) {
        pg8::Gemm g = pg8::make_gemm((const bf16_t*)(ws + WS_MIXED), (const bf16_t*)(ws + WS_WOUT), MTOK, 1024, 1024);
        pg8::StaticOrder S; S.init(MTOK, 1024, G, bx);
        EpiRes1 E{P.in[0], P.out, (bf16_t*)(ws + WS_XB1), (float*)(ws + WS_PART)};
        pg8::gemm_phase<EpiRes1, pg8::StaticOrder, true, true>((PG8_LAS unsigned char*)lds, g, S, E);
    }
    SEAM(5);
    if (IN(6)) {
        pg8::Gemm g = pg8::make_gemm((const bf16_t*)(ws + WS_XB1), (const bf16_t*)(ws + WS_WUP), MTOK, DFF, 1024);
        pg8::StaticOrder S; S.init(MTOK, DFF, G, bx);
        EpiUp E{(const float*)(ws + WS_PART), (bf16_t*)(ws + WS_HB)};
        pg8::gemm_phase<EpiUp, pg8::StaticOrder, true, true>((PG8_LAS unsigned char*)lds, g, S, E);
    }
    SEAM(6);
    if (IN(7)) {
        pg8::Gemm g = pg8::make_gemm((const bf16_t*)(ws + WS_HB), (const bf16_t*)(ws + WS_WDN), MTOK, 1024, DFF);
        pg8::StaticOrder S; S.init(MTOK, 1024, G, bx);
        EpiRes2 E{P.out};
        pg8::gemm_phase<EpiRes2, pg8::StaticOrder, true, true>((PG8_LAS unsigned char*)lds, g, S, E);
    }
#undef IN
#undef SEAM
}

extern "C" void kernel_launch(void* const* d_in, const int* in_sizes, int n_in, void* d_out, int out_size, void* d_ws, size_t ws_size, hipStream_t stream) {
    static int grid = 0;
    if (grid == 0) {
        if (n_in != 24 || out_size != MTOK * DM || ws_size < WS_END) { fprintf(stderr, "kernel_launch: unexpected shapes (n_in %d out %d ws %zu)\n", n_in, out_size, ws_size); grid = -1; return; }
        int dev = 0, cus = 0, per_cu = 0;
        hipGetDevice(&dev); hipDeviceGetAttribute(&cus, hipDeviceAttributeMultiprocessorCount, dev);
        if (hipFuncSetAttribute((const void*)fwd_megakernel, hipFuncAttributeMaxDynamicSharedMemorySize, LDS_BYTES) != hipSuccess) { fprintf(stderr, "kernel_launch: hipFuncSetAttribute failed\n"); grid = -1; return; }
        if (hipOccupancyMaxActiveBlocksPerMultiprocessor(&per_cu, (const void*)fwd_megakernel, NTHREADS, LDS_BYTES) != hipSuccess || per_cu < 1) { fprintf(stderr, "kernel_launch: occupancy query says %d\n", per_cu); per_cu = 1; }
        (void)hipGetLastError();
        grid = cus * 1;
        fprintf(stderr, "kernel_launch: grid %d (cus %d, per_cu %d)\n", grid, cus, per_cu);
    }
    if (grid < 0) return;
    hipMemsetAsync((char*)d_ws + WS_CTL, 0, CTL_BYTES, stream);
    Params p{};
    for (int i = 0; i < 24; ++i) p.in[i] = (const float*)d_in[i];
    p.out = (float*)d_out; p.ws = (unsigned char*)d_ws;
    for (int i = 0; i < 32; ++i) p.invfreq[i] = (double)powf(10000.0f, -(float)i / 32.0f);
    p.ph_lo = 0; p.ph_hi = 8;
    void* args[] = {&p};
    hipError_t e = hipLaunchCooperativeKernel((const void*)fwd_megakernel, dim3(grid), dim3(NTHREADS), args, LDS_BYTES, stream);
    if (e != hipSuccess) fprintf(stderr, "kernel_launch: cooperative launch failed: %s (grid %d)\n", hipGetErrorString(e), grid);
}
```

```cpp
#include <hip/hip_runtime.h>
#include <hip/hip_cooperative_groups.h>
#include <cstdio>
#include <cstdint>
#include <cmath>
namespace cg = cooperative_groups;

namespace pg8 {
#define PG8_LAS __attribute__((address_space(3)))
typedef unsigned short bf16_t;
typedef short bf16x8 __attribute__((ext_vector_type(8)));
typedef float f32x4 __attribute__((ext_vector_type(4)));
typedef unsigned u32x4 __attribute__((ext_vector_type(4)));
constexpr int BM = 256, BK = 64, HALF = 128, HTB = HALF * BK * 2  , STAGE_BYTES = 8 * HTB, NXCD = 8, WGM = 8;

__host__ __device__ __forceinline__ int lds_byte(int r, int c) { const int st = (r >> 4) * 2 + (c >> 5), rr = r & 15, cc = c & 31, ob = rr * 64 + cc * 2; return st * 1024 + (ob ^ (((ob >> 9) & 1) << 5)); }
__host__ __device__ __forceinline__ void stage_rc(int b, int& R, int& C) { const int st = b / 1024, sb = b % 1024, swz = sb ^ (((sb >> 9) & 1) << 5); R = (st >> 1) * 16 + swz / 64; C = (st & 1) * 32 + (swz % 64) / 2; }
__host__ __device__ __forceinline__ int perm32(int rho) { const int n = rho >> 4, i = rho & 15; return 8 * (i >> 2) + 4 * n + (i & 3); }

struct Unit { int pm, pn; };
struct Gemm { const bf16_t* A; const bf16_t* Bt; int M, N, K; int lda; int kstepA; int a_sh; size_t a_lo, a_hi; };
__host__ __device__ __forceinline__ Gemm make_gemm(const bf16_t* A, const bf16_t* Bt, int M, int N, int K) { Gemm g; g.A = A; g.Bt = Bt; g.M = M; g.N = N; g.K = K; g.lda = K; g.kstepA = BK * 2; g.a_sh = 24; g.a_lo = (size_t)BM * K * 2; g.a_hi = 0; return g; }
__device__ __forceinline__ const char* a_tile(const Gemm& g, int pm) { return (const char*)g.A + (size_t)(pm >> g.a_sh) * g.a_hi + (size_t)(pm & ((1 << g.a_sh) - 1)) * g.a_lo; }

struct StaticOrder {
    int nM, nN, nwg, G, c;
    __host__ __device__ void init(int M, int N, int G_, int c_) { nM = M / BM; nN = N / BM; nwg = nM * nN; G = G_; c = c_; }
    __host__ __device__ bool next(int i, Unit& u) const {
        const long L = (long)i * G + c; if (L >= nwg) return false;
        int wgid = (int)L; { const int q = nwg / NXCD, r = nwg % NXCD, xcd = wgid % NXCD, off = wgid / NXCD; wgid = (xcd < r ? xcd * (q + 1) : r * (q + 1) + (xcd - r) * q) + off; }
        const int nig = WGM * nN, gid = wgid / nig, fm = gid * WGM, gsz = (nM - fm) < WGM ? (nM - fm) : WGM;
        u.pm = fm + ((wgid % nig) % gsz); u.pn = (wgid % nig) / gsz; return true;
    }
    __device__ __forceinline__ void a_ready(const Unit&) const {}
    __device__ __forceinline__ void done(const Unit&) const {}
};


template <class Epi, class Sched, bool ALIGN_EPI = false, bool SP2 = false>
__device__ __forceinline__ void gemm_phase(PG8_LAS unsigned char* lds, const Gemm g, const Sched& S, const Epi& E) {
    const int tid = threadIdx.x, wid = __builtin_amdgcn_readfirstlane(tid >> 6), lane = tid & 63, wr = wid >> 2, wc = wid & 3, fr = lane & 15, fq = lane >> 4;
    const int K = g.K, nt = K / BK;
    unsigned voffA[2], voffB[2];
#pragma unroll
    for (int i = 0; i < 2; ++i) { int R, C; stage_rc(tid * 16 + i * 8192, R, C); const int Rb = Epi::PERM ? ((R & ~31) + perm32(R & 31)) : R;
        voffA[i] = (unsigned)(R * g.lda + C) * 2u; voffB[i] = (unsigned)(Rb * K + C) * 2u; }
    const size_t kstep = (size_t)(BK * 2); const size_t kstepA = (size_t)g.kstepA; const size_t hstepA = (size_t)HALF * g.lda * 2;
    const size_t hstep = (size_t)HALF * K * 2;
    const size_t tstep = 2 * hstep;
    const unsigned ldsw = (unsigned)wid * 1024u;
    const int aoff = lds_byte(wr * 64 + fr, fq * 8), boff = lds_byte(wc * 32 + fr, fq * 8);
#define PG8_SA(b, h) (((b) * 2 + (h)) * HTB)
#define PG8_SB(b, h) ((4 + (b) * 2 + (h)) * HTB)
#define PG8_STAGE(bufoff, gbase, voff) do { _Pragma("unroll") for (int _i = 0; _i < 2; ++_i) \
        __builtin_amdgcn_global_load_lds((const unsigned*)((const char*)(gbase) + (voff)[_i]), (PG8_LAS unsigned*)(lds + (bufoff) + ldsw + _i * 8192), 16, 0, 0); } while (0)
#define PG8_LDA(dst, b, h) do { _Pragma("unroll") for (int m = 0; m < 4; ++m) _Pragma("unroll") for (int k = 0; k < 2; ++k) dst[m][k] = *(const PG8_LAS bf16x8*)(lds + PG8_SA(b, h) + aoff + m * 2048 + k * 1024); } while (0)
#define PG8_LDB(dst, b, h) do { _Pragma("unroll") for (int n = 0; n < 2; ++n) _Pragma("unroll") for (int k = 0; k < 2; ++k) dst[n][k] = *(const PG8_LAS bf16x8*)(lds + PG8_SB(b, h) + boff + n * 2048 + k * 1024); } while (0)
#define PG8_MMA(ai, bj, At, Bt) do { __builtin_amdgcn_s_setprio(1); _Pragma("unroll") for (int m = 0; m < 4; ++m) _Pragma("unroll") for (int n = 0; n < 2; ++n) _Pragma("unroll") for (int k = 0; k < 2; ++k) \
        acc[ai][bj][m][n] = __builtin_amdgcn_mfma_f32_16x16x32_bf16(Bt[n][k], At[m][k], acc[ai][bj][m][n], 0, 0, 0); __builtin_amdgcn_s_setprio(0); } while (0)
#define PG8_WAIT_V(n) asm volatile("s_waitcnt vmcnt(" #n ")" ::: "memory")
#define PG8_WAIT_L(n) asm volatile("s_waitcnt lgkmcnt(" #n ")" ::: "memory")
#define PG8_BAR __builtin_amdgcn_s_barrier()
#define PG8_SCHED __builtin_amdgcn_sched_barrier(0)
    Unit cur, nxt; int ui = 0;
    if (!S.next(0, cur)) return;
    f32x4 acc[2][2][4][2];
#pragma unroll
    for (int a = 0; a < 2; ++a)
#pragma unroll
        for (int b = 0; b < 2; ++b)
#pragma unroll
            for (int m = 0; m < 4; ++m)
#pragma unroll
                for (int n = 0; n < 2; ++n) acc[a][b][m][n] = (f32x4){0.f, 0.f, 0.f, 0.f};
    bf16x8 At[4][2], B0[2][2], B1[2][2];
    const char* cA = a_tile(g, cur.pm); const char* cB = (const char*)g.Bt + (size_t)cur.pn * tstep;
    S.a_ready(cur);
    if constexpr (SP2) {
        PG8_STAGE(PG8_SB(0, 0), cB, voffB); PG8_STAGE(PG8_SB(0, 1), cB + hstep, voffB); PG8_STAGE(PG8_SA(0, 0), cA, voffA); PG8_STAGE(PG8_SA(0, 1), cA + hstepA, voffA);
        if (wr == 1) PG8_BAR;
        PG8_WAIT_V(2); PG8_BAR;
        PG8_STAGE(PG8_SB(1, 0), cB + kstep, voffB); PG8_STAGE(PG8_SA(1, 0), cA + kstepA, voffA); PG8_STAGE(PG8_SB(1, 1), cB + hstep + kstep, voffB);
        PG8_WAIT_V(6); PG8_BAR;
    } else {
        PG8_STAGE(PG8_SB(0, 0), cB, voffB); PG8_STAGE(PG8_SA(0, 0), cA, voffA); PG8_STAGE(PG8_SB(0, 1), cB + hstep, voffB); PG8_STAGE(PG8_SA(0, 1), cA + hstepA, voffA);
        if (wr == 1) PG8_BAR;
        PG8_WAIT_V(4); PG8_BAR;
        PG8_STAGE(PG8_SB(1, 0), cB + kstep, voffB); PG8_STAGE(PG8_SA(1, 0), cA + kstepA, voffA); PG8_STAGE(PG8_SB(1, 1), cB + hstep + kstep, voffB);
        PG8_WAIT_V(6); PG8_BAR;
    }
    for (;;) {
        const bool has_next = S.next(ui + 1, nxt);
        const char* nA = has_next ? a_tile(g, nxt.pm) : cA; const char* nB = has_next ? (const char*)g.Bt + (size_t)nxt.pn * tstep : cB;
        for (int t = 0; t < nt; t += 2) {
            const bool last = (t == nt - 2);
            const char* a1 = cA + (size_t)(t + 1) * kstepA;
            const char* a2 = last ? nA : cA + (size_t)(t + 2) * kstepA; const char* b2 = last ? nB : cB + (size_t)(t + 2) * kstep;
            const char* a3 = a2 + kstepA; const char* b3 = b2 + kstep;
            if (last && has_next) S.a_ready(nxt);
            if constexpr (SP2) {
            PG8_LDB(B0, 0, 0); PG8_LDB(B1, 0, 1); PG8_SCHED; PG8_LDA(At, 0, 0); PG8_STAGE(PG8_SA(1, 1), a1 + hstepA, voffA);
            PG8_WAIT_V(8); PG8_WAIT_L(0); PG8_BAR; PG8_MMA(0, 0, At, B0); PG8_MMA(0, 1, At, B1); PG8_BAR; PG8_SCHED;
            PG8_LDA(At, 0, 1); PG8_STAGE(PG8_SB(0, 0), b2, voffB); PG8_STAGE(PG8_SB(0, 1), b2 + hstep, voffB); PG8_STAGE(PG8_SA(0, 0), a2, voffA);
            PG8_WAIT_V(8); PG8_WAIT_L(0); PG8_BAR; PG8_MMA(1, 0, At, B0); PG8_MMA(1, 1, At, B1); PG8_BAR; PG8_SCHED;
            PG8_LDB(B0, 1, 0); PG8_LDB(B1, 1, 1); PG8_SCHED; PG8_LDA(At, 1, 0); PG8_STAGE(PG8_SA(0, 1), a2 + hstepA, voffA);
            PG8_WAIT_V(8); PG8_WAIT_L(0); PG8_BAR; PG8_MMA(0, 0, At, B0); PG8_MMA(0, 1, At, B1); PG8_BAR; PG8_SCHED;
            PG8_LDA(At, 1, 1); PG8_STAGE(PG8_SB(1, 0), b3, voffB); PG8_STAGE(PG8_SB(1, 1), b3 + hstep, voffB); PG8_STAGE(PG8_SA(1, 0), a3, voffA);
            PG8_WAIT_V(8); PG8_WAIT_L(0); PG8_BAR; PG8_MMA(1, 0, At, B0); PG8_MMA(1, 1, At, B1); PG8_BAR; PG8_SCHED;
            } else {
            PG8_LDB(B0, 0, 0); PG8_SCHED; PG8_LDA(At, 0, 0); PG8_STAGE(PG8_SA(1, 1), a1 + hstepA, voffA);
            PG8_WAIT_L(8); PG8_BAR; PG8_WAIT_L(0); PG8_MMA(0, 0, At, B0); PG8_BAR; PG8_SCHED;
            PG8_LDB(B1, 0, 1); PG8_STAGE(PG8_SB(0, 0), b2, voffB);
            PG8_BAR; PG8_WAIT_L(0); PG8_MMA(0, 1, At, B1); PG8_BAR;
            PG8_LDA(At, 0, 1); PG8_STAGE(PG8_SA(0, 0), a2, voffA);
            PG8_BAR; PG8_WAIT_L(0); PG8_MMA(1, 0, At, B0); PG8_BAR; PG8_SCHED;
            PG8_STAGE(PG8_SB(0, 1), b2 + hstep, voffB);
            PG8_WAIT_V(6); PG8_BAR; PG8_MMA(1, 1, At, B1); PG8_BAR;
            PG8_LDB(B0, 1, 0); PG8_SCHED; PG8_LDA(At, 1, 0); PG8_STAGE(PG8_SA(0, 1), a2 + hstepA, voffA);
            PG8_WAIT_L(8); PG8_BAR; PG8_WAIT_L(0); PG8_MMA(0, 0, At, B0); PG8_BAR; PG8_SCHED;
            PG8_LDB(B1, 1, 1); PG8_STAGE(PG8_SB(1, 0), b3, voffB);
            PG8_BAR; PG8_WAIT_L(0); PG8_MMA(0, 1, At, B1); PG8_BAR;
            PG8_LDA(At, 1, 1); PG8_STAGE(PG8_SA(1, 0), a3, voffA);
            PG8_BAR; PG8_WAIT_L(0); PG8_MMA(1, 0, At, B0); PG8_BAR; PG8_SCHED;
            PG8_STAGE(PG8_SB(1, 1), b3 + hstep, voffB);
            PG8_WAIT_V(6); PG8_BAR; PG8_MMA(1, 1, At, B1); PG8_BAR;
            }
        }
        if constexpr (ALIGN_EPI) { if (wr == 0) PG8_BAR; }
        if constexpr (!Epi::AFTER_DRAIN) { E(acc, cur, wr, wc, fr, fq); S.done(cur); }
        if (!has_next) break;
#pragma unroll
        for (int a = 0; a < 2; ++a)
#pragma unroll
            for (int b = 0; b < 2; ++b)
#pragma unroll
                for (int m = 0; m < 4; ++m)
#pragma unroll
                    for (int n = 0; n < 2; ++n) acc[a][b][m][n] = (f32x4){0.f, 0.f, 0.f, 0.f};
        cur = nxt; cA = nA; cB = nB; ++ui;
        if constexpr (ALIGN_EPI) { if (wr == 1) PG8_BAR; }
    }
    PG8_WAIT_V(0);
    if constexpr (!ALIGN_EPI) { if (wr == 0) PG8_BAR; }
    PG8_BAR;
    if constexpr (Epi::AFTER_DRAIN) { E.fused(acc, cur, wr, wc, fr, fq, lds, wid, lane); S.done(cur); }
#undef PG8_SA
#undef PG8_SB
#undef PG8_STAGE
#undef PG8_LDA
#undef PG8_LDB
#undef PG8_MMA
#undef PG8_WAIT_V
#undef PG8_WAIT_L
#undef PG8_BAR
#undef PG8_SCHED
}
}

#define LAS __attribute__((address_space(3)))
typedef unsigned short bf16_t;
typedef short bf16x8 __attribute__((ext_vector_type(8)));
typedef float f32x4 __attribute__((ext_vector_type(4)));
typedef float f32x16 __attribute__((ext_vector_type(16)));
typedef float f32x8 __attribute__((ext_vector_type(8)));
typedef unsigned u32x4 __attribute__((ext_vector_type(4)));
typedef unsigned u32x2 __attribute__((ext_vector_type(2)));
typedef float f32x2_t __attribute__((ext_vector_type(2)));
typedef __bf16 bf16x2_t __attribute__((ext_vector_type(2)));

constexpr int NB = 4, SEQ = 4096, DM = 1024, MTOK = NB * SEQ, DIN = 7728, NPAD = 7936, DFF = 4096;
constexpr float QSCALE = 0.125f * 1.4426950408889634f;
constexpr float EPS = 1e-6f;
constexpr int NTHREADS = 512, NWAVES = 8;

constexpr size_t MiB = 1u << 20;
constexpr size_t WS_CTL = 0, CTL_BYTES = 65536;
constexpr int CW_BAR = 4096;
constexpr size_t WS_COS = 1 * MiB, WS_SIN = WS_COS + 4096 * 32 * 4, WS_CCOS = WS_SIN + 4096 * 32 * 4, WS_CSIN = WS_CCOS + 256 * 32 * 4;
constexpr size_t WS_PB = 3 * MiB;
constexpr size_t WS_W2T = 3 * MiB + 65536;
constexpr size_t WS_W1T = 4 * MiB;
constexpr size_t WS_WPD = 6 * MiB, WS_WPN = 8 * MiB, WS_WOUT = 10 * MiB, WS_WUP = 12 * MiB, WS_WDN = 20 * MiB, WS_WIN = 28 * MiB;
constexpr size_t WS_XN = 45 * MiB;
constexpr size_t WS_HID = WS_XN, WS_KCMP = WS_XN + 4 * MiB, WS_VCMPT = WS_XN + 5 * MiB, WS_MIXED = WS_XN;
constexpr size_t WS_DQ = 77 * MiB, WS_DK = 109 * MiB, WS_DVT = 141 * MiB, WS_NQ = 173 * MiB;
constexpr size_t WS_KC = 205 * MiB, WS_VC = 213 * MiB, WS_KSL = 221 * MiB, WS_KWN = 229 * MiB, WS_VSLT = 237 * MiB, WS_VWNT = 245 * MiB, WS_NG = 253 * MiB;
constexpr size_t WS_T1 = WS_DK;
constexpr size_t WS_XB1 = WS_KC;
constexpr size_t WS_PART = WS_NG;
constexpr size_t WS_HB = WS_DQ;
constexpr size_t WS_END = 256 * MiB;

constexpr int LDS_BYTES = 151552;
constexpr int TROW = 72;
constexpr int ABUF = 64 * TROW * 2 + 128 * TROW * 2;
constexpr int L_O0P = 83968;
constexpr int L_CK = 57344, CKROW = 72;
constexpr int L_CV = L_CK + 256 * CKROW * 2, CVROW = 264;
constexpr int L_IMP = L_CV + 64 * CVROW * 2;
constexpr int L_SEL = L_IMP + 16384;
constexpr int L_SLOT = 149504;
static_assert(L_SEL + 512 <= L_SLOT && L_O0P + 65536 <= L_SLOT && 3 * ABUF <= L_O0P && 3 * (128 * TROW * 2) <= L_CK, "lds map 2");
static_assert(L_SLOT + 64 <= LDS_BYTES, "lds map");

struct Params { const float* in[24]; float* out; unsigned char* ws; double invfreq[32]; int ph_lo, ph_hi, dup, pad; };

__device__ __forceinline__ unsigned cvtpk(float lo, float hi) { f32x2_t v = {lo, hi}; bf16x2_t b = __builtin_convertvector(v, bf16x2_t); return __builtin_bit_cast(unsigned, b); }
__device__ __forceinline__ bf16_t f2bf(float f) { return (bf16_t)(cvtpk(f, 0.f) & 0xffffu); }
__device__ __forceinline__ int crow(int r, int hi) { return (r & 3) + 8 * (r >> 2) + 4 * hi; }
__device__ __forceinline__ int perm16(int t) { return (t & ~12) | ((t & 4) << 1) | ((t & 8) >> 1); }
__device__ __forceinline__ float wave_sum(float v) {
#pragma unroll
    for (int o = 1; o < 64; o <<= 1) v += __shfl_xor(v, o);
    return v;
}
__device__ __forceinline__ float sigmoidf_(float v) { return __builtin_amdgcn_rcpf(1.0f + __expf(-v)); }
__device__ __forceinline__ float gelu_tanh(float x) { const float u = 0.7978845608028654f * (x + 0.044715f * x * x * x); return x * __builtin_amdgcn_rcpf(1.0f + __expf(-2.0f * u)); }

__device__ __forceinline__ void tr_item(const float* W, int ldw, int col0, int nvalid, const float* kscale, bf16_t* WT, int ldt, int row0, int k0, LAS float* scr, int lane) {
    const int cl = lane & 31;
#pragma unroll 8
    for (int i = 0; i < 32; ++i) { const int kk = 2 * i + (lane >> 5); float v = 0.f; if (cl < nvalid) { v = W[(size_t)(k0 + kk) * ldw + col0 + cl]; if (kscale) v *= kscale[k0 + kk]; } scr[kk * 33 + cl] = v; }
    asm volatile("s_waitcnt lgkmcnt(0)" ::: "memory");
    const int c = lane & 7;
#pragma unroll
    for (int j = 0; j < 4; ++j) { const int n = (lane >> 3) + 8 * j; const LAS float* s = scr + (8 * c) * 33 + n;
        u32x4 o; o.x = cvtpk(s[0 * 33], s[1 * 33]); o.y = cvtpk(s[2 * 33], s[3 * 33]); o.z = cvtpk(s[4 * 33], s[5 * 33]); o.w = cvtpk(s[6 * 33], s[7 * 33]);
        *(u32x4*)(WT + (size_t)(row0 + n) * ldt + k0 + 8 * c) = o; }
    asm volatile("s_waitcnt lgkmcnt(0)" ::: "memory");
}
__device__ __forceinline__ void tr_plain(const float* W, int K, int N, const float* kscale, bf16_t* WT, LAS float* scr, int item, int lane) {
    const int nblk = N / 32, kb = item / nblk, nb = item % nblk;
    tr_item(W, N, 32 * nb, 32, kscale, WT, K, 32 * nb, 64 * kb, scr, lane);
}
__device__ __forceinline__ void sincos_d(double ang, float& s, float& c) {
    const double k = rint(ang * 0.15915494309189535);
    double r = fma(-k, 6.283185307179586, ang); r = fma(-k, 2.4492935982947064e-16, r);
    const double r2 = r * r; double ts = r, tc = 1.0, ss = r, cs = 1.0;
#pragma unroll
    for (int n = 1; n <= 14; ++n) { tc *= -r2 * (1.0 / ((2.0 * n - 1.0) * (2.0 * n))); cs += tc; ts *= -r2 * (1.0 / ((2.0 * n) * (2.0 * n + 1.0))); ss += ts; }
    s = (float)ss; c = (float)cs;
}

__device__ __forceinline__ void late_weight_item(const Params& P, LAS unsigned char* lds, int item) {
    const int tid = threadIdx.x, lane = tid & 63, wave = tid >> 6;
    LAS float* scr = (LAS float*)(lds + wave * 16384);
    unsigned char* ws = P.ws;
    int it = item * NWAVES + wave;
    if (it < 512) { tr_plain(P.in[18], 1024, 1024, nullptr, (bf16_t*)(ws + WS_WPD), scr, it, lane); return; } it -= 512;
    if (it < 512) { tr_plain(P.in[19], 1024, 1024, nullptr, (bf16_t*)(ws + WS_WPN), scr, it, lane); return; } it -= 512;
    if (it < 512) { tr_plain(P.in[20], 1024, 1024, nullptr, (bf16_t*)(ws + WS_WOUT), scr, it, lane); return; } it -= 512;
    if (it < 2048) { tr_plain(P.in[22], 1024, 4096, P.in[21], (bf16_t*)(ws + WS_WUP), scr, it, lane); return; } it -= 2048;
    tr_plain(P.in[23], 4096, 1024, nullptr, (bf16_t*)(ws + WS_WDN), scr, it, lane);
}
__device__ __forceinline__ void p0_prologue(const Params& P, LAS unsigned char* lds, int vb, int G) {
    const int tid = threadIdx.x, lane = tid & 63, wave = tid >> 6;
    LAS float* scr = (LAS float*)(lds + wave * 16384);
    const int gw = vb * NWAVES + wave, NGW = G * NWAVES;
    unsigned char* ws = P.ws;
    for (int it = gw; it < 16 * 248; it += NGW) {
        const int kb = it / 248, nb = it % 248, n0 = 32 * nb, pn = n0 >> 8, p = n0 & 255, bj = p >> 7, wc = (p >> 5) & 3, L0 = 64 * wc + 32 * bj;
        const int srcbase = pn < 22 ? 256 * pn : (pn < 30 ? 5680 + 256 * (pn - 22) : 5632), tv = pn < 30 ? 256 : 48;
        int nv = tv - L0; nv = nv < 0 ? 0 : (nv > 32 ? 32 : nv);
        tr_item(P.in[2], DIN, srcbase + L0, nv, nullptr, (bf16_t*)(ws + WS_WIN), 1024, n0, 64 * kb, scr, lane);
    }
    for (int it = gw; it < 32 * 8; it += NGW) tr_plain(P.in[14], 2048, 256, nullptr, (bf16_t*)(ws + WS_W1T), scr, it, lane);
    for (int it = gw; it < 32 * 8; it += NGW) tr_plain(P.in[16], 2048, 256, nullptr, (bf16_t*)(ws + WS_W1T) + 256 * 2048, scr, it, lane);
    for (int it = gw; it < 4 * 2; it += NGW) tr_plain(P.in[15], 256, 64, nullptr, (bf16_t*)(ws + WS_W2T), scr, it, lane);
    for (int it = gw; it < 4 * 2; it += NGW) tr_plain(P.in[17], 256, 64, nullptr, (bf16_t*)(ws + WS_W2T) + 64 * 256, scr, it, lane);
    for (int it = NGW - 1 - gw; it < 128; it += NGW) {
        const int which = it >> 6, kc = (it >> 2) & 15, j = 64 * (it & 3) + lane; const float* pos = P.in[which ? 13 : 12] + 128 * kc; const float* W1 = P.in[which ? 16 : 14] + (size_t)128 * kc * 256;
        float a0 = 0.f, a1 = 0.f, a2 = 0.f, a3 = 0.f;
#pragma unroll 4
        for (int k = 0; k < 128; k += 4) { a0 += pos[k] * W1[(size_t)k * 256 + j]; a1 += pos[k + 1] * W1[(size_t)(k + 1) * 256 + j]; a2 += pos[k + 2] * W1[(size_t)(k + 2) * 256 + j]; a3 += pos[k + 3] * W1[(size_t)(k + 3) * 256 + j]; }
        ((float*)(ws + WS_PB))[(which * 16 + kc) * 256 + j] = (a0 + a1) + (a2 + a3);
    }
    for (int idx = vb * NTHREADS + tid; idx < (4096 + 256) * 32; idx += G * NTHREADS) {
        const int i = idx & 31, p = idx >> 5; float s, c;
        if (p < 4096) { sincos_d((double)p * P.invfreq[i], s, c); ((float*)(ws + WS_COS))[p * 32 + i] = c; ((float*)(ws + WS_SIN))[p * 32 + i] = s; }
        else { const int n = p - 4096; sincos_d(((double)n * 16.0 + 15.5) * P.invfreq[i], s, c); ((float*)(ws + WS_CCOS))[n * 32 + i] = c; ((float*)(ws + WS_CSIN))[n * 32 + i] = s; }
    }
    const float* x = P.in[0]; const float* g = P.in[1]; bf16_t* XN = (bf16_t*)(ws + WS_XN);
    f32x4 gv[4];
#pragma unroll
    for (int j = 0; j < 4; ++j) gv[j] = ((const f32x4*)g)[lane + 64 * j];
    for (int m = gw; m < MTOK; m += NGW) {
        const f32x4* xr = (const f32x4*)(x + (size_t)m * DM) + lane; f32x4 v[4]; float s = 0.f;
#pragma unroll
        for (int j = 0; j < 4; ++j) { v[j] = xr[64 * j]; s += (v[j].x * v[j].x + v[j].y * v[j].y) + (v[j].z * v[j].z + v[j].w * v[j].w); }
        const float rstd = rsqrtf(wave_sum(s) * (1.f / DM) + EPS);
        u32x2* o8 = (u32x2*)(XN + (size_t)m * DM) + lane;
#pragma unroll
        for (int j = 0; j < 4; ++j) { const f32x4 y = v[j] * rstd * gv[j]; u32x2 w; w.x = cvtpk(y.x, y.y); w.y = cvtpk(y.z, y.w); o8[64 * j] = w; }
    }
}

struct EpiProj {
    static constexpr bool PERM = true, AFTER_DRAIN = false;
    unsigned char* ws; const float *gq, *gk, *gnq, *gnk;
    __device__ __forceinline__ void operator()(const f32x4 (&acc)[2][2][4][2], const pg8::Unit& u, int wr, int wc, int fr, int fq) const {
        const int pn = u.pn; const int row0 = u.pm * 256 + wr * 64 + fr;
        int type, ld = 1024, cb = 0; bf16_t* dst = nullptr; const float* gain = nullptr; float qs = 1.f;
        if (pn < 4) { type = 0; dst = (bf16_t*)(ws + WS_DQ); cb = 256 * pn; gain = gq; qs = QSCALE; }
        else if (pn < 8) { type = 0; dst = (bf16_t*)(ws + WS_DK); cb = 256 * (pn - 4); gain = gk; }
        else if (pn < 12) { type = 2; dst = (bf16_t*)(ws + WS_DVT); }
        else if (pn < 16) { type = 0; dst = (bf16_t*)(ws + WS_NQ); cb = 256 * (pn - 12); gain = gnq; qs = QSCALE; }
        else if (pn == 16) { type = 1; dst = (bf16_t*)(ws + WS_KC); ld = 256; }
        else if (pn == 17) { type = 1; dst = (bf16_t*)(ws + WS_VC); ld = 256; }
        else if (pn == 18) { type = 0; dst = (bf16_t*)(ws + WS_KSL); ld = 256; gain = gnk + 64; }
        else if (pn == 19) { type = 2; dst = (bf16_t*)(ws + WS_VSLT); }
        else if (pn == 20) { type = 0; dst = (bf16_t*)(ws + WS_KWN); ld = 256; gain = gnk + 128; }
        else if (pn == 21) { type = 2; dst = (bf16_t*)(ws + WS_VWNT); }
        else if (pn < 30) { type = 3; dst = (bf16_t*)P_MG(); ld = 2048; cb = 256 * (pn - 22); }
        else { type = 4; }
        const int lc = 64 * wc + 8 * fq;
        if (type == 0) {
            const float* COS = (const float*)(ws + WS_COS); const float* SIN = (const float*)(ws + WS_SIN);
            f32x4 g1[2], g2[2];
#pragma unroll
            for (int n = 0; n < 2; ++n) { g1[n] = *(const f32x4*)(gain + 8 * fq + 4 * n); g2[n] = *(const f32x4*)(gain + 32 + 8 * fq + 4 * n); }
#pragma unroll
            for (int ai = 0; ai < 2; ++ai)
#pragma unroll
                for (int m = 0; m < 4; ++m) {
                    const int row = row0 + ai * 128 + m * 16, pos = row & (SEQ - 1);
                    float ss = 0.f;
#pragma unroll
                    for (int bj = 0; bj < 2; ++bj)
#pragma unroll
                        for (int n = 0; n < 2; ++n) { const f32x4 v = acc[ai][bj][m][n]; ss += (v.x * v.x + v.y * v.y) + (v.z * v.z + v.w * v.w); }
                    ss += __shfl_xor(ss, 16); ss += __shfl_xor(ss, 32);
                    const float rstd = rsqrtf(ss * (1.f / 64.f) + EPS);
                    f32x4 o1[2], o2[2];
#pragma unroll
                    for (int n = 0; n < 2; ++n) {
                        const f32x4 c4 = *(const f32x4*)(COS + pos * 32 + 8 * fq + 4 * n), s4 = *(const f32x4*)(SIN + pos * 32 + 8 * fq + 4 * n);
                        const f32x4 x1 = acc[ai][0][m][n] * rstd * g1[n], x2 = acc[ai][1][m][n] * rstd * g2[n];
                        o1[n] = (x1 * c4 - x2 * s4) * qs; o2[n] = (x2 * c4 + x1 * s4) * qs;
                    }
                    bf16_t* rp = dst + (size_t)row * ld + cb + lc;
                    u32x4 w; w.x = cvtpk(o1[0].x, o1[0].y); w.y = cvtpk(o1[0].z, o1[0].w); w.z = cvtpk(o1[1].x, o1[1].y); w.w = cvtpk(o1[1].z, o1[1].w); *(u32x4*)rp = w;
                    w.x = cvtpk(o2[0].x, o2[0].y); w.y = cvtpk(o2[0].z, o2[0].w); w.z = cvtpk(o2[1].x, o2[1].y); w.w = cvtpk(o2[1].z, o2[1].w); *(u32x4*)(rp + 32) = w;
                }
        } else if (type == 1 || type == 3) {
#pragma unroll
            for (int ai = 0; ai < 2; ++ai)
#pragma unroll
                for (int m = 0; m < 4; ++m) {
                    const int row = row0 + ai * 128 + m * 16; bf16_t* rp = dst + (size_t)row * ld + cb + lc;
#pragma unroll
                    for (int bj = 0; bj < 2; ++bj) {
                        f32x4 a = acc[ai][bj][m][0], b = acc[ai][bj][m][1];
                        if (type == 3) { a.x = sigmoidf_(a.x); a.y = sigmoidf_(a.y); a.z = sigmoidf_(a.z); a.w = sigmoidf_(a.w); b.x = sigmoidf_(b.x); b.y = sigmoidf_(b.y); b.z = sigmoidf_(b.z); b.w = sigmoidf_(b.w); }
                        u32x4 w; w.x = cvtpk(a.x, a.y); w.y = cvtpk(a.z, a.w); w.z = cvtpk(b.x, b.y); w.w = cvtpk(b.z, b.w); *(u32x4*)(rp + 32 * bj) = w;
                    }
                }
        } else if (type == 2) {
            int nh, dv, vh, dbase;
            if (pn < 12) { nh = 8; dv = 128; vh = 2 * (pn - 8) + (wc >> 1); dbase = 64 * (wc & 1); } else { nh = 4; dv = 64; vh = wc; dbase = 0; }
#pragma unroll
            for (int ai = 0; ai < 2; ++ai)
#pragma unroll
                for (int m = 0; m < 4; ++m) {
                    const int row = row0 + ai * 128 + m * 16, b = row >> 12, t = row & (SEQ - 1);
                    bf16_t* bp = dst + ((size_t)(b * nh + vh) * dv + dbase + 8 * fq) * SEQ + perm16(t);
#pragma unroll
                    for (int bj = 0; bj < 2; ++bj)
#pragma unroll
                        for (int n = 0; n < 2; ++n) { const f32x4 v = acc[ai][bj][m][n]; bf16_t* q = bp + (size_t)(32 * bj + 4 * n) * SEQ;
                            q[0] = f2bf(v.x); q[SEQ] = f2bf(v.y); q[2 * SEQ] = f2bf(v.z); q[3 * SEQ] = f2bf(v.w); }
                }
        } else {
            float* NG = (float*)(ws + WS_NG);
            if (wc == 0) {
#pragma unroll
                for (int ai = 0; ai < 2; ++ai)
#pragma unroll
                    for (int m = 0; m < 4; ++m) {
                        const int row = row0 + ai * 128 + m * 16;
#pragma unroll
                        for (int bj = 0; bj < 2; ++bj)
#pragma unroll
                            for (int n = 0; n < 2; ++n) { const int L = 32 * bj + 8 * fq + 4 * n; if (L < 48) { const f32x4 v = acc[ai][bj][m][n];
                                f32x4 o; o.x = sigmoidf_(v.x); o.y = sigmoidf_(v.y); o.z = sigmoidf_(v.z); o.w = sigmoidf_(v.w); *(f32x4*)(NG + (size_t)row * 48 + L) = o; } }
                    }
            }
        }
    }
    unsigned char* mgp;
    __device__ __forceinline__ unsigned char* P_MG() const { return mgp; }
};
struct EpiHid {
    static constexpr bool PERM = true, AFTER_DRAIN = false;
    bf16_t* HID; const LAS float* pb;
    __device__ __forceinline__ void operator()(const f32x4 (&acc)[2][2][4][2], const pg8::Unit& u, int wr, int wc, int fr, int fq) const {
        const int row0 = u.pm * 256 + wr * 64 + fr, col0 = wc * 32 + 8 * fq;
#pragma unroll
        for (int ai = 0; ai < 2; ++ai)
#pragma unroll
            for (int m = 0; m < 4; ++m) { bf16_t* rp = HID + (size_t)(row0 + ai * 128 + m * 16) * 256 + col0;
#pragma unroll
                for (int bj = 0; bj < 2; ++bj) { const f32x4 b0 = *(const LAS f32x4*)(pb + col0 + 128 * bj), b1 = *(const LAS f32x4*)(pb + col0 + 128 * bj + 4);
                    const f32x4 a = acc[ai][bj][m][0] + b0, b = acc[ai][bj][m][1] + b1;
                    u32x4 w; w.x = cvtpk(gelu_tanh(a.x), gelu_tanh(a.y)); w.y = cvtpk(gelu_tanh(a.z), gelu_tanh(a.w)); w.z = cvtpk(gelu_tanh(b.x), gelu_tanh(b.y)); w.w = cvtpk(gelu_tanh(b.z), gelu_tanh(b.w));
                    *(u32x4*)(rp + 128 * bj) = w; asm volatile("" ::: "memory"); } }
    }
};
template <int MODE> struct EpiMerge {
    static constexpr bool PERM = false, AFTER_DRAIN = false;
    const bf16_t* MG; float* T1; bf16_t* MIXED;
    __device__ __forceinline__ void operator()(const f32x4 (&acc)[2][2][4][2], const pg8::Unit& u, int wr, int wc, int fr, int fq) const {
        const int row0 = u.pm * 256 + wr * 64 + fr, col0 = u.pn * 256 + wc * 32 + 4 * fq;
#pragma unroll
        for (int ai = 0; ai < 2; ++ai)
#pragma unroll
            for (int m = 0; m < 4; ++m) { const size_t row = row0 + ai * 128 + m * 16;
#pragma unroll
                for (int bj = 0; bj < 2; ++bj)
#pragma unroll
                    for (int n = 0; n < 2; ++n) { const int col = col0 + 128 * bj + 16 * n;
                        const u32x2 gw = *(const u32x2*)(MG + row * 2048 + MODE * 1024 + col);
                        f32x4 gt; gt.x = __uint_as_float(gw.x << 16); gt.y = __uint_as_float(gw.x & 0xffff0000u); gt.z = __uint_as_float(gw.y << 16); gt.w = __uint_as_float(gw.y & 0xffff0000u);
                        if (MODE == 0) { const f32x4 v = gt * acc[ai][bj][m][n]; u32x2 w; w.x = cvtpk(v.x, v.y); w.y = cvtpk(v.z, v.w); *(u32x2*)(MIXED + row * 1024 + col) = w; }
                        else { const u32x2 tw = *(const u32x2*)(MIXED + row * 1024 + col); f32x4 t1; t1.x = __uint_as_float(tw.x << 16); t1.y = __uint_as_float(tw.x & 0xffff0000u); t1.z = __uint_as_float(tw.y << 16); t1.w = __uint_as_float(tw.y & 0xffff0000u); const f32x4 v = t1 + gt * acc[ai][bj][m][n]; u32x2 w; w.x = cvtpk(v.x, v.y); w.y = cvtpk(v.z, v.w); *(u32x2*)(MIXED + row * 1024 + col) = w; }
                    } }
    }
};
struct EpiMerge2 {
    static constexpr bool PERM = false, AFTER_DRAIN = false;
    const bf16_t* MG; bf16_t* MIXED;
    template <int W> __device__ __forceinline__ void run(const f32x4 (&acc)[2][2][4][2], const pg8::Unit& u, int wr, int wc, int fr, int fq) const {
        const int row0 = (u.pm & 63) * 256 + wr * 64 + fr, col0 = (u.pn & 3) * 256 + wc * 32 + 4 * fq;
#pragma unroll
        for (int ai = 0; ai < 2; ++ai) {
            u32x2 gwv[4][2][2], twv[4][2][2];
#pragma unroll
            for (int m = 0; m < 4; ++m)
#pragma unroll
                for (int bj = 0; bj < 2; ++bj)
#pragma unroll
                    for (int n = 0; n < 2; ++n) { const size_t row = row0 + ai * 128 + m * 16; const int col = col0 + 128 * bj + 16 * n;
                        gwv[m][bj][n] = *(const u32x2*)(MG + row * 2048 + W * 1024 + col);
                        if (W) twv[m][bj][n] = *(const u32x2*)(MIXED + row * 1024 + col); }
            asm volatile("" ::: "memory");
#pragma unroll
            for (int m = 0; m < 4; ++m)
#pragma unroll
                for (int bj = 0; bj < 2; ++bj)
#pragma unroll
                    for (int n = 0; n < 2; ++n) { const size_t row = row0 + ai * 128 + m * 16; const int col = col0 + 128 * bj + 16 * n; const u32x2 gw = gwv[m][bj][n];
                        f32x4 gt; gt.x = __uint_as_float(gw.x << 16); gt.y = __uint_as_float(gw.x & 0xffff0000u); gt.z = __uint_as_float(gw.y << 16); gt.w = __uint_as_float(gw.y & 0xffff0000u);
                        f32x4 v = gt * acc[ai][bj][m][n];
                        if (W) { const u32x2 tw = twv[m][bj][n]; f32x4 t1; t1.x = __uint_as_float(tw.x << 16); t1.y = __uint_as_float(tw.x & 0xffff0000u); t1.z = __uint_as_float(tw.y << 16); t1.w = __uint_as_float(tw.y & 0xffff0000u); v = v + t1; }
                        u32x2 wv; wv.x = cvtpk(v.x, v.y); wv.y = cvtpk(v.z, v.w); *(u32x2*)(MIXED + row * 1024 + col) = wv; }
            asm volatile("" ::: "memory");
        }
    }
    __device__ __forceinline__ void operator()(const f32x4 (&acc)[2][2][4][2], const pg8::Unit& u, int wr, int wc, int fr, int fq) const {
        if ((u.pm >> 6) == 0) run<0>(acc, u, wr, wc, fr, fq); else run<1>(acc, u, wr, wc, fr, fq);
    }
};
struct TwoSched {
    pg8::StaticOrder S;
    __device__ __forceinline__ bool next(int i, pg8::Unit& u) const { pg8::Unit b; if (!S.next(i >> 1, b)) return false; const int w = i & 1; u.pm = b.pm + 64 * w; u.pn = b.pn + 4 * w; return true; }
    __device__ __forceinline__ void a_ready(const pg8::Unit&) const {}
    __device__ __forceinline__ void done(const pg8::Unit&) const {}
};
struct EpiRes1 {
    static constexpr bool PERM = false, AFTER_DRAIN = false;
    const float* x; float* out; bf16_t* XB1; float* PART;
    __device__ __forceinline__ void operator()(const f32x4 (&acc)[2][2][4][2], const pg8::Unit& u, int wr, int wc, int fr, int fq) const {
        const int row0 = u.pm * 256 + wr * 64 + fr, col0 = u.pn * 256 + wc * 32 + 4 * fq;
#pragma unroll
        for (int ai = 0; ai < 2; ++ai) {
            f32x4 xv[4][2][2];
#pragma unroll
            for (int m = 0; m < 4; ++m)
#pragma unroll
                for (int bj = 0; bj < 2; ++bj)
#pragma unroll
                    for (int n = 0; n < 2; ++n) xv[m][bj][n] = *(const f32x4*)(x + (size_t)(row0 + ai * 128 + m * 16) * 1024 + col0 + 128 * bj + 16 * n);
            asm volatile("" ::: "memory");
#pragma unroll
            for (int m = 0; m < 4; ++m) { const size_t row = row0 + ai * 128 + m * 16; float ss = 0.f;
#pragma unroll
                for (int bj = 0; bj < 2; ++bj)
#pragma unroll
                    for (int n = 0; n < 2; ++n) { const int col = col0 + 128 * bj + 16 * n;
                        const f32x4 v = xv[m][bj][n] + acc[ai][bj][m][n];
                        u32x2 w; w.x = cvtpk(v.x, v.y); w.y = cvtpk(v.z, v.w); *(u32x2*)(XB1 + row * 1024 + col) = w;
                        ss += (v.x * v.x + v.y * v.y) + (v.z * v.z + v.w * v.w); }
                ss += __shfl_xor(ss, 16); ss += __shfl_xor(ss, 32);
                if (fq == 0) PART[row * 16 + u.pn * 4 + wc] = ss; }
            asm volatile("" ::: "memory");
        }
    }
};
struct EpiUp {
    static constexpr bool PERM = true, AFTER_DRAIN = false;
    const float* PART; bf16_t* HB;
    __device__ __forceinline__ void operator()(const f32x4 (&acc)[2][2][4][2], const pg8::Unit& u, int wr, int wc, int fr, int fq) const {
        const int row0 = u.pm * 256 + wr * 64 + fr, col0 = u.pn * 256 + wc * 32 + 8 * fq;
#pragma unroll
        for (int ai = 0; ai < 2; ++ai)
#pragma unroll
            for (int m = 0; m < 4; ++m) { const size_t row = row0 + ai * 128 + m * 16;
                const f32x4* pp = (const f32x4*)(PART + row * 16); const f32x4 p0 = pp[0], p1 = pp[1], p2 = pp[2], p3 = pp[3];
                const float ss = ((p0.x + p0.y) + (p0.z + p0.w)) + ((p1.x + p1.y) + (p1.z + p1.w)) + ((p2.x + p2.y) + (p2.z + p2.w)) + ((p3.x + p3.y) + (p3.z + p3.w));
                const float rstd = rsqrtf(ss * (1.f / 1024.f) + EPS);
#pragma unroll
                for (int bj = 0; bj < 2; ++bj) { f32x4 a = acc[ai][bj][m][0] * rstd, b = acc[ai][bj][m][1] * rstd;
                    a.x = fmaxf(a.x, 0.f); a.y = fmaxf(a.y, 0.f); a.z = fmaxf(a.z, 0.f); a.w = fmaxf(a.w, 0.f); b.x = fmaxf(b.x, 0.f); b.y = fmaxf(b.y, 0.f); b.z = fmaxf(b.z, 0.f); b.w = fmaxf(b.w, 0.f);
                    a = a * a; b = b * b;
                    u32x4 w; w.x = cvtpk(a.x, a.y); w.y = cvtpk(a.z, a.w); w.z = cvtpk(b.x, b.y); w.w = cvtpk(b.z, b.w); *(u32x4*)(HB + row * 4096 + col0 + 128 * bj) = w; } }
    }
};
struct EpiRes2 {
    static constexpr bool PERM = false, AFTER_DRAIN = false;
    float* out; float scale; const bf16_t* XB1;
    __device__ __forceinline__ void operator()(const f32x4 (&acc)[2][2][4][2], const pg8::Unit& u, int wr, int wc, int fr, int fq) const {
        const int row0 = u.pm * 256 + wr * 64 + fr, col0 = u.pn * 256 + wc * 32 + 4 * fq;
#pragma unroll
        for (int ai = 0; ai < 2; ++ai) {
            u32x2 xw[4][2][2];
#pragma unroll
            for (int m = 0; m < 4; ++m)
#pragma unroll
                for (int bj = 0; bj < 2; ++bj)
#pragma unroll
                    for (int n = 0; n < 2; ++n) xw[m][bj][n] = *(const u32x2*)(XB1 + (size_t)(row0 + ai * 128 + m * 16) * 1024 + col0 + 128 * bj + 16 * n);
            asm volatile("" ::: "memory");
#pragma unroll
            for (int m = 0; m < 4; ++m)
#pragma unroll
                for (int bj = 0; bj < 2; ++bj)
#pragma unroll
                    for (int n = 0; n < 2; ++n) { const size_t off = (size_t)(row0 + ai * 128 + m * 16) * 1024 + col0 + 128 * bj + 16 * n; const u32x2 w = xw[m][bj][n];
                        f32x4 x1; x1.x = __uint_as_float(w.x << 16); x1.y = __uint_as_float(w.x & 0xffff0000u); x1.z = __uint_as_float(w.y << 16); x1.w = __uint_as_float(w.y & 0xffff0000u);
                        *(f32x4*)(out + off) = x1 + acc[ai][bj][m][n] * scale; }
            asm volatile("" ::: "memory");
        }
    }
};
struct OneUnit {
    int pm, pn;
    __device__ bool next(int i, pg8::Unit& u) const { if (i > 0) return false; u.pm = pm; u.pn = pn; return true; }
    __device__ __forceinline__ void a_ready(const pg8::Unit&) const {}
    __device__ __forceinline__ void done(const pg8::Unit&) const {}
};

#define MFMA32(a, b, c) __builtin_amdgcn_mfma_f32_32x32x16_bf16((a), (b), (c), 0, 0, 0)
#define EXP2(x) __builtin_amdgcn_exp2f(x)

__device__ __forceinline__ void load_q(const bf16_t* qrow, int hi, bf16x8 (&qf)[4]) {
#pragma unroll
    for (int ds = 0; ds < 4; ++ds) qf[ds] = *(const bf16x8*)(qrow + 16 * ds + 8 * hi);
    asm volatile("" : "+v"(qf[0]), "+v"(qf[1]), "+v"(qf[2]), "+v"(qf[3]));
}
template <int KROW>
__device__ __forceinline__ void qk_tile(const LAS bf16_t* Kt, const bf16x8 (&qf)[4], f32x16 (&s)[2], int r32, int hi) {
#pragma unroll
    for (int kb = 0; kb < 2; ++kb) {
        f32x16 a = {};
#pragma unroll
        for (int ds = 0; ds < 4; ++ds) { const bf16x8 kf = *(const LAS bf16x8*)(Kt + (32 * kb + r32) * KROW + 16 * ds + 8 * hi); a = MFMA32(kf, qf[ds], a); }
        s[kb] = a;
    }
}
template <int DV, int VROW>
__device__ __forceinline__ void pv_tile(const LAS bf16_t* Vt, const f32x16 (&p)[2], f32x16 (&o)[DV / 32], int r32, int hi) {
    bf16x8 pb[4];
#pragma unroll
    for (int j = 0; j < 4; ++j) { const int kb = j >> 1, r0 = 8 * (j & 1); u32x4 w; w.x = cvtpk(p[kb][r0], p[kb][r0 + 1]); w.y = cvtpk(p[kb][r0 + 2], p[kb][r0 + 3]); w.z = cvtpk(p[kb][r0 + 4], p[kb][r0 + 5]); w.w = cvtpk(p[kb][r0 + 6], p[kb][r0 + 7]); pb[j] = __builtin_bit_cast(bf16x8, w); }
#pragma unroll
    for (int db = 0; db < DV / 32; ++db) {
        bf16x8 vf[4];
#pragma unroll
        for (int j = 0; j < 4; ++j) vf[j] = *(const LAS bf16x8*)(Vt + (32 * db + r32) * VROW + 16 * j + 8 * hi);
#pragma unroll
        for (int j = 0; j < 4; ++j) o[db] = MFMA32(vf[j], pb[j], o[db]);
        __builtin_amdgcn_sched_barrier(0);
    }
}
template <int DV, class TF>
__device__ __forceinline__ void attn_loop(LAS unsigned char* lds, const bf16_t* Kg, int ldk, const bf16_t* VTg, int ldv, unsigned long long tmask,
                                          const bf16x8 (&qf)[4], f32x16 (&o)[DV / 32], float& m, float& l, const TF& tf) {
    const int tid = threadIdx.x, lane = tid & 63, r32 = lane & 31, hi = lane >> 5, srow = tid >> 3, sch = tid & 7;
    u32x4 kreg, vreg[DV / 64];
    int buf = 0;
    if (tmask) { const int t = __builtin_ctzll(tmask); kreg = *(const u32x4*)(Kg + (size_t)(64 * t + srow) * ldk + sch * 8);
#pragma unroll
        for (int i = 0; i < DV / 64; ++i) vreg[i] = *(const u32x4*)(VTg + (size_t)(srow + 64 * i) * ldv + 64 * t + sch * 8); }
    while (tmask) {
        const int t = __builtin_ctzll(tmask); tmask &= tmask - 1;
        LAS bf16_t* Kt = (LAS bf16_t*)(lds + buf * ABUF); LAS bf16_t* Vt = Kt + 64 * TROW;
        *(LAS u32x4*)(Kt + srow * TROW + sch * 8) = kreg;
#pragma unroll
        for (int i = 0; i < DV / 64; ++i) *(LAS u32x4*)(Vt + (srow + 64 * i) * TROW + sch * 8) = vreg[i];
        __syncthreads();
        if (tmask) { const int tn = __builtin_ctzll(tmask); kreg = *(const u32x4*)(Kg + (size_t)(64 * tn + srow) * ldk + sch * 8);
#pragma unroll
            for (int i = 0; i < DV / 64; ++i) vreg[i] = *(const u32x4*)(VTg + (size_t)(srow + 64 * i) * ldv + 64 * tn + sch * 8); }
        const int md = tf.mode(t);
        if (md) {
            f32x16 s[2];
            qk_tile<TROW>(Kt, qf, s, r32, hi);
            if (md == 2) {
                const int lim_hi = tf.lim_hi(t), lim_lo = tf.lim_lo(t);
#pragma unroll
                for (int kb = 0; kb < 2; ++kb)
#pragma unroll
                    for (int r = 0; r < 16; ++r) { const int kc_ = 32 * kb + (r & 3) + 8 * (r >> 2); if (kc_ > lim_hi || kc_ < lim_lo) s[kb][r] = -INFINITY; }
            }
            float mx = fmaxf(s[0][0], s[1][0]);
#pragma unroll
            for (int r = 1; r < 16; ++r) mx = fmaxf(mx, fmaxf(s[0][r], s[1][r]));
            mx = fmaxf(mx, __shfl_xor(mx, 32));
            const float mn = fmaxf(m, mx), alpha = EXP2(m - mn); m = mn;
            float rs = 0.f;
#pragma unroll
            for (int kb = 0; kb < 2; ++kb)
#pragma unroll
                for (int r = 0; r < 16; ++r) { const float e = EXP2(s[kb][r] - mn); s[kb][r] = e; rs += e; }
            l = l * alpha + rs;
            if (!__all(alpha == 1.0f)) {
#pragma unroll
                for (int db = 0; db < DV / 32; ++db) o[db] = o[db] * alpha;
            }
            pv_tile<DV, TROW>(Vt, s, o, r32, hi);
        }
        buf ^= 1;
    }
    __syncthreads();
}


template <int DV, bool LSEL, class TF>
__device__ __forceinline__ void attn_loop_fast(LAS unsigned char* lds, const bf16_t* Kg, int ldk, const bf16_t* VTg, int ldv, unsigned long long tmask,
                                               const bf16x8 (&qf)[4], f32x16 (&o)[DV / 32], f32x4& lsum, const TF& tf) {
    constexpr int ABF = (64 + DV) * TROW * 2;
    const int tid = threadIdx.x, lane = tid & 63, r32 = lane & 31, hi = lane >> 5, srow = tid >> 3, sch = tid & 7;
    if (!tmask) return;
    u32x4 kreg, vreg[DV / 64];
#define AF_LOAD(t) do { kreg = *(const u32x4*)(Kg + (size_t)(64 * (t) + srow) * ldk + sch * 8); _Pragma("unroll") for (int i_ = 0; i_ < DV / 64; ++i_) vreg[i_] = *(const u32x4*)(VTg + (size_t)(srow + 64 * i_) * ldv + 64 * (t) + sch * 8); } while (0)
#define AF_STORE(b) do { LAS bf16_t* Kt_ = (LAS bf16_t*)(lds + (b) * ABF); *(LAS u32x4*)(Kt_ + srow * TROW + sch * 8) = kreg; _Pragma("unroll") for (int i_ = 0; i_ < DV / 64; ++i_) *(LAS u32x4*)(Kt_ + 64 * TROW + (srow + 64 * i_) * TROW + sch * 8) = vreg[i_]; } while (0)
    int tc = __builtin_ctzll(tmask); tmask &= tmask - 1;
    AF_LOAD(tc); AF_STORE(0);
    int tn = -1; if (tmask) { tn = __builtin_ctzll(tmask); tmask &= tmask - 1; AF_LOAD(tn); }
    __syncthreads();
    f32x16 sA[2], sB[2];
    int bc = 0;
    if (tf.mode(tc)) qk_tile<TROW>((const LAS bf16_t*)(lds), qf, sA, r32, hi);
#define AF_STEP(scur, snxt) do { \
        const int bn = (bc == 2) ? 0 : bc + 1; \
        if (tn >= 0) AF_STORE(bn); \
        __syncthreads(); \
        int tnn = -1; if (tmask) { tnn = __builtin_ctzll(tmask); tmask &= tmask - 1; AF_LOAD(tnn); } \
        if (tn >= 0 && tf.mode(tn)) qk_tile<TROW>((const LAS bf16_t*)(lds + bn * ABF), qf, snxt, r32, hi); \
        const int md = tf.mode(tc); \
        if (md) { \
            _Pragma("unroll") for (int kb = 0; kb < 2; ++kb) _Pragma("unroll") for (int r = 0; r < 16; ++r) scur[kb][r] = EXP2(scur[kb][r]); \
            if (md == 2) { const int lim_hi = tf.lim_hi(tc), lim_lo = tf.lim_lo(tc); _Pragma("unroll") for (int kb = 0; kb < 2; ++kb) _Pragma("unroll") for (int r = 0; r < 16; ++r) { const int kc_ = 32 * kb + (r & 3) + 8 * (r >> 2); if (kc_ > lim_hi || kc_ < lim_lo) scur[kb][r] = 0.f; } } \
            bf16x8 pb[4]; \
            if constexpr (LSEL) { const bool sel = tf.lanesel(tc); const float sm = sel ? 1.f : 0.f; const unsigned am = sel ? 0xffffffffu : 0u; { const f32x16 t16_ = scur[0] + scur[1]; const f32x8 t8_ = t16_.lo + t16_.hi; lsum = lsum + (t8_.lo + t8_.hi) * sm; } \
                _Pragma("unroll") for (int j = 0; j < 4; ++j) { const int kb = j >> 1, r0 = 8 * (j & 1); u32x4 w; w.x = cvtpk(scur[kb][r0], scur[kb][r0 + 1]) & am; w.y = cvtpk(scur[kb][r0 + 2], scur[kb][r0 + 3]) & am; w.z = cvtpk(scur[kb][r0 + 4], scur[kb][r0 + 5]) & am; w.w = cvtpk(scur[kb][r0 + 6], scur[kb][r0 + 7]) & am; pb[j] = __builtin_bit_cast(bf16x8, w); } \
            } else { { const f32x16 t16_ = scur[0] + scur[1]; const f32x8 t8_ = t16_.lo + t16_.hi; lsum = lsum + (t8_.lo + t8_.hi); } \
                _Pragma("unroll") for (int j = 0; j < 4; ++j) { const int kb = j >> 1, r0 = 8 * (j & 1); u32x4 w; w.x = cvtpk(scur[kb][r0], scur[kb][r0 + 1]); w.y = cvtpk(scur[kb][r0 + 2], scur[kb][r0 + 3]); w.z = cvtpk(scur[kb][r0 + 4], scur[kb][r0 + 5]); w.w = cvtpk(scur[kb][r0 + 6], scur[kb][r0 + 7]); pb[j] = __builtin_bit_cast(bf16x8, w); } } \
            const LAS bf16_t* Vt_ = (const LAS bf16_t*)(lds + bc * ABF) + 64 * TROW; \
            _Pragma("unroll") for (int db = 0; db < DV / 32; ++db) { bf16x8 vf[4]; \
                _Pragma("unroll") for (int j = 0; j < 4; ++j) vf[j] = *(const LAS bf16x8*)(Vt_ + (32 * db + r32) * TROW + 16 * j + 8 * hi); \
                _Pragma("unroll") for (int j = 0; j < 4; ++j) o[db] = MFMA32(vf[j], pb[j], o[db]); } \
        } \
        tc = tn; tn = tnn; bc = bn; \
    } while (0)
    for (;;) {
        AF_STEP(sA, sB); if (tc < 0) break;
        AF_STEP(sB, sA); if (tc < 0) break;
    }
    __syncthreads();
#undef AF_LOAD
#undef AF_STORE
#undef AF_STEP
}
__device__ __forceinline__ float hsum4(const f32x4& v) { return (v[0] + v[1]) + (v[2] + v[3]); }

struct DiffTF { int qlo, qpos, hi4; __device__ __forceinline__ int mode(int t) const { return 64 * t > qlo + 31 ? 0 : (64 * t + 63 > qlo ? 2 : 1); }
    __device__ __forceinline__ int lim_hi(int t) const { return qpos - 64 * t - hi4; } __device__ __forceinline__ int lim_lo(int t) const { return -(1 << 30); } };
template <bool FAST>
__device__ __forceinline__ void diff_unit(const Params& P, LAS unsigned char* lds, int b, int h, int qb, float lam, bool dry) {
    const int tid = threadIdx.x, lane = tid & 63, wave = tid >> 6, r32 = lane & 31, hi = lane >> 5;
    unsigned char* ws = P.ws;
    const int q0 = qb * 256, qpos = q0 + 32 * wave + r32;
    bf16_t* DQ = (bf16_t*)(ws + WS_DQ); const bf16_t* DK = (const bf16_t*)(ws + WS_DK); const bf16_t* DVT = (const bf16_t*)(ws + WS_DVT);
    bf16_t* qrow = DQ + (size_t)(b * SEQ + qpos) * 1024 + h * 128;
    const unsigned long long tmask = (qb == 15) ? ~0ull : ((1ull << (4 * qb + 4)) - 1ull);
    DiffTF tf; tf.qlo = q0 + 32 * wave; tf.qpos = qpos; tf.hi4 = 4 * hi;
    LAS unsigned* o0p = (LAS unsigned*)(lds + L_O0P) + wave * 32 * 64 + lane;
    f32x16 o0[4];
#pragma unroll
    for (int c = 0; c < 2; ++c) {
        bf16x8 qf[4]; load_q(qrow + 64 * c, hi, qf);
        f32x16 o[4];
#pragma unroll
        for (int db = 0; db < 4; ++db) o[db] = (f32x16){};
        float m = -1e30f, l = 0.f;
        if (FAST) { f32x4 ls = {}; attn_loop_fast<128, false, DiffTF>(lds, DK + (size_t)b * SEQ * 1024 + (h * 2 + c) * 64, 1024, DVT + (size_t)((b * 8 + h) * 128) * SEQ, SEQ, tmask, qf, o, ls, tf); l = hsum4(ls); }
        else attn_loop<128, DiffTF>(lds, DK + (size_t)b * SEQ * 1024 + (h * 2 + c) * 64, 1024, DVT + (size_t)((b * 8 + h) * 128) * SEQ, SEQ, tmask, qf, o, m, l, tf);
        l += __shfl_xor(l, 32);
        const float inv = 1.0f / fmaxf(l, 1e-30f);
        if (c == 0) {
#pragma unroll
            for (int db = 0; db < 4; ++db)
#pragma unroll
                for (int r = 0; r < 8; ++r) o0p[(db * 8 + r) * 64] = cvtpk(o[db][2 * r] * inv, o[db][2 * r + 1] * inv);
        } else {
            const float il = inv * lam;
#pragma unroll
            for (int db = 0; db < 4; ++db)
#pragma unroll
                for (int r = 0; r < 8; ++r) { const unsigned pw = o0p[(db * 8 + r) * 64]; o0[db][2 * r] = __uint_as_float(pw << 16) - o[db][2 * r] * il; o0[db][2 * r + 1] = __uint_as_float(pw & 0xffff0000u) - o[db][2 * r + 1] * il; }
        }
    }
    float ss = 0.f;
#pragma unroll
    for (int db = 0; db < 4; ++db)
#pragma unroll
        for (int r = 0; r < 16; ++r) ss += o0[db][r] * o0[db][r];
    ss += __shfl_xor(ss, 32);
    const float rstd = rsqrtf(ss * (1.f / 128.f) + EPS) * 0.8f;
    const float* sg = P.in[9];
#pragma unroll
    for (int db = 0; db < 4; ++db)
#pragma unroll
        for (int u = 0; u < 4; ++u) { const int d = 32 * db + 8 * u + 4 * hi; const f32x4 g4 = *(const f32x4*)(sg + d);
            u32x2 w; w.x = cvtpk(o0[db][4 * u] * rstd * g4.x, o0[db][4 * u + 1] * rstd * g4.y); w.y = cvtpk(o0[db][4 * u + 2] * rstd * g4.z, o0[db][4 * u + 3] * rstd * g4.w);
            if (!dry) *(u32x2*)(qrow + d) = w; }
}

__device__ __forceinline__ void compress_unit(const Params& P, LAS unsigned char* lds, int which, int pm) {
    unsigned char* ws = P.ws;
    bf16_t* HID = (bf16_t*)(ws + WS_HID) + (size_t)which * 4096 * 256;
    {
        pg8::Gemm g = pg8::make_gemm((const bf16_t*)(ws + (which ? WS_VC : WS_KC)), (const bf16_t*)(ws + WS_W1T) + (size_t)which * 256 * 2048, 4096, 256, 2048);
        g.lda = 4096; g.kstepA = 512; g.a_sh = 2; g.a_lo = (size_t)256 * 4096 * 2; g.a_hi = 128;
        LAS float* pbs = (LAS float*)(lds + 131072);
        if (threadIdx.x < 256) { const float* pp = (const float*)(ws + WS_PB) + which * 16 * 256 + threadIdx.x; float sacc = 0.f;
#pragma unroll
            for (int kc = 0; kc < 16; ++kc) sacc += pp[kc * 256];
            pbs[threadIdx.x] = sacc; }
        __syncthreads();
        OneUnit S{pm, 0}; EpiHid E{HID, pbs};
        pg8::gemm_phase<EpiHid, OneUnit, false, true>((PG8_LAS unsigned char*)lds, g, S, E);
    }
    __threadfence(); __syncthreads(); __threadfence();
    int tid = threadIdx.x; asm volatile("" : "+v"(tid));
    const int lane = tid & 63, wave = tid >> 6, r32 = lane & 31, hi = lane >> 5;
    const bf16_t* W2T = (const bf16_t*)(ws + WS_W2T) + which * 64 * 256;
    const int rowl = 32 * wave + r32; const bf16_t* hrow = HID + (size_t)(pm * 256 + rowl) * 256;
    f32x16 c0 = {}, c1 = {};
#pragma unroll 2
    for (int ks = 0; ks < 16; ++ks) {
        const bf16x8 a0 = *(const bf16x8*)(W2T + r32 * 256 + 16 * ks + 8 * hi), a1 = *(const bf16x8*)(W2T + (32 + r32) * 256 + 16 * ks + 8 * hi), bf = *(const bf16x8*)(hrow + 16 * ks + 8 * hi);
        c0 = MFMA32(a0, bf, c0); c1 = MFMA32(a1, bf, c1);
    }
    const int g = pm >> 2, b = pm & 3, n = rowl;
    if (which == 0) {
        float ss = 0.f;
#pragma unroll
        for (int r = 0; r < 16; ++r) ss += c0[r] * c0[r] + c1[r] * c1[r];
        ss += __shfl_xor(ss, 32);
        const float rstd = (n < 255) ? rsqrtf(ss * (1.f / 64.f) + EPS) : 0.f;
        const float* gk = P.in[11]; const float* CC = (const float*)(ws + WS_CCOS) + n * 32; const float* CS = (const float*)(ws + WS_CSIN) + n * 32;
        bf16_t* kr = (bf16_t*)(ws + WS_KCMP) + (size_t)((b * 4 + g) * 256 + n) * 64;
#pragma unroll
        for (int u = 0; u < 4; ++u) { const int i = 8 * u + 4 * hi; const f32x4 g1 = *(const f32x4*)(gk + i), g2 = *(const f32x4*)(gk + 32 + i), cc = *(const f32x4*)(CC + i), sn = *(const f32x4*)(CS + i);
            float o1[4], o2[4];
#pragma unroll
            for (int j = 0; j < 4; ++j) { const float x1 = c0[4 * u + j] * rstd * g1[j], x2 = c1[4 * u + j] * rstd * g2[j]; o1[j] = x1 * cc[j] - x2 * sn[j]; o2[j] = x2 * cc[j] + x1 * sn[j]; }
            u32x2 w; w.x = cvtpk(o1[0], o1[1]); w.y = cvtpk(o1[2], o1[3]); *(u32x2*)(kr + i) = w; w.x = cvtpk(o2[0], o2[1]); w.y = cvtpk(o2[2], o2[3]); *(u32x2*)(kr + 32 + i) = w; }
    } else {
        bf16_t* vt = (bf16_t*)(ws + WS_VCMPT) + (size_t)((b * 4 + g) * 64) * 256 + perm16(n);
        const float z = (n < 255) ? 1.f : 0.f;
#pragma unroll
        for (int r = 0; r < 16; ++r) { const int d = crow(r, hi); vt[(size_t)d * 256] = f2bf(c0[r] * z); vt[(size_t)(d + 32) * 256] = f2bf(c1[r] * z); }
    }
}

struct SlcTF { unsigned long long mymask, wu; int qpos, hi4; __device__ __forceinline__ int mode(int t) const { return ((wu >> t) & 1ull) ? 2 : 0; }
    __device__ __forceinline__ int lim_hi(int t) const { return ((mymask >> t) & 1ull) ? qpos - 64 * t - hi4 : -(1 << 30); } __device__ __forceinline__ int lim_lo(int t) const { return -(1 << 30); } };
struct SlcTFF { unsigned long long mymask, wu; int qpos, c, hi4; __device__ __forceinline__ int mode(int t) const { return ((wu >> t) & 1ull) ? (t == c ? 2 : 1) : 0; }
    __device__ __forceinline__ bool lanesel(int t) const { return (mymask >> t) & 1ull; }
    __device__ __forceinline__ int lim_hi(int t) const { return qpos - 64 * t - hi4; } __device__ __forceinline__ int lim_lo(int t) const { return -(1 << 30); } };
struct WinTF { int c, qpos, hi4; __device__ __forceinline__ int mode(int t) const { return (t == c || t == c - 8) ? 2 : 1; }
    __device__ __forceinline__ int lim_hi(int t) const { return qpos - 64 * t - hi4; } __device__ __forceinline__ int lim_lo(int t) const { return qpos - 511 - 64 * t - hi4; } };
template <bool FAST>
__device__ __forceinline__ void nsa_unit(const Params& P, LAS unsigned char* lds, int b, int g, int c, bool dry) {
    const int tid = threadIdx.x, lane = tid & 63, wave = tid >> 6, r32 = lane & 31, hi = lane >> 5;
    unsigned char* ws = P.ws;
    const int q0 = 64 * c, tk = r32 >> 2, hg = r32 & 3, tokl = 8 * wave + tk, qpos = q0 + tokl;
    bf16_t* qrow = (bf16_t*)(ws + WS_NQ) + (size_t)(b * SEQ + qpos) * 1024 + (g * 4 + hg) * 64;
    bf16x8 qf[4]; load_q(qrow, hi, qf);
    const float* ngp = (const float*)(ws + WS_NG) + (size_t)(b * SEQ + qpos) * 48 + (g * 4 + hg) * 3;
    const float gate0 = ngp[0], gate1 = ngp[1], gate2 = ngp[2];
    f32x16 yt[2]; yt[0] = (f32x16){}; yt[1] = (f32x16){};
    const int ntl = (4 * c + 2) / 64 + 1;
    LAS bf16_t* CK = (LAS bf16_t*)(lds + L_CK); LAS bf16_t* CV = (LAS bf16_t*)(lds + L_CV);
    LAS float* IMP = (LAS float*)(lds + L_IMP); LAS unsigned long long* SEL = (LAS unsigned long long*)(lds + L_SEL);
    {
        const bf16_t* kc = (const bf16_t*)(ws + WS_KCMP) + (size_t)((b * 4 + g) * 256) * 64; const bf16_t* vc = (const bf16_t*)(ws + WS_VCMPT) + (size_t)((b * 4 + g) * 64) * 256;
        u32x4 kr[4], vr[4]; const int srow = tid >> 3, sch = tid & 7;
#pragma unroll
        for (int it = 0; it < 4; ++it) if (it < ntl) { kr[it] = *(const u32x4*)(kc + (64 * it + srow) * 64 + sch * 8); vr[it] = *(const u32x4*)(vc + srow * 256 + (sch + 8 * it) * 8); }
#pragma unroll
        for (int it = 0; it < 4; ++it) if (it < ntl) { *(LAS u32x4*)(CK + (64 * it + srow) * CKROW + sch * 8) = kr[it]; *(LAS u32x4*)(CV + srow * CVROW + (sch + 8 * it) * 8) = vr[it]; }
    }
    __syncthreads();
    if constexpr (FAST) {
        const int nlim = ((qpos - 31) >> 4) - 4 * hi;
        f32x16 o[2]; o[0] = (f32x16){}; o[1] = (f32x16){};
        float lrow = 0.f, carry = 0.f; float ivq[4][8];
#pragma unroll
        for (int T = 0; T < 4; ++T) {
#pragma unroll
            for (int i = 0; i < 8; ++i) ivq[T][i] = 0.f;
            if (T < ntl) {
                f32x16 s[2]; qk_tile<CKROW>(CK + T * 64 * CKROW, qf, s, r32, hi);
#pragma unroll
                for (int kb = 0; kb < 2; ++kb)
#pragma unroll
                    for (int r = 0; r < 16; ++r) { const int kc_ = 32 * kb + (r & 3) + 8 * (r >> 2); const float e = EXP2(s[kb][r]); s[kb][r] = (kc_ > nlim - 64 * T) ? 0.f : e; }
#pragma unroll
                for (int kb = 0; kb < 2; ++kb)
#pragma unroll
                    for (int u = 0; u < 4; ++u) {
                        const float qs = (s[kb][4 * u] + s[kb][4 * u + 1]) + (s[kb][4 * u + 2] + s[kb][4 * u + 3]);
                        lrow += qs;
                        const float x = __shfl_xor(s[kb][4 * u + 3], 32);
                        ivq[T][kb * 4 + u] = qs + (hi ? x : carry); carry = x;
                    }
                pv_tile<64, CVROW>(CV + 64 * T, s, o, r32, hi);
            }
        }
        lrow += __shfl_xor(lrow, 32);
        const float invl = 1.0f / fmaxf(lrow, 1e-30f);
#pragma unroll
        for (int T = 0; T < 4; ++T)
            if (T < ntl) {
#pragma unroll
                for (int i = 0; i < 8; ++i) { float iv = ivq[T][i] * invl; iv += __shfl_xor(iv, 1); iv += __shfl_xor(iv, 2); if (hg == 0) IMP[tokl * 64 + 16 * T + 2 * i + hi] = iv; }
            }
        const float gs = gate0 * invl;
#pragma unroll
        for (int db = 0; db < 2; ++db) yt[db] = o[db] * gs;
    } else {
        const int nlim = ((qpos - 31) >> 4) - 4 * hi;
        float m = -1e30f, l = 0.f;
        for (int T = 0; T < ntl; ++T) {
            f32x16 s[2]; qk_tile<CKROW>(CK + T * 64 * CKROW, qf, s, r32, hi);
            float mx = -INFINITY;
#pragma unroll
            for (int kb = 0; kb < 2; ++kb)
#pragma unroll
                for (int r = 0; r < 16; ++r) { const int kc_ = 32 * kb + (r & 3) + 8 * (r >> 2); if (kc_ > nlim - 64 * T) s[kb][r] = -INFINITY; mx = fmaxf(mx, s[kb][r]); }
            mx = fmaxf(mx, __shfl_xor(mx, 32));
            const float mn = fmaxf(m, mx), alpha = EXP2(m - mn); m = mn; float rs = 0.f;
#pragma unroll
            for (int kb = 0; kb < 2; ++kb)
#pragma unroll
                for (int r = 0; r < 16; ++r) rs += EXP2(s[kb][r] - mn);
            l = l * alpha + rs;
        }
        l += __shfl_xor(l, 32);
        const float invl = 1.0f / fmaxf(l, 1e-30f);
        f32x16 o[2]; o[0] = (f32x16){}; o[1] = (f32x16){};
        float carry = 0.f;
        for (int T = 0; T < ntl; ++T) {
            f32x16 s[2]; qk_tile<CKROW>(CK + T * 64 * CKROW, qf, s, r32, hi);
#pragma unroll
            for (int kb = 0; kb < 2; ++kb)
#pragma unroll
                for (int r = 0; r < 16; ++r) { const int kc_ = 32 * kb + (r & 3) + 8 * (r >> 2); s[kb][r] = (kc_ > nlim - 64 * T) ? 0.f : EXP2(s[kb][r] - m) * invl; }
#pragma unroll
            for (int kb = 0; kb < 2; ++kb)
#pragma unroll
                for (int u = 0; u < 4; ++u) {
                    const float qs = (s[kb][4 * u] + s[kb][4 * u + 1]) + (s[kb][4 * u + 2] + s[kb][4 * u + 3]);
                    const float x = __shfl_xor(s[kb][4 * u + 3], 32);
                    float iv = qs + (hi ? x : carry); carry = x;
                    iv += __shfl_xor(iv, 1); iv += __shfl_xor(iv, 2);
                    if (hg == 0) IMP[tokl * 64 + 16 * T + 8 * kb + 2 * u + hi] = iv;
                }
            pv_tile<64, CVROW>(CV + 64 * T, s, o, r32, hi);
        }
#pragma unroll
        for (int db = 0; db < 2; ++db) yt[db] = o[db] * gate0;
    }
    __syncthreads();
    LAS float* yst = (LAS float*)(lds + L_CK) + tid;
#pragma unroll
    for (int db = 0; db < 2; ++db)
#pragma unroll
        for (int r = 0; r < 16; ++r) yst[(db * 16 + r) * NTHREADS] = yt[db][r];
    for (int i = 0; i < 8; ++i) {
        const int tl = 8 * wave + i; const int j = lane;
        const bool forced = (j == 0) || (j == c) || (j == c - 1);
        const float v = forced ? 1e4f : IMP[tl * 64 + j];
        const bool okj = (j <= c);
        const unsigned key = okj ? (__float_as_uint(v) + 1u) : 0u;
        unsigned thr = 0u;
        for (int bit = 31; bit >= 0; --bit) { const unsigned cand = thr | (1u << bit); if (__popcll(__ballot(key >= cand)) >= 16) thr = cand; }
        const unsigned long long gtm = __ballot(key > thr), eqm = __ballot(key == thr);
        const int need = 16 - __popcll(gtm);
        const bool selj = (key > thr) || (key == thr && __popcll(eqm & ((1ull << j) - 1ull)) < need);
        const unsigned long long msk = __ballot(selj && okj);
        if (lane == 0) SEL[tl] = msk;
    }
    __syncthreads();
    unsigned long long mymask = SEL[tokl], wu = 0ull;
#pragma unroll
    for (int i = 0; i < 8; ++i) wu |= SEL[8 * wave + i];
    {
        SlcTF tf; tf.mymask = mymask; tf.wu = wu; tf.qpos = qpos; tf.hi4 = 4 * hi;
        const unsigned long long tmask = (c == 63) ? ~0ull : ((1ull << (c + 1)) - 1ull);
        f32x16 o[2]; o[0] = (f32x16){}; o[1] = (f32x16){}; float m = -1e30f, l = 0.f;
        if (FAST) { SlcTFF tff; tff.mymask = mymask; tff.wu = wu; tff.qpos = qpos; tff.c = c; tff.hi4 = 4 * hi; f32x4 ls = {};
            attn_loop_fast<64, true, SlcTFF>(lds, (const bf16_t*)(ws + WS_KSL) + (size_t)b * SEQ * 256 + g * 64, 256, (const bf16_t*)(ws + WS_VSLT) + (size_t)((b * 4 + g) * 64) * SEQ, SEQ, tmask, qf, o, ls, tff); l = hsum4(ls); }
        else attn_loop<64, SlcTF>(lds, (const bf16_t*)(ws + WS_KSL) + (size_t)b * SEQ * 256 + g * 64, 256, (const bf16_t*)(ws + WS_VSLT) + (size_t)((b * 4 + g) * 64) * SEQ, SEQ, tmask, qf, o, m, l, tf);
        l += __shfl_xor(l, 32); const float sc = gate1 / fmaxf(l, 1e-30f);
#pragma unroll
        for (int db = 0; db < 2; ++db)
#pragma unroll
            for (int r = 0; r < 16; ++r) yst[(db * 16 + r) * NTHREADS] += o[db][r] * sc;
    }
    {
        WinTF tf; tf.c = c; tf.qpos = qpos; tf.hi4 = 4 * hi;
        const int tlo = c >= 8 ? c - 8 : 0;
        const unsigned long long hi_m = (c == 63) ? ~0ull : ((1ull << (c + 1)) - 1ull), tmask = hi_m & ~((1ull << tlo) - 1ull);
        f32x16 o[2]; o[0] = (f32x16){}; o[1] = (f32x16){}; float m = -1e30f, l = 0.f;
        if (FAST) { f32x4 ls = {}; attn_loop_fast<64, false, WinTF>(lds, (const bf16_t*)(ws + WS_KWN) + (size_t)b * SEQ * 256 + g * 64, 256, (const bf16_t*)(ws + WS_VWNT) + (size_t)((b * 4 + g) * 64) * SEQ, SEQ, tmask, qf, o, ls, tf); l = hsum4(ls); }
        else attn_loop<64, WinTF>(lds, (const bf16_t*)(ws + WS_KWN) + (size_t)b * SEQ * 256 + g * 64, 256, (const bf16_t*)(ws + WS_VWNT) + (size_t)((b * 4 + g) * 64) * SEQ, SEQ, tmask, qf, o, m, l, tf);
        l += __shfl_xor(l, 32); const float sc = gate2 / fmaxf(l, 1e-30f);
#pragma unroll
        for (int db = 0; db < 2; ++db)
#pragma unroll
            for (int r = 0; r < 16; ++r) yt[db][r] = yst[(db * 16 + r) * NTHREADS] + o[db][r] * sc;
    }
#pragma unroll
    for (int db = 0; db < 2; ++db)
#pragma unroll
        for (int u = 0; u < 4; ++u) { const int d = 32 * db + 8 * u + 4 * hi; u32x2 w; w.x = cvtpk(yt[db][4 * u], yt[db][4 * u + 1]); w.y = cvtpk(yt[db][4 * u + 2], yt[db][4 * u + 3]); if (!dry) *(u32x2*)(qrow + d) = w; }
}

#define XB_TMO      128
#define XB_XCNT(j)  (256  + 64 * (j))
#define XB_XSUB(j)  (1280 + 64 * (j))
#define XB_XGEN(j)  (2304 + 64 * (j))
#define XB_TOP      3328
#define XB_TOPGEN   3392
#define XCD_BAR_WORDS 3456
#define XB_SPIN_CAP (1u << 18)

__device__ __forceinline__ unsigned xb_ld(unsigned* p)              { return __hip_atomic_load(p, __ATOMIC_RELAXED, __HIP_MEMORY_SCOPE_AGENT); }
__device__ __forceinline__ unsigned xb_add(unsigned* p, unsigned v) { return __hip_atomic_fetch_add(p, v, __ATOMIC_RELAXED, __HIP_MEMORY_SCOPE_AGENT); }
__device__ __forceinline__ unsigned xb_xcc_id() { return (unsigned)__builtin_amdgcn_s_getreg((3 << 11) | 20) & 0xFu; }
#define XB_SPIN(cond, bar) do { unsigned _sp = 0; while (cond) { __builtin_amdgcn_s_sleep(1); \
    if ((++_sp & 255u) == 0u) { if (xb_ld(&(bar)[XB_TMO])) break; if (_sp > XB_SPIN_CAP) { atomicAdd(&(bar)[XB_TMO], 1u); break; } } } } while (0)

struct XcdBarrier {
    unsigned* bar; unsigned x;
    volatile LAS unsigned* st;
};

__device__ __forceinline__ XcdBarrier xcd_barrier_post(unsigned* bar, volatile LAS unsigned* st) {
    XcdBarrier b; b.bar = bar; b.x = xb_xcc_id(); b.st = st;
    if (threadIdx.x == 0) (void)xb_add(&bar[XB_XCNT(b.x)], 1u);
    return b;
}
__device__ __forceinline__ void xcd_barrier_complete(unsigned* bar, unsigned x, unsigned& nloc, unsigned& nx) {
    const unsigned G = gridDim.x * gridDim.y * gridDim.z;
    unsigned sum, cnt, mine, sp = 0u;
    for (;;) {
        sum = 0u; cnt = 0u; mine = 0u;
#pragma unroll
        for (unsigned j = 0; j < 16; ++j) { const unsigned c = xb_ld(&bar[XB_XCNT(j)]); sum += c; cnt += (c > 0u) ? 1u : 0u; mine = (j == x) ? c : mine; }
        if (sum == G) break;
        __builtin_amdgcn_s_sleep(1);
        if ((++sp & 255u) == 0u) { if (xb_ld(&bar[XB_TMO])) break; if (sp > XB_SPIN_CAP) { atomicAdd(&bar[XB_TMO], 1u); break; } }
    }
    nloc = mine > 0u ? mine : 1u; nx = cnt > 0u ? cnt : 1u;
}

__device__ __forceinline__ void xcd_barrier(const XcdBarrier& b) {
    asm volatile("s_waitcnt vmcnt(0)" ::: "memory");
    __syncthreads();
    if (threadIdx.x == 0) {
        unsigned* bar = b.bar;
        __builtin_amdgcn_s_waitcnt(0);
        unsigned nloc = b.st[0], nx = b.st[1];
        if (nloc == 0u) { xcd_barrier_complete(bar, b.x, nloc, nx); b.st[0] = nloc; b.st[1] = nx; }
        const unsigned old = xb_add(&bar[XB_XSUB(b.x)], 1u);
        const unsigned gen = old / nloc;
        if (old + 1u == (gen + 1u) * nloc) {
            __builtin_amdgcn_fence(__ATOMIC_RELEASE, "agent");
            asm volatile("s_waitcnt vmcnt(0)" ::: "memory");
            const unsigned og = xb_add(&bar[XB_TOP], 1u);
            const unsigned tg = og / nx;
            if (og + 1u == (tg + 1u) * nx) xb_add(&bar[XB_TOPGEN], 1u);
            else XB_SPIN(xb_ld(&bar[XB_TOPGEN]) == tg, bar);
            __builtin_amdgcn_fence(__ATOMIC_ACQUIRE, "agent");
            xb_add(&bar[XB_XGEN(b.x)], 1u);
            asm volatile("s_waitcnt vmcnt(0)" ::: "memory");
        } else {
            XB_SPIN(xb_ld(&bar[XB_XGEN(b.x)]) == gen, bar);
            __builtin_amdgcn_fence(__ATOMIC_ACQUIRE, "agent");
            asm volatile("s_waitcnt vmcnt(0)" ::: "memory");
        }
    }
    __syncthreads();
}

__device__ __forceinline__ int next_item(unsigned* counter, LAS int* slot) {
    __syncthreads();
    if (threadIdx.x == 0) *slot = (int)atomicAdd(counter, 1u);
    __syncthreads();
    return *slot;
}

__global__ void __launch_bounds__(NTHREADS) fwd_megakernel(Params P) {
    extern __shared__ __attribute__((aligned(16))) unsigned char lds_raw[];
    LAS unsigned char* lds = (LAS unsigned char*)lds_raw;
    cg::grid_group grid = cg::this_grid();
    const int G = gridDim.x, bx = blockIdx.x;
    const int vb = (G % 8 == 0) ? (bx % 8) * (G / 8) + bx / 8 : bx;
    unsigned char* ws = P.ws;
    unsigned* ctl = (unsigned*)(ws + WS_CTL);
    LAS int* slot = (LAS int*)(lds + L_SLOT);
    if (threadIdx.x < 8) ((LAS unsigned*)(lds + L_SLOT))[threadIdx.x] = 0u;
    __syncthreads();
    XcdBarrier xbar = xcd_barrier_post(ctl + CW_BAR, (volatile LAS unsigned*)(lds + L_SLOT + 16));
    const int lo = P.ph_lo, hi = P.ph_hi;
#ifdef PROBE_PHASE
    const unsigned long long t_start = __builtin_amdgcn_s_memrealtime(); unsigned long long t_probe = 0ull;
#define STAMP(k) do { if ((k) == PROBE_PHASE) t_probe = __builtin_amdgcn_s_memrealtime(); } while (0)
#else
#define STAMP(k) do { } while (0)
#endif
#ifndef PHMASK
#define PHMASK 0xff
#endif
#define IN(k) (((PHMASK >> (k)) & 1) && lo <= (k) && (k) < hi)
#define SEAM(k) do { if (IN(k) && IN((k) + 1)) { if (P.ph_lo < 0) grid.sync(); else xcd_barrier(xbar); } STAMP(k); } while (0)

    if (IN(0)) p0_prologue(P, lds, vb, G);
    SEAM(0);
    if (IN(1)) {
        pg8::Gemm g = pg8::make_gemm((const bf16_t*)(ws + WS_XN), (const bf16_t*)(ws + WS_WIN), MTOK, NPAD, 1024);
        pg8::StaticOrder S; S.init(MTOK, NPAD, G, bx);
        EpiProj E; E.ws = ws; E.gq = P.in[3]; E.gk = P.in[4]; E.gnq = P.in[10]; E.gnk = P.in[11]; E.mgp = (unsigned char*)P.out;
        pg8::gemm_phase<EpiProj, pg8::StaticOrder, true, true>((PG8_LAS unsigned char*)lds, g, S, E);
        for (;;) {
            const int it = next_item(ctl + 320, slot);
            if (it >= 704) break;
            late_weight_item(P, lds, it);
        }
    }
    SEAM(1);
    if (IN(2)) {
        float lam;
        bool fast;
        { const int lane = threadIdx.x & 63; const float a = wave_sum(P.in[5][lane] * P.in[6][lane]), b2 = wave_sum(P.in[7][lane] * P.in[8][lane]); lam = expf(a) - expf(b2) + 0.2f;
          float gq = fabsf(P.in[3][lane]), gk = fabsf(P.in[4][lane]);
#pragma unroll
          for (int o_ = 1; o_ < 64; o_ <<= 1) { gq = fmaxf(gq, __shfl_xor(gq, o_)); gk = fmaxf(gk, __shfl_xor(gk, o_)); }
          fast = (QSCALE * 64.f * gq * gk <= 40.f); }
        for (;;) {
            const int it = next_item(ctl + 128, slot);
            if (it >= 32) break;
            compress_unit(P, lds, it >> 4, it & 15);
        }
        for (;;) {
            const int it = next_item(ctl + 0, slot);
            if (it >= 512) break;
            const int qb = 15 - (it >> 5), bh = it & 31;
            if (fast) diff_unit<true>(P, lds, bh >> 3, bh & 7, qb, lam, P.dup != 0); else diff_unit<false>(P, lds, bh >> 3, bh & 7, qb, lam, P.dup != 0);
        }
    }
    SEAM(2);
    if (IN(3)) {
        bool fast;
        { const int lane = threadIdx.x & 63; float gq = fabsf(P.in[10][lane]), gk = fmaxf(fabsf(P.in[11][lane]), fmaxf(fabsf(P.in[11][64 + lane]), fabsf(P.in[11][128 + lane])));
#pragma unroll
          for (int o_ = 1; o_ < 64; o_ <<= 1) { gq = fmaxf(gq, __shfl_xor(gq, o_)); gk = fmaxf(gk, __shfl_xor(gk, o_)); }
          fast = (QSCALE * 64.f * gq * gk <= 40.f); }
        for (;;) {
            const int it = next_item(ctl + 64, slot);
            if (it >= 1024) break;
            const int c = 63 - (it >> 4), bg = it & 15;
            if (fast) nsa_unit<true>(P, lds, bg >> 2, bg & 3, c, P.dup != 0); else nsa_unit<false>(P, lds, bg >> 2, bg & 3, c, P.dup != 0);
        }
    }
    SEAM(3);
    if (IN(4)) {
        static_assert(WS_WPN == WS_WPD + (size_t)1024 * 1024 * 2 && WS_NQ > WS_DQ, "the two branch GEMMs are addressed as one virtual GEMM");
        TwoSched S; S.S.init(MTOK, 1024, G, bx);
        pg8::Gemm g = pg8::make_gemm((const bf16_t*)(ws + WS_DQ), (const bf16_t*)(ws + WS_WPD), MTOK, 2048, 1024);
        g.a_sh = 6; g.a_lo = (size_t)256 * 1024 * 2; g.a_hi = WS_NQ - WS_DQ;
        EpiMerge2 E{(const bf16_t*)P.out, (bf16_t*)(ws + WS_MIXED)};
        pg8::gemm_phase<EpiMerge2, TwoSched, true, true>((PG8_LAS unsigned char*)lds, g, S, E);
    }
    SEAM(4);
    if (IN(5)) {
        pg8::Gemm g = pg8::make_gemm((const bf16_t*)(ws + WS_MIXED), (const bf16_t*)(ws + WS_WOUT), MTOK, 1024, 1024);
        pg8::StaticOrder S; S.init(MTOK, 1024, G, bx);
        EpiRes1 E{P.in[0], P.out, (bf16_t*)(ws + WS_XB1), (float*)(ws + WS_PART)};
        pg8::gemm_phase<EpiRes1, pg8::StaticOrder, true, true>((PG8_LAS unsigned char*)lds, g, S, E);
    }
    SEAM(5);
    if (IN(6)) {
        pg8::Gemm g = pg8::make_gemm((const bf16_t*)(ws + WS_XB1), (const bf16_t*)(ws + WS_WUP), MTOK, DFF, 1024);
        pg8::StaticOrder S; S.init(MTOK, DFF, G, bx);
        EpiUp E{(const float*)(ws + WS_PART), (bf16_t*)(ws + WS_HB)};
        pg8::gemm_phase<EpiUp, pg8::StaticOrder, true, true>((PG8_LAS unsigned char*)lds, g, S, E);
    }
    SEAM(6);
    if (IN(7)) {
        pg8::Gemm g = pg8::make_gemm((const bf16_t*)(ws + WS_HB), (const bf16_t*)(ws + WS_WDN), MTOK, 1024, DFF);
        pg8::StaticOrder S; S.init(MTOK, 1024, G, bx);
        EpiRes2 E{P.out, 1.f, (const bf16_t*)(ws + WS_XB1)};
        pg8::gemm_phase<EpiRes2, pg8::StaticOrder, true, true>((PG8_LAS unsigned char*)lds, g, S, E);
    }
#ifdef PROBE_PHASE
    grid.sync();
    if (blockIdx.x == 0 && threadIdx.x == 0) P.out[0] = 1000.0f + (float)(t_probe - t_start) * 0.01f;
#endif
#undef IN
#undef SEAM
}

#ifndef PROBE_DUP
#define PROBE_DUP -1
#endif
extern "C" void kernel_launch(void* const* d_in, const int* in_sizes, int n_in, void* d_out, int out_size, void* d_ws, size_t ws_size, hipStream_t stream) {
    static int grid = 0;
    if (grid == 0) {
        if (n_in != 24 || out_size != MTOK * DM || ws_size < WS_END) { fprintf(stderr, "kernel_launch: unexpected shapes (n_in %d out %d ws %zu)\n", n_in, out_size, ws_size); grid = -1; return; }
        int dev = 0, cus = 0, per_cu = 0;
        hipGetDevice(&dev); hipDeviceGetAttribute(&cus, hipDeviceAttributeMultiprocessorCount, dev);
        if (hipFuncSetAttribute((const void*)fwd_megakernel, hipFuncAttributeMaxDynamicSharedMemorySize, LDS_BYTES) != hipSuccess) { fprintf(stderr, "kernel_launch: hipFuncSetAttribute failed\n"); grid = -1; return; }
        if (hipOccupancyMaxActiveBlocksPerMultiprocessor(&per_cu, (const void*)fwd_megakernel, NTHREADS, LDS_BYTES) != hipSuccess || per_cu < 1) { fprintf(stderr, "kernel_launch: occupancy query says %d\n", per_cu); per_cu = 1; }
        (void)hipGetLastError();
        grid = cus * 1;
        fprintf(stderr, "kernel_launch: grid %d (cus %d, per_cu %d)\n", grid, cus, per_cu);
    }
    if (grid < 0) return;
    hipMemsetAsync((char*)d_ws + WS_CTL, 0, CTL_BYTES, stream);
    Params p{};
    for (int i = 0; i < 24; ++i) p.in[i] = (const float*)d_in[i];
    p.out = (float*)d_out; p.ws = (unsigned char*)d_ws;
    for (int i = 0; i < 32; ++i) p.invfreq[i] = (double)powf(10000.0f, -(float)i / 32.0f);
    p.pad = 0;
    int plan[3][3] = {{0, 8, 0}, {0, 0, 0}, {0, 0, 0}}; int nl = 1;
    if (PROBE_DUP >= 0) { const int k = PROBE_DUP; const bool inplace = (k == 2 || k == 3 || k == 7); plan[0][0] = 0; plan[0][1] = k + (inplace ? 0 : 1); plan[0][2] = 0; plan[1][0] = k; plan[1][1] = k + 1; plan[1][2] = inplace ? 1 : 0; plan[2][0] = k + (inplace ? 0 : 1); plan[2][1] = 8; plan[2][2] = 0; nl = 3; }
    for (int li = 0; li < nl; ++li) {
        if (plan[li][0] >= plan[li][1]) continue;
        if (li > 0) hipMemsetAsync((char*)d_ws + WS_CTL, 0, CTL_BYTES, stream);
        p.ph_lo = plan[li][0]; p.ph_hi = plan[li][1]; p.dup = plan[li][2];
        void* args[] = {&p};
        hipError_t e = hipLaunchCooperativeKernel((const void*)fwd_megakernel, dim3(grid), dim3(NTHREADS), args, LDS_BYTES, stream);
        if (e != hipSuccess) fprintf(stderr, "kernel_launch: cooperative launch failed: %s (grid %d)\n", hipGetErrorString(e), grid);
    }
}
```

```cpp
#include <hip/hip_runtime.h>
#include <hip/hip_cooperative_groups.h>
#include <cstdio>
#include <cstdint>
#include <cmath>
namespace cg = cooperative_groups;

namespace pg8 {
#define PG8_LAS __attribute__((address_space(3)))
typedef unsigned short bf16_t;
typedef short bf16x8 __attribute__((ext_vector_type(8)));
typedef float f32x4 __attribute__((ext_vector_type(4)));
typedef unsigned u32x4 __attribute__((ext_vector_type(4)));
constexpr int BM = 256, BK = 64, HALF = 128, HTB = HALF * BK * 2  , STAGE_BYTES = 8 * HTB, NXCD = 8, WGM = 8;

__host__ __device__ __forceinline__ int lds_byte(int r, int c) { const int st = (r >> 4) * 2 + (c >> 5), rr = r & 15, cc = c & 31, ob = rr * 64 + cc * 2; return st * 1024 + (ob ^ (((ob >> 9) & 1) << 5)); }
__host__ __device__ __forceinline__ void stage_rc(int b, int& R, int& C) { const int st = b / 1024, sb = b % 1024, swz = sb ^ (((sb >> 9) & 1) << 5); R = (st >> 1) * 16 + swz / 64; C = (st & 1) * 32 + (swz % 64) / 2; }
__host__ __device__ __forceinline__ int perm32(int rho) { const int n = rho >> 4, i = rho & 15; return 8 * (i >> 2) + 4 * n + (i & 3); }

struct Unit { int pm, pn; };
struct Gemm { const bf16_t* A; const bf16_t* Bt; int M, N, K; int lda; int kstepA; int a_sh; size_t a_lo, a_hi; };
__host__ __device__ __forceinline__ Gemm make_gemm(const bf16_t* A, const bf16_t* Bt, int M, int N, int K) { Gemm g; g.A = A; g.Bt = Bt; g.M = M; g.N = N; g.K = K; g.lda = K; g.kstepA = BK * 2; g.a_sh = 24; g.a_lo = (size_t)BM * K * 2; g.a_hi = 0; return g; }
__device__ __forceinline__ const char* a_tile(const Gemm& g, int pm) { return (const char*)g.A + (size_t)(pm >> g.a_sh) * g.a_hi + (size_t)(pm & ((1 << g.a_sh) - 1)) * g.a_lo; }

struct StaticOrder {
    int nM, nN, nwg, G, c;
    __host__ __device__ void init(int M, int N, int G_, int c_) { nM = M / BM; nN = N / BM; nwg = nM * nN; G = G_; c = c_; }
    __host__ __device__ bool next(int i, Unit& u) const {
        const long L = (long)i * G + c; if (L >= nwg) return false;
        int wgid = (int)L; { const int q = nwg / NXCD, r = nwg % NXCD, xcd = wgid % NXCD, off = wgid / NXCD; wgid = (xcd < r ? xcd * (q + 1) : r * (q + 1) + (xcd - r) * q) + off; }
        const int nig = WGM * nN, gid = wgid / nig, fm = gid * WGM, gsz = (nM - fm) < WGM ? (nM - fm) : WGM;
        u.pm = fm + ((wgid % nig) % gsz); u.pn = (wgid % nig) / gsz; return true;
    }
    __device__ __forceinline__ void a_ready(const Unit&) const {}
    __device__ __forceinline__ void done(const Unit&) const {}
};


template <class Epi, class Sched, bool ALIGN_EPI = false, bool SP2 = false>
__device__ __forceinline__ void gemm_phase(PG8_LAS unsigned char* lds, const Gemm g, const Sched& S, const Epi& E) {
    const int tid = threadIdx.x, wid = __builtin_amdgcn_readfirstlane(tid >> 6), lane = tid & 63, wr = wid >> 2, wc = wid & 3, fr = lane & 15, fq = lane >> 4;
    const int K = g.K, nt = K / BK;
    unsigned voffA[2], voffB[2];
#pragma unroll
    for (int i = 0; i < 2; ++i) { int R, C; stage_rc(tid * 16 + i * 8192, R, C); const int Rb = Epi::PERM ? ((R & ~31) + perm32(R & 31)) : R;
        voffA[i] = (unsigned)(R * g.lda + C) * 2u; voffB[i] = (unsigned)(Rb * K + C) * 2u; }
    const size_t kstep = (size_t)(BK * 2); const size_t kstepA = (size_t)g.kstepA; const size_t hstepA = (size_t)HALF * g.lda * 2;
    const size_t hstep = (size_t)HALF * K * 2;
    const size_t tstep = 2 * hstep;
    const unsigned ldsw = (unsigned)wid * 1024u;
    const int aoff = lds_byte(wr * 64 + fr, fq * 8), boff = lds_byte(wc * 32 + fr, fq * 8);
#define PG8_SA(b, h) (((b) * 2 + (h)) * HTB)
#define PG8_SB(b, h) ((4 + (b) * 2 + (h)) * HTB)
#define PG8_STAGE(bufoff, gbase, voff) do { _Pragma("unroll") for (int _i = 0; _i < 2; ++_i) \
        __builtin_amdgcn_global_load_lds((const unsigned*)((const char*)(gbase) + (voff)[_i]), (PG8_LAS unsigned*)(lds + (bufoff) + ldsw + _i * 8192), 16, 0, 0); } while (0)
#define PG8_LDA(dst, b, h) do { _Pragma("unroll") for (int m = 0; m < 4; ++m) _Pragma("unroll") for (int k = 0; k < 2; ++k) dst[m][k] = *(const PG8_LAS bf16x8*)(lds + PG8_SA(b, h) + aoff + m * 2048 + k * 1024); } while (0)
#define PG8_LDB(dst, b, h) do { _Pragma("unroll") for (int n = 0; n < 2; ++n) _Pragma("unroll") for (int k = 0; k < 2; ++k) dst[n][k] = *(const PG8_LAS bf16x8*)(lds + PG8_SB(b, h) + boff + n * 2048 + k * 1024); } while (0)
#define PG8_MMA(ai, bj, At, Bt) do { __builtin_amdgcn_s_setprio(1); _Pragma("unroll") for (int m = 0; m < 4; ++m) _Pragma("unroll") for (int n = 0; n < 2; ++n) _Pragma("unroll") for (int k = 0; k < 2; ++k) \
        acc[ai][bj][m][n] = __builtin_amdgcn_mfma_f32_16x16x32_bf16(Bt[n][k], At[m][k], acc[ai][bj][m][n], 0, 0, 0); __builtin_amdgcn_s_setprio(0); } while (0)
#define PG8_WAIT_V(n) asm volatile("s_waitcnt vmcnt(" #n ")" ::: "memory")
#define PG8_WAIT_L(n) asm volatile("s_waitcnt lgkmcnt(" #n ")" ::: "memory")
#define PG8_BAR __builtin_amdgcn_s_barrier()
#define PG8_SCHED __builtin_amdgcn_sched_barrier(0)
    Unit cur, nxt; int ui = 0;
    if (!S.next(0, cur)) return;
    f32x4 acc[2][2][4][2];
#pragma unroll
    for (int a = 0; a < 2; ++a)
#pragma unroll
        for (int b = 0; b < 2; ++b)
#pragma unroll
            for (int m = 0; m < 4; ++m)
#pragma unroll
                for (int n = 0; n < 2; ++n) acc[a][b][m][n] = (f32x4){0.f, 0.f, 0.f, 0.f};
    bf16x8 At[4][2], B0[2][2], B1[2][2];
    const char* cA = a_tile(g, cur.pm); const char* cB = (const char*)g.Bt + (size_t)cur.pn * tstep;
    S.a_ready(cur);
    if constexpr (SP2) {
        PG8_STAGE(PG8_SB(0, 0), cB, voffB); PG8_STAGE(PG8_SB(0, 1), cB + hstep, voffB); PG8_STAGE(PG8_SA(0, 0), cA, voffA); PG8_STAGE(PG8_SA(0, 1), cA + hstepA, voffA);
        if (wr == 1) PG8_BAR;
        PG8_WAIT_V(2); PG8_BAR;
        PG8_STAGE(PG8_SB(1, 0), cB + kstep, voffB); PG8_STAGE(PG8_SA(1, 0), cA + kstepA, voffA); PG8_STAGE(PG8_SB(1, 1), cB + hstep + kstep, voffB);
        PG8_WAIT_V(6); PG8_BAR;
    } else {
        PG8_STAGE(PG8_SB(0, 0), cB, voffB); PG8_STAGE(PG8_SA(0, 0), cA, voffA); PG8_STAGE(PG8_SB(0, 1), cB + hstep, voffB); PG8_STAGE(PG8_SA(0, 1), cA + hstepA, voffA);
        if (wr == 1) PG8_BAR;
        PG8_WAIT_V(4); PG8_BAR;
        PG8_STAGE(PG8_SB(1, 0), cB + kstep, voffB); PG8_STAGE(PG8_SA(1, 0), cA + kstepA, voffA); PG8_STAGE(PG8_SB(1, 1), cB + hstep + kstep, voffB);
        PG8_WAIT_V(6); PG8_BAR;
    }
    for (;;) {
        const bool has_next = S.next(ui + 1, nxt);
        const char* nA = has_next ? a_tile(g, nxt.pm) : cA; const char* nB = has_next ? (const char*)g.Bt + (size_t)nxt.pn * tstep : cB;
        for (int t = 0; t < nt; t += 2) {
            const bool last = (t == nt - 2);
            const char* a1 = cA + (size_t)(t + 1) * kstepA;
            const char* a2 = last ? nA : cA + (size_t)(t + 2) * kstepA; const char* b2 = last ? nB : cB + (size_t)(t + 2) * kstep;
            const char* a3 = a2 + kstepA; const char* b3 = b2 + kstep;
            if (last && has_next) S.a_ready(nxt);
            if constexpr (SP2) {
            PG8_LDB(B0, 0, 0); PG8_LDB(B1, 0, 1); PG8_SCHED; PG8_LDA(At, 0, 0); PG8_STAGE(PG8_SA(1, 1), a1 + hstepA, voffA);
            PG8_WAIT_V(8); PG8_WAIT_L(0); PG8_BAR; PG8_MMA(0, 0, At, B0); PG8_MMA(0, 1, At, B1); PG8_BAR; PG8_SCHED;
            PG8_LDA(At, 0, 1); PG8_STAGE(PG8_SB(0, 0), b2, voffB); PG8_STAGE(PG8_SB(0, 1), b2 + hstep, voffB); PG8_STAGE(PG8_SA(0, 0), a2, voffA);
            PG8_WAIT_V(8); PG8_WAIT_L(0); PG8_BAR; PG8_MMA(1, 0, At, B0); PG8_MMA(1, 1, At, B1); PG8_BAR; PG8_SCHED;
            PG8_LDB(B0, 1, 0); PG8_LDB(B1, 1, 1); PG8_SCHED; PG8_LDA(At, 1, 0); PG8_STAGE(PG8_SA(0, 1), a2 + hstepA, voffA);
            PG8_WAIT_V(8); PG8_WAIT_L(0); PG8_BAR; PG8_MMA(0, 0, At, B0); PG8_MMA(0, 1, At, B1); PG8_BAR; PG8_SCHED;
            PG8_LDA(At, 1, 1); PG8_STAGE(PG8_SB(1, 0), b3, voffB); PG8_STAGE(PG8_SB(1, 1), b3 + hstep, voffB); PG8_STAGE(PG8_SA(1, 0), a3, voffA);
            PG8_WAIT_V(8); PG8_WAIT_L(0); PG8_BAR; PG8_MMA(1, 0, At, B0); PG8_MMA(1, 1, At, B1); PG8_BAR; PG8_SCHED;
            } else {
            PG8_LDB(B0, 0, 0); PG8_SCHED; PG8_LDA(At, 0, 0); PG8_STAGE(PG8_SA(1, 1), a1 + hstepA, voffA);
            PG8_WAIT_L(8); PG8_BAR; PG8_WAIT_L(0); PG8_MMA(0, 0, At, B0); PG8_BAR; PG8_SCHED;
            PG8_LDB(B1, 0, 1); PG8_STAGE(PG8_SB(0, 0), b2, voffB);
            PG8_BAR; PG8_WAIT_L(0); PG8_MMA(0, 1, At, B1); PG8_BAR;
            PG8_LDA(At, 0, 1); PG8_STAGE(PG8_SA(0, 0), a2, voffA);
            PG8_BAR; PG8_WAIT_L(0); PG8_MMA(1, 0, At, B0); PG8_BAR; PG8_SCHED;
            PG8_STAGE(PG8_SB(0, 1), b2 + hstep, voffB);
            PG8_WAIT_V(6); PG8_BAR; PG8_MMA(1, 1, At, B1); PG8_BAR;
            PG8_LDB(B0, 1, 0); PG8_SCHED; PG8_LDA(At, 1, 0); PG8_STAGE(PG8_SA(0, 1), a2 + hstepA, voffA);
            PG8_WAIT_L(8); PG8_BAR; PG8_WAIT_L(0); PG8_MMA(0, 0, At, B0); PG8_BAR; PG8_SCHED;
            PG8_LDB(B1, 1, 1); PG8_STAGE(PG8_SB(1, 0), b3, voffB);
            PG8_BAR; PG8_WAIT_L(0); PG8_MMA(0, 1, At, B1); PG8_BAR;
            PG8_LDA(At, 1, 1); PG8_STAGE(PG8_SA(1, 0), a3, voffA);
            PG8_BAR; PG8_WAIT_L(0); PG8_MMA(1, 0, At, B0); PG8_BAR; PG8_SCHED;
            PG8_STAGE(PG8_SB(1, 1), b3 + hstep, voffB);
            PG8_WAIT_V(6); PG8_BAR; PG8_MMA(1, 1, At, B1); PG8_BAR;
            }
        }
        if constexpr (ALIGN_EPI) { if (wr == 0) PG8_BAR; }
        if constexpr (!Epi::AFTER_DRAIN) { E(acc, cur, wr, wc, fr, fq); S.done(cur); }
        if (!has_next) break;
#pragma unroll
        for (int a = 0; a < 2; ++a)
#pragma unroll
            for (int b = 0; b < 2; ++b)
#pragma unroll
                for (int m = 0; m < 4; ++m)
#pragma unroll
                    for (int n = 0; n < 2; ++n) acc[a][b][m][n] = (f32x4){0.f, 0.f, 0.f, 0.f};
        cur = nxt; cA = nA; cB = nB; ++ui;
        if constexpr (ALIGN_EPI) { if (wr == 1) PG8_BAR; }
    }
    PG8_WAIT_V(0);
    if constexpr (!ALIGN_EPI) { if (wr == 0) PG8_BAR; }
    PG8_BAR;
    if constexpr (Epi::AFTER_DRAIN) { E.fused(acc, cur, wr, wc, fr, fq, lds, wid, lane); S.done(cur); }
#undef PG8_SA
#undef PG8_SB
#undef PG8_STAGE
#undef PG8_LDA
#undef PG8_LDB
#undef PG8_MMA
#undef PG8_WAIT_V
#undef PG8_WAIT_L
#undef PG8_BAR
#undef PG8_SCHED
}
}

#define LAS __attribute__((address_space(3)))
typedef unsigned short bf16_t;
typedef short bf16x8 __attribute__((ext_vector_type(8)));
typedef float f32x4 __attribute__((ext_vector_type(4)));
typedef float f32x16 __attribute__((ext_vector_type(16)));
typedef float f32x8 __attribute__((ext_vector_type(8)));
typedef unsigned u32x4 __attribute__((ext_vector_type(4)));
typedef unsigned u32x2 __attribute__((ext_vector_type(2)));
typedef float f32x2_t __attribute__((ext_vector_type(2)));
typedef __bf16 bf16x2_t __attribute__((ext_vector_type(2)));

constexpr int NB = 4, SEQ = 4096, DM = 1024, MTOK = NB * SEQ, DIN = 7728, NPAD = 7936, DFF = 4096;
constexpr float QSCALE = 0.125f * 1.4426950408889634f;
constexpr float EPS = 1e-6f;
constexpr int NTHREADS = 512, NWAVES = 8;

constexpr size_t MiB = 1u << 20;
constexpr size_t WS_CTL = 0, CTL_BYTES = 65536;
constexpr int CW_BAR = 4096;
constexpr size_t WS_COS = 1 * MiB, WS_SIN = WS_COS + 4096 * 32 * 4, WS_CCOS = WS_SIN + 4096 * 32 * 4, WS_CSIN = WS_CCOS + 256 * 32 * 4;
constexpr size_t WS_PB = 3 * MiB;
constexpr size_t WS_W2T = 3 * MiB + 65536;
constexpr size_t WS_W1T = 4 * MiB;
constexpr size_t WS_WPD = 6 * MiB, WS_WPN = 8 * MiB, WS_WOUT = 10 * MiB, WS_WUP = 12 * MiB, WS_WDN = 20 * MiB, WS_WIN = 28 * MiB;
constexpr size_t WS_XN = 45 * MiB;
constexpr size_t WS_HID = WS_XN, WS_KCMP = WS_XN + 4 * MiB, WS_VCMPT = WS_XN + 5 * MiB, WS_MIXED = WS_XN;
constexpr size_t WS_DQ = 77 * MiB, WS_DK = 109 * MiB, WS_DVT = 141 * MiB, WS_NQ = 173 * MiB;
constexpr size_t WS_KC = 205 * MiB, WS_VC = 213 * MiB, WS_KSL = 221 * MiB, WS_KWN = 229 * MiB, WS_VSLT = 237 * MiB, WS_VWNT = 245 * MiB, WS_NG = 253 * MiB;
constexpr size_t WS_T1 = WS_DK;
constexpr size_t WS_XB1 = WS_KC;
constexpr size_t WS_PART = WS_NG;
constexpr size_t WS_HB = WS_DQ;
constexpr size_t WS_END = 256 * MiB;

constexpr int LDS_BYTES = 151552;
constexpr int TROW = 72;
constexpr int ABUF = 64 * TROW * 2 + 128 * TROW * 2;
constexpr int L_O0P = 83968;
constexpr int L_CK = 57344, CKROW = 72;
constexpr int L_CV = L_CK + 256 * CKROW * 2, CVROW = 264;
constexpr int L_IMP = L_CV + 64 * CVROW * 2;
constexpr int L_SEL = L_IMP + 16384;
constexpr int L_SLOT = 149504;
static_assert(L_SEL + 512 <= L_SLOT && L_O0P + 65536 <= L_SLOT && 3 * ABUF <= L_O0P && 3 * (128 * TROW * 2) <= L_CK, "lds map 2");
static_assert(L_SLOT + 64 <= LDS_BYTES, "lds map");

struct Params { const float* in[24]; float* out; unsigned char* ws; double invfreq[32]; int ph_lo, ph_hi, dup, pad; };

__device__ __forceinline__ unsigned cvtpk(float lo, float hi) { f32x2_t v = {lo, hi}; bf16x2_t b = __builtin_convertvector(v, bf16x2_t); return __builtin_bit_cast(unsigned, b); }
__device__ __forceinline__ bf16_t f2bf(float f) { return (bf16_t)(cvtpk(f, 0.f) & 0xffffu); }
__device__ __forceinline__ int crow(int r, int hi) { return (r & 3) + 8 * (r >> 2) + 4 * hi; }
__device__ __forceinline__ int perm16(int t) { return (t & ~12) | ((t & 4) << 1) | ((t & 8) >> 1); }
__device__ __forceinline__ float wave_sum(float v) {
#pragma unroll
    for (int o = 1; o < 64; o <<= 1) v += __shfl_xor(v, o);
    return v;
}
__device__ __forceinline__ float sigmoidf_(float v) { return __builtin_amdgcn_rcpf(1.0f + __expf(-v)); }
__device__ __forceinline__ float gelu_tanh(float x) { const float u = 0.7978845608028654f * (x + 0.044715f * x * x * x); return x * __builtin_amdgcn_rcpf(1.0f + __expf(-2.0f * u)); }

__device__ __forceinline__ void tr_item(const float* W, int ldw, int col0, int nvalid, const float* kscale, bf16_t* WT, int ldt, int row0, int k0, LAS float* scr, int lane) {
    const int cl = lane & 31;
#pragma unroll 8
    for (int i = 0; i < 32; ++i) { const int kk = 2 * i + (lane >> 5); float v = 0.f; if (cl < nvalid) { v = __builtin_nontemporal_load(W + (size_t)(k0 + kk) * ldw + col0 + cl); if (kscale) v *= kscale[k0 + kk]; } scr[kk * 33 + cl] = v; }
    asm volatile("s_waitcnt lgkmcnt(0)" ::: "memory");
    const int c = lane & 7;
#pragma unroll
    for (int j = 0; j < 4; ++j) { const int n = (lane >> 3) + 8 * j; const LAS float* s = scr + (8 * c) * 33 + n;
        u32x4 o; o.x = cvtpk(s[0 * 33], s[1 * 33]); o.y = cvtpk(s[2 * 33], s[3 * 33]); o.z = cvtpk(s[4 * 33], s[5 * 33]); o.w = cvtpk(s[6 * 33], s[7 * 33]);
        *(u32x4*)(WT + (size_t)(row0 + n) * ldt + k0 + 8 * c) = o; }
    asm volatile("s_waitcnt lgkmcnt(0)" ::: "memory");
}
__device__ __forceinline__ void tr_plain(const float* W, int K, int N, const float* kscale, bf16_t* WT, LAS float* scr, int item, int lane) {
    const int nblk = N / 32, kb = item / nblk, nb = item % nblk;
    tr_item(W, N, 32 * nb, 32, kscale, WT, K, 32 * nb, 64 * kb, scr, lane);
}
__device__ __forceinline__ void sincos_d(double ang, float& s, float& c) {
    const double k = rint(ang * 0.15915494309189535);
    double r = fma(-k, 6.283185307179586, ang); r = fma(-k, 2.4492935982947064e-16, r);
    const double r2 = r * r; double ts = r, tc = 1.0, ss = r, cs = 1.0;
#pragma unroll
    for (int n = 1; n <= 14; ++n) { tc *= -r2 * (1.0 / ((2.0 * n - 1.0) * (2.0 * n))); cs += tc; ts *= -r2 * (1.0 / ((2.0 * n) * (2.0 * n + 1.0))); ss += ts; }
    s = (float)ss; c = (float)cs;
}

__device__ __forceinline__ void late_weight_item(const Params& P, LAS unsigned char* lds, int item) {
    const int tid = threadIdx.x, lane = tid & 63, wave = tid >> 6;
    LAS float* scr = (LAS float*)(lds + wave * 16384);
    unsigned char* ws = P.ws;
    int it = item * NWAVES + wave;
    if (it < 512) { tr_plain(P.in[18], 1024, 1024, nullptr, (bf16_t*)(ws + WS_WPD), scr, it, lane); return; } it -= 512;
    if (it < 512) { tr_plain(P.in[19], 1024, 1024, nullptr, (bf16_t*)(ws + WS_WPN), scr, it, lane); return; } it -= 512;
    if (it < 512) { tr_plain(P.in[20], 1024, 1024, nullptr, (bf16_t*)(ws + WS_WOUT), scr, it, lane); return; } it -= 512;
    if (it < 2048) { tr_plain(P.in[22], 1024, 4096, P.in[21], (bf16_t*)(ws + WS_WUP), scr, it, lane); return; } it -= 2048;
    tr_plain(P.in[23], 4096, 1024, nullptr, (bf16_t*)(ws + WS_WDN), scr, it, lane);
}
__device__ __forceinline__ void p0_prologue(const Params& P, LAS unsigned char* lds, int vb, int G) {
    const int tid = threadIdx.x, lane = tid & 63, wave = tid >> 6;
    LAS float* scr = (LAS float*)(lds + wave * 16384);
    const int gw = vb * NWAVES + wave, NGW = G * NWAVES;
    unsigned char* ws = P.ws;
    for (int it = gw; it < 16 * 248; it += NGW) {
        const int kb = it / 248, nb = it % 248, n0 = 32 * nb, pn = n0 >> 8, p = n0 & 255, bj = p >> 7, wc = (p >> 5) & 3, L0 = 64 * wc + 32 * bj;
        const int srcbase = pn < 22 ? 256 * pn : (pn < 30 ? 5680 + 256 * (pn - 22) : 5632), tv = pn < 30 ? 256 : 48;
        int nv = tv - L0; nv = nv < 0 ? 0 : (nv > 32 ? 32 : nv);
        tr_item(P.in[2], DIN, srcbase + L0, nv, nullptr, (bf16_t*)(ws + WS_WIN), 1024, n0, 64 * kb, scr, lane);
    }
    for (int it = gw; it < 32 * 8; it += NGW) tr_plain(P.in[14], 2048, 256, nullptr, (bf16_t*)(ws + WS_W1T), scr, it, lane);
    for (int it = gw; it < 32 * 8; it += NGW) tr_plain(P.in[16], 2048, 256, nullptr, (bf16_t*)(ws + WS_W1T) + 256 * 2048, scr, it, lane);
    for (int it = gw; it < 4 * 2; it += NGW) tr_plain(P.in[15], 256, 64, nullptr, (bf16_t*)(ws + WS_W2T), scr, it, lane);
    for (int it = gw; it < 4 * 2; it += NGW) tr_plain(P.in[17], 256, 64, nullptr, (bf16_t*)(ws + WS_W2T) + 64 * 256, scr, it, lane);
    for (int it = NGW - 1 - gw; it < 128; it += NGW) {
        const int which = it >> 6, kc = (it >> 2) & 15, j = 64 * (it & 3) + lane; const float* pos = P.in[which ? 13 : 12] + 128 * kc; const float* W1 = P.in[which ? 16 : 14] + (size_t)128 * kc * 256;
        float a0 = 0.f, a1 = 0.f, a2 = 0.f, a3 = 0.f;
#pragma unroll 4
        for (int k = 0; k < 128; k += 4) { a0 += pos[k] * W1[(size_t)k * 256 + j]; a1 += pos[k + 1] * W1[(size_t)(k + 1) * 256 + j]; a2 += pos[k + 2] * W1[(size_t)(k + 2) * 256 + j]; a3 += pos[k + 3] * W1[(size_t)(k + 3) * 256 + j]; }
        ((float*)(ws + WS_PB))[(which * 16 + kc) * 256 + j] = (a0 + a1) + (a2 + a3);
    }
    for (int idx = vb * NTHREADS + tid; idx < (4096 + 256) * 32; idx += G * NTHREADS) {
        const int i = idx & 31, p = idx >> 5; float s, c;
        if (p < 4096) { sincos_d((double)p * P.invfreq[i], s, c); ((float*)(ws + WS_COS))[p * 32 + i] = c; ((float*)(ws + WS_SIN))[p * 32 + i] = s; }
        else { const int n = p - 4096; sincos_d(((double)n * 16.0 + 15.5) * P.invfreq[i], s, c); ((float*)(ws + WS_CCOS))[n * 32 + i] = c; ((float*)(ws + WS_CSIN))[n * 32 + i] = s; }
    }
    const float* x = P.in[0]; const float* g = P.in[1]; bf16_t* XN = (bf16_t*)(ws + WS_XN);
    f32x4 gv[4];
#pragma unroll
    for (int j = 0; j < 4; ++j) gv[j] = ((const f32x4*)g)[lane + 64 * j];
    for (int m = gw; m < MTOK; m += NGW) {
        const f32x4* xr = (const f32x4*)(x + (size_t)m * DM) + lane; f32x4 v[4]; float s = 0.f;
#pragma unroll
        for (int j = 0; j < 4; ++j) { v[j] = __builtin_nontemporal_load(xr + 64 * j); s += (v[j].x * v[j].x + v[j].y * v[j].y) + (v[j].z * v[j].z + v[j].w * v[j].w); }
        const float rstd = rsqrtf(wave_sum(s) * (1.f / DM) + EPS);
        u32x2* o8 = (u32x2*)(XN + (size_t)m * DM) + lane;
#pragma unroll
        for (int j = 0; j < 4; ++j) { const f32x4 y = v[j] * rstd * gv[j]; u32x2 w; w.x = cvtpk(y.x, y.y); w.y = cvtpk(y.z, y.w); o8[64 * j] = w; }
    }
}

struct EpiProj {
    static constexpr bool PERM = true, AFTER_DRAIN = false;
    unsigned char* ws; const float *gq, *gk, *gnq, *gnk;
    __device__ __forceinline__ void operator()(const f32x4 (&acc)[2][2][4][2], const pg8::Unit& u, int wr, int wc, int fr, int fq) const {
        const int pn = u.pn; const int row0 = u.pm * 256 + wr * 64 + fr;
        int type, ld = 1024, cb = 0; bf16_t* dst = nullptr; const float* gain = nullptr; float qs = 1.f;
        if (pn < 4) { type = 0; dst = (bf16_t*)(ws + WS_DQ); cb = 256 * pn; gain = gq; qs = QSCALE; }
        else if (pn < 8) { type = 0; dst = (bf16_t*)(ws + WS_DK); cb = 256 * (pn - 4); gain = gk; }
        else if (pn < 12) { type = 2; dst = (bf16_t*)(ws + WS_DVT); }
        else if (pn < 16) { type = 0; dst = (bf16_t*)(ws + WS_NQ); cb = 256 * (pn - 12); gain = gnq; qs = QSCALE; }
        else if (pn == 16) { type = 1; dst = (bf16_t*)(ws + WS_KC); ld = 256; }
        else if (pn == 17) { type = 1; dst = (bf16_t*)(ws + WS_VC); ld = 256; }
        else if (pn == 18) { type = 0; dst = (bf16_t*)(ws + WS_KSL); ld = 256; gain = gnk + 64; }
        else if (pn == 19) { type = 2; dst = (bf16_t*)(ws + WS_VSLT); }
        else if (pn == 20) { type = 0; dst = (bf16_t*)(ws + WS_KWN); ld = 256; gain = gnk + 128; }
        else if (pn == 21) { type = 2; dst = (bf16_t*)(ws + WS_VWNT); }
        else if (pn < 30) { type = 3; dst = (bf16_t*)P_MG(); ld = 2048; cb = 256 * (pn - 22); }
        else { type = 4; }
        const int lc = 64 * wc + 8 * fq;
        if (type == 0) {
            const float* COS = (const float*)(ws + WS_COS); const float* SIN = (const float*)(ws + WS_SIN);
            f32x4 g1[2], g2[2];
#pragma unroll
            for (int n = 0; n < 2; ++n) { g1[n] = *(const f32x4*)(gain + 8 * fq + 4 * n); g2[n] = *(const f32x4*)(gain + 32 + 8 * fq + 4 * n); }
#pragma unroll
            for (int ai = 0; ai < 2; ++ai)
#pragma unroll
                for (int m = 0; m < 4; ++m) {
                    const int row = row0 + ai * 128 + m * 16, pos = row & (SEQ - 1);
                    float ss = 0.f;
#pragma unroll
                    for (int bj = 0; bj < 2; ++bj)
#pragma unroll
                        for (int n = 0; n < 2; ++n) { const f32x4 v = acc[ai][bj][m][n]; ss += (v.x * v.x + v.y * v.y) + (v.z * v.z + v.w * v.w); }
                    ss += __shfl_xor(ss, 16); ss += __shfl_xor(ss, 32);
                    const float rstd = rsqrtf(ss * (1.f / 64.f) + EPS);
                    f32x4 o1[2], o2[2];
#pragma unroll
                    for (int n = 0; n < 2; ++n) {
                        const f32x4 c4 = *(const f32x4*)(COS + pos * 32 + 8 * fq + 4 * n), s4 = *(const f32x4*)(SIN + pos * 32 + 8 * fq + 4 * n);
                        const f32x4 x1 = acc[ai][0][m][n] * rstd * g1[n], x2 = acc[ai][1][m][n] * rstd * g2[n];
                        o1[n] = (x1 * c4 - x2 * s4) * qs; o2[n] = (x2 * c4 + x1 * s4) * qs;
                    }
                    bf16_t* rp = dst + (size_t)row * ld + cb + lc;
                    u32x4 w; w.x = cvtpk(o1[0].x, o1[0].y); w.y = cvtpk(o1[0].z, o1[0].w); w.z = cvtpk(o1[1].x, o1[1].y); w.w = cvtpk(o1[1].z, o1[1].w); *(u32x4*)rp = w;
                    w.x = cvtpk(o2[0].x, o2[0].y); w.y = cvtpk(o2[0].z, o2[0].w); w.z = cvtpk(o2[1].x, o2[1].y); w.w = cvtpk(o2[1].z, o2[1].w); *(u32x4*)(rp + 32) = w;
                }
        } else if (type == 1 || type == 3) {
#pragma unroll
            for (int ai = 0; ai < 2; ++ai)
#pragma unroll
                for (int m = 0; m < 4; ++m) {
                    const int row = row0 + ai * 128 + m * 16; bf16_t* rp = dst + (size_t)row * ld + cb + lc;
#pragma unroll
                    for (int bj = 0; bj < 2; ++bj) {
                        f32x4 a = acc[ai][bj][m][0], b = acc[ai][bj][m][1];
                        if (type == 3) { a.x = sigmoidf_(a.x); a.y = sigmoidf_(a.y); a.z = sigmoidf_(a.z); a.w = sigmoidf_(a.w); b.x = sigmoidf_(b.x); b.y = sigmoidf_(b.y); b.z = sigmoidf_(b.z); b.w = sigmoidf_(b.w); }
                        u32x4 w; w.x = cvtpk(a.x, a.y); w.y = cvtpk(a.z, a.w); w.z = cvtpk(b.x, b.y); w.w = cvtpk(b.z, b.w); *(u32x4*)(rp + 32 * bj) = w;
                    }
                }
        } else if (type == 2) {
            int nh, dv, vh, dbase;
            if (pn < 12) { nh = 8; dv = 128; vh = 2 * (pn - 8) + (wc >> 1); dbase = 64 * (wc & 1); } else { nh = 4; dv = 64; vh = wc; dbase = 0; }
#pragma unroll
            for (int ai = 0; ai < 2; ++ai)
#pragma unroll
                for (int m = 0; m < 4; ++m) {
                    const int row = row0 + ai * 128 + m * 16, b = row >> 12, t = row & (SEQ - 1);
                    bf16_t* bp = dst + ((size_t)(b * nh + vh) * dv + dbase + 8 * fq) * SEQ + perm16(t);
#pragma unroll
                    for (int bj = 0; bj < 2; ++bj)
#pragma unroll
                        for (int n = 0; n < 2; ++n) { const f32x4 v = acc[ai][bj][m][n]; bf16_t* q = bp + (size_t)(32 * bj + 4 * n) * SEQ;
                            q[0] = f2bf(v.x); q[SEQ] = f2bf(v.y); q[2 * SEQ] = f2bf(v.z); q[3 * SEQ] = f2bf(v.w); }
                }
        } else {
            float* NG = (float*)(ws + WS_NG);
            if (wc == 0) {
#pragma unroll
                for (int ai = 0; ai < 2; ++ai)
#pragma unroll
                    for (int m = 0; m < 4; ++m) {
                        const int row = row0 + ai * 128 + m * 16;
#pragma unroll
                        for (int bj = 0; bj < 2; ++bj)
#pragma unroll
                            for (int n = 0; n < 2; ++n) { const int L = 32 * bj + 8 * fq + 4 * n; if (L < 48) { const f32x4 v = acc[ai][bj][m][n];
                                f32x4 o; o.x = sigmoidf_(v.x); o.y = sigmoidf_(v.y); o.z = sigmoidf_(v.z); o.w = sigmoidf_(v.w); *(f32x4*)(NG + (size_t)row * 48 + L) = o; } }
                    }
            }
        }
    }
    unsigned char* mgp;
    __device__ __forceinline__ unsigned char* P_MG() const { return mgp; }
};
struct EpiHid {
    static constexpr bool PERM = true, AFTER_DRAIN = false;
    bf16_t* HID; const LAS float* pb;
    __device__ __forceinline__ void operator()(const f32x4 (&acc)[2][2][4][2], const pg8::Unit& u, int wr, int wc, int fr, int fq) const {
        const int row0 = u.pm * 256 + wr * 64 + fr, col0 = wc * 32 + 8 * fq;
#pragma unroll
        for (int ai = 0; ai < 2; ++ai)
#pragma unroll
            for (int m = 0; m < 4; ++m) { bf16_t* rp = HID + (size_t)(row0 + ai * 128 + m * 16) * 256 + col0;
#pragma unroll
                for (int bj = 0; bj < 2; ++bj) { const f32x4 b0 = *(const LAS f32x4*)(pb + col0 + 128 * bj), b1 = *(const LAS f32x4*)(pb + col0 + 128 * bj + 4);
                    const f32x4 a = acc[ai][bj][m][0] + b0, b = acc[ai][bj][m][1] + b1;
                    u32x4 w; w.x = cvtpk(gelu_tanh(a.x), gelu_tanh(a.y)); w.y = cvtpk(gelu_tanh(a.z), gelu_tanh(a.w)); w.z = cvtpk(gelu_tanh(b.x), gelu_tanh(b.y)); w.w = cvtpk(gelu_tanh(b.z), gelu_tanh(b.w));
                    *(u32x4*)(rp + 128 * bj) = w; asm volatile("" ::: "memory"); } }
    }
};
template <int MODE> struct EpiMerge {
    static constexpr bool PERM = false, AFTER_DRAIN = false;
    const bf16_t* MG; float* T1; bf16_t* MIXED;
    __device__ __forceinline__ void operator()(const f32x4 (&acc)[2][2][4][2], const pg8::Unit& u, int wr, int wc, int fr, int fq) const {
        const int row0 = u.pm * 256 + wr * 64 + fr, col0 = u.pn * 256 + wc * 32 + 4 * fq;
#pragma unroll
        for (int ai = 0; ai < 2; ++ai)
#pragma unroll
            for (int m = 0; m < 4; ++m) { const size_t row = row0 + ai * 128 + m * 16;
#pragma unroll
                for (int bj = 0; bj < 2; ++bj)
#pragma unroll
                    for (int n = 0; n < 2; ++n) { const int col = col0 + 128 * bj + 16 * n;
                        const u32x2 gw = *(const u32x2*)(MG + row * 2048 + MODE * 1024 + col);
                        f32x4 gt; gt.x = __uint_as_float(gw.x << 16); gt.y = __uint_as_float(gw.x & 0xffff0000u); gt.z = __uint_as_float(gw.y << 16); gt.w = __uint_as_float(gw.y & 0xffff0000u);
                        if (MODE == 0) { const f32x4 v = gt * acc[ai][bj][m][n]; u32x2 w; w.x = cvtpk(v.x, v.y); w.y = cvtpk(v.z, v.w); *(u32x2*)(MIXED + row * 1024 + col) = w; }
                        else { const u32x2 tw = *(const u32x2*)(MIXED + row * 1024 + col); f32x4 t1; t1.x = __uint_as_float(tw.x << 16); t1.y = __uint_as_float(tw.x & 0xffff0000u); t1.z = __uint_as_float(tw.y << 16); t1.w = __uint_as_float(tw.y & 0xffff0000u); const f32x4 v = t1 + gt * acc[ai][bj][m][n]; u32x2 w; w.x = cvtpk(v.x, v.y); w.y = cvtpk(v.z, v.w); *(u32x2*)(MIXED + row * 1024 + col) = w; }
                    } }
    }
};
struct EpiMerge2 {
    static constexpr bool PERM = false, AFTER_DRAIN = false;
    const bf16_t* MG; bf16_t* MIXED;
    template <int W> __device__ __forceinline__ void run(const f32x4 (&acc)[2][2][4][2], const pg8::Unit& u, int wr, int wc, int fr, int fq) const {
        const int row0 = (u.pm & 63) * 256 + wr * 64 + fr, col0 = (u.pn & 3) * 256 + wc * 32 + 4 * fq;
#pragma unroll
        for (int ai = 0; ai < 2; ++ai) {
            u32x2 gwv[4][2][2], twv[4][2][2];
#pragma unroll
            for (int m = 0; m < 4; ++m)
#pragma unroll
                for (int bj = 0; bj < 2; ++bj)
#pragma unroll
                    for (int n = 0; n < 2; ++n) { const size_t row = row0 + ai * 128 + m * 16; const int col = col0 + 128 * bj + 16 * n;
                        gwv[m][bj][n] = *(const u32x2*)(MG + row * 2048 + W * 1024 + col);
                        if (W) twv[m][bj][n] = *(const u32x2*)(MIXED + row * 1024 + col); }
            asm volatile("" ::: "memory");
#pragma unroll
            for (int m = 0; m < 4; ++m)
#pragma unroll
                for (int bj = 0; bj < 2; ++bj)
#pragma unroll
                    for (int n = 0; n < 2; ++n) { const size_t row = row0 + ai * 128 + m * 16; const int col = col0 + 128 * bj + 16 * n; const u32x2 gw = gwv[m][bj][n];
                        f32x4 gt; gt.x = __uint_as_float(gw.x << 16); gt.y = __uint_as_float(gw.x & 0xffff0000u); gt.z = __uint_as_float(gw.y << 16); gt.w = __uint_as_float(gw.y & 0xffff0000u);
                        f32x4 v = gt * acc[ai][bj][m][n];
                        if (W) { const u32x2 tw = twv[m][bj][n]; f32x4 t1; t1.x = __uint_as_float(tw.x << 16); t1.y = __uint_as_float(tw.x & 0xffff0000u); t1.z = __uint_as_float(tw.y << 16); t1.w = __uint_as_float(tw.y & 0xffff0000u); v = v + t1; }
                        u32x2 wv; wv.x = cvtpk(v.x, v.y); wv.y = cvtpk(v.z, v.w); *(u32x2*)(MIXED + row * 1024 + col) = wv; }
            asm volatile("" ::: "memory");
        }
    }
    __device__ __forceinline__ void operator()(const f32x4 (&acc)[2][2][4][2], const pg8::Unit& u, int wr, int wc, int fr, int fq) const {
        if ((u.pm >> 6) == 0) run<0>(acc, u, wr, wc, fr, fq); else run<1>(acc, u, wr, wc, fr, fq);
    }
};
struct TwoSched {
    pg8::StaticOrder S;
    __device__ __forceinline__ bool next(int i, pg8::Unit& u) const { pg8::Unit b; if (!S.next(i >> 1, b)) return false; const int w = i & 1; u.pm = b.pm + 64 * w; u.pn = b.pn + 4 * w; return true; }
    __device__ __forceinline__ void a_ready(const pg8::Unit&) const {}
    __device__ __forceinline__ void done(const pg8::Unit&) const {}
};
struct EpiRes1 {
    static constexpr bool PERM = false, AFTER_DRAIN = false;
    const float* x; float* out; bf16_t* XB1; float* PART;
    __device__ __forceinline__ void operator()(const f32x4 (&acc)[2][2][4][2], const pg8::Unit& u, int wr, int wc, int fr, int fq) const {
        const int row0 = u.pm * 256 + wr * 64 + fr, col0 = u.pn * 256 + wc * 32 + 4 * fq;
#pragma unroll
        for (int ai = 0; ai < 2; ++ai) {
            f32x4 xv[4][2][2];
#pragma unroll
            for (int m = 0; m < 4; ++m)
#pragma unroll
                for (int bj = 0; bj < 2; ++bj)
#pragma unroll
                    for (int n = 0; n < 2; ++n) xv[m][bj][n] = *(const f32x4*)(x + (size_t)(row0 + ai * 128 + m * 16) * 1024 + col0 + 128 * bj + 16 * n);
            asm volatile("" ::: "memory");
#pragma unroll
            for (int m = 0; m < 4; ++m) { const size_t row = row0 + ai * 128 + m * 16; float ss = 0.f;
#pragma unroll
                for (int bj = 0; bj < 2; ++bj)
#pragma unroll
                    for (int n = 0; n < 2; ++n) { const int col = col0 + 128 * bj + 16 * n;
                        const f32x4 v = xv[m][bj][n] + acc[ai][bj][m][n];
                        u32x2 w; w.x = cvtpk(v.x, v.y); w.y = cvtpk(v.z, v.w); *(u32x2*)(XB1 + row * 1024 + col) = w;
                        ss += (v.x * v.x + v.y * v.y) + (v.z * v.z + v.w * v.w); }
                ss += __shfl_xor(ss, 16); ss += __shfl_xor(ss, 32);
                if (fq == 0) PART[row * 16 + u.pn * 4 + wc] = ss; }
            asm volatile("" ::: "memory");
        }
    }
};
struct EpiUp {
    static constexpr bool PERM = true, AFTER_DRAIN = false;
    const float* PART; bf16_t* HB;
    __device__ __forceinline__ void operator()(const f32x4 (&acc)[2][2][4][2], const pg8::Unit& u, int wr, int wc, int fr, int fq) const {
        const int row0 = u.pm * 256 + wr * 64 + fr, col0 = u.pn * 256 + wc * 32 + 8 * fq;
#pragma unroll
        for (int ai = 0; ai < 2; ++ai)
#pragma unroll
            for (int m = 0; m < 4; ++m) { const size_t row = row0 + ai * 128 + m * 16;
                const f32x4* pp = (const f32x4*)(PART + row * 16); const f32x4 p0 = pp[0], p1 = pp[1], p2 = pp[2], p3 = pp[3];
                const float ss = ((p0.x + p0.y) + (p0.z + p0.w)) + ((p1.x + p1.y) + (p1.z + p1.w)) + ((p2.x + p2.y) + (p2.z + p2.w)) + ((p3.x + p3.y) + (p3.z + p3.w));
                const float rstd = rsqrtf(ss * (1.f / 1024.f) + EPS);
#pragma unroll
                for (int bj = 0; bj < 2; ++bj) { f32x4 a = acc[ai][bj][m][0] * rstd, b = acc[ai][bj][m][1] * rstd;
                    a.x = fmaxf(a.x, 0.f); a.y = fmaxf(a.y, 0.f); a.z = fmaxf(a.z, 0.f); a.w = fmaxf(a.w, 0.f); b.x = fmaxf(b.x, 0.f); b.y = fmaxf(b.y, 0.f); b.z = fmaxf(b.z, 0.f); b.w = fmaxf(b.w, 0.f);
                    a = a * a; b = b * b;
                    u32x4 w; w.x = cvtpk(a.x, a.y); w.y = cvtpk(a.z, a.w); w.z = cvtpk(b.x, b.y); w.w = cvtpk(b.z, b.w); *(u32x4*)(HB + row * 4096 + col0 + 128 * bj) = w; } }
    }
};
struct EpiRes2 {
    static constexpr bool PERM = false, AFTER_DRAIN = false;
    float* out; float scale; const bf16_t* XB1;
    __device__ __forceinline__ void operator()(const f32x4 (&acc)[2][2][4][2], const pg8::Unit& u, int wr, int wc, int fr, int fq) const {
        const int row0 = u.pm * 256 + wr * 64 + fr, col0 = u.pn * 256 + wc * 32 + 4 * fq;
#pragma unroll
        for (int ai = 0; ai < 2; ++ai) {
            u32x2 xw[4][2][2];
#pragma unroll
            for (int m = 0; m < 4; ++m)
#pragma unroll
                for (int bj = 0; bj < 2; ++bj)
#pragma unroll
                    for (int n = 0; n < 2; ++n) xw[m][bj][n] = *(const u32x2*)(XB1 + (size_t)(row0 + ai * 128 + m * 16) * 1024 + col0 + 128 * bj + 16 * n);
            asm volatile("" ::: "memory");
#pragma unroll
            for (int m = 0; m < 4; ++m)
#pragma unroll
                for (int bj = 0; bj < 2; ++bj)
#pragma unroll
                    for (int n = 0; n < 2; ++n) { const size_t off = (size_t)(row0 + ai * 128 + m * 16) * 1024 + col0 + 128 * bj + 16 * n; const u32x2 w = xw[m][bj][n];
                        f32x4 x1; x1.x = __uint_as_float(w.x << 16); x1.y = __uint_as_float(w.x & 0xffff0000u); x1.z = __uint_as_float(w.y << 16); x1.w = __uint_as_float(w.y & 0xffff0000u);
                        *(f32x4*)(out + off) = x1 + acc[ai][bj][m][n] * scale; }
            asm volatile("" ::: "memory");
        }
    }
};
struct OneUnit {
    int pm, pn;
    __device__ bool next(int i, pg8::Unit& u) const { if (i > 0) return false; u.pm = pm; u.pn = pn; return true; }
    __device__ __forceinline__ void a_ready(const pg8::Unit&) const {}
    __device__ __forceinline__ void done(const pg8::Unit&) const {}
};

#define MFMA32(a, b, c) __builtin_amdgcn_mfma_f32_32x32x16_bf16((a), (b), (c), 0, 0, 0)
#define EXP2(x) __builtin_amdgcn_exp2f(x)

__device__ __forceinline__ void load_q(const bf16_t* qrow, int hi, bf16x8 (&qf)[4]) {
#pragma unroll
    for (int ds = 0; ds < 4; ++ds) qf[ds] = *(const bf16x8*)(qrow + 16 * ds + 8 * hi);
    asm volatile("" : "+v"(qf[0]), "+v"(qf[1]), "+v"(qf[2]), "+v"(qf[3]));
}
template <int KROW>
__device__ __forceinline__ void qk_tile(const LAS bf16_t* Kt, const bf16x8 (&qf)[4], f32x16 (&s)[2], int r32, int hi) {
#pragma unroll
    for (int kb = 0; kb < 2; ++kb) {
        f32x16 a = {};
#pragma unroll
        for (int ds = 0; ds < 4; ++ds) { const bf16x8 kf = *(const LAS bf16x8*)(Kt + (32 * kb + r32) * KROW + 16 * ds + 8 * hi); a = MFMA32(kf, qf[ds], a); }
        s[kb] = a;
    }
}
template <int DV, int VROW>
__device__ __forceinline__ void pv_tile(const LAS bf16_t* Vt, const f32x16 (&p)[2], f32x16 (&o)[DV / 32], int r32, int hi) {
    bf16x8 pb[4];
#pragma unroll
    for (int j = 0; j < 4; ++j) { const int kb = j >> 1, r0 = 8 * (j & 1); u32x4 w; w.x = cvtpk(p[kb][r0], p[kb][r0 + 1]); w.y = cvtpk(p[kb][r0 + 2], p[kb][r0 + 3]); w.z = cvtpk(p[kb][r0 + 4], p[kb][r0 + 5]); w.w = cvtpk(p[kb][r0 + 6], p[kb][r0 + 7]); pb[j] = __builtin_bit_cast(bf16x8, w); }
#pragma unroll
    for (int db = 0; db < DV / 32; ++db) {
        bf16x8 vf[4];
#pragma unroll
        for (int j = 0; j < 4; ++j) vf[j] = *(const LAS bf16x8*)(Vt + (32 * db + r32) * VROW + 16 * j + 8 * hi);
#pragma unroll
        for (int j = 0; j < 4; ++j) o[db] = MFMA32(vf[j], pb[j], o[db]);
        __builtin_amdgcn_sched_barrier(0);
    }
}
template <int DV, class TF>
__device__ __forceinline__ void attn_loop(LAS unsigned char* lds, const bf16_t* Kg, int ldk, const bf16_t* VTg, int ldv, unsigned long long tmask,
                                          const bf16x8 (&qf)[4], f32x16 (&o)[DV / 32], float& m, float& l, const TF& tf) {
    const int tid = threadIdx.x, lane = tid & 63, r32 = lane & 31, hi = lane >> 5, srow = tid >> 3, sch = tid & 7;
    u32x4 kreg, vreg[DV / 64];
    int buf = 0;
    if (tmask) { const int t = __builtin_ctzll(tmask); kreg = *(const u32x4*)(Kg + (size_t)(64 * t + srow) * ldk + sch * 8);
#pragma unroll
        for (int i = 0; i < DV / 64; ++i) vreg[i] = *(const u32x4*)(VTg + (size_t)(srow + 64 * i) * ldv + 64 * t + sch * 8); }
    while (tmask) {
        const int t = __builtin_ctzll(tmask); tmask &= tmask - 1;
        LAS bf16_t* Kt = (LAS bf16_t*)(lds + buf * ABUF); LAS bf16_t* Vt = Kt + 64 * TROW;
        *(LAS u32x4*)(Kt + srow * TROW + sch * 8) = kreg;
#pragma unroll
        for (int i = 0; i < DV / 64; ++i) *(LAS u32x4*)(Vt + (srow + 64 * i) * TROW + sch * 8) = vreg[i];
        __syncthreads();
        if (tmask) { const int tn = __builtin_ctzll(tmask); kreg = *(const u32x4*)(Kg + (size_t)(64 * tn + srow) * ldk + sch * 8);
#pragma unroll
            for (int i = 0; i < DV / 64; ++i) vreg[i] = *(const u32x4*)(VTg + (size_t)(srow + 64 * i) * ldv + 64 * tn + sch * 8); }
        const int md = tf.mode(t);
        if (md) {
            f32x16 s[2];
            qk_tile<TROW>(Kt, qf, s, r32, hi);
            if (md == 2) {
                const int lim_hi = tf.lim_hi(t), lim_lo = tf.lim_lo(t);
#pragma unroll
                for (int kb = 0; kb < 2; ++kb)
#pragma unroll
                    for (int r = 0; r < 16; ++r) { const int kc_ = 32 * kb + (r & 3) + 8 * (r >> 2); if (kc_ > lim_hi || kc_ < lim_lo) s[kb][r] = -INFINITY; }
            }
            float mx = fmaxf(s[0][0], s[1][0]);
#pragma unroll
            for (int r = 1; r < 16; ++r) mx = fmaxf(mx, fmaxf(s[0][r], s[1][r]));
            mx = fmaxf(mx, __shfl_xor(mx, 32));
            const float mn = fmaxf(m, mx), alpha = EXP2(m - mn); m = mn;
            float rs = 0.f;
#pragma unroll
            for (int kb = 0; kb < 2; ++kb)
#pragma unroll
                for (int r = 0; r < 16; ++r) { const float e = EXP2(s[kb][r] - mn); s[kb][r] = e; rs += e; }
            l = l * alpha + rs;
            if (!__all(alpha == 1.0f)) {
#pragma unroll
                for (int db = 0; db < DV / 32; ++db) o[db] = o[db] * alpha;
            }
            pv_tile<DV, TROW>(Vt, s, o, r32, hi);
        }
        buf ^= 1;
    }
    __syncthreads();
}


template <int DV, bool LSEL, class TF>
__device__ __forceinline__ void attn_loop_fast(LAS unsigned char* lds, const bf16_t* Kg, int ldk, const bf16_t* VTg, int ldv, unsigned long long tmask,
                                               const bf16x8 (&qf)[4], f32x16 (&o)[DV / 32], f32x4& lsum, const TF& tf) {
    constexpr int ABF = (64 + DV) * TROW * 2;
    const int tid = threadIdx.x, lane = tid & 63, r32 = lane & 31, hi = lane >> 5, srow = tid >> 3, sch = tid & 7;
    if (!tmask) return;
    u32x4 kreg, vreg[DV / 64];
#define AF_LOAD(t) do { kreg = *(const u32x4*)(Kg + (size_t)(64 * (t) + srow) * ldk + sch * 8); _Pragma("unroll") for (int i_ = 0; i_ < DV / 64; ++i_) vreg[i_] = *(const u32x4*)(VTg + (size_t)(srow + 64 * i_) * ldv + 64 * (t) + sch * 8); } while (0)
#define AF_STORE(b) do { LAS bf16_t* Kt_ = (LAS bf16_t*)(lds + (b) * ABF); *(LAS u32x4*)(Kt_ + srow * TROW + sch * 8) = kreg; _Pragma("unroll") for (int i_ = 0; i_ < DV / 64; ++i_) *(LAS u32x4*)(Kt_ + 64 * TROW + (srow + 64 * i_) * TROW + sch * 8) = vreg[i_]; } while (0)
    int tc = __builtin_ctzll(tmask); tmask &= tmask - 1;
    AF_LOAD(tc); AF_STORE(0);
    int tn = -1; if (tmask) { tn = __builtin_ctzll(tmask); tmask &= tmask - 1; AF_LOAD(tn); }
    __syncthreads();
    f32x16 sA[2], sB[2];
    int bc = 0;
    if (tf.mode(tc)) qk_tile<TROW>((const LAS bf16_t*)(lds), qf, sA, r32, hi);
#define AF_STEP(scur, snxt) do { \
        const int bn = (bc == 2) ? 0 : bc + 1; \
        if (tn >= 0) AF_STORE(bn); \
        __syncthreads(); \
        int tnn = -1; if (tmask) { tnn = __builtin_ctzll(tmask); tmask &= tmask - 1; AF_LOAD(tnn); } \
        if (tn >= 0 && tf.mode(tn)) qk_tile<TROW>((const LAS bf16_t*)(lds + bn * ABF), qf, snxt, r32, hi); \
        const int md = tf.mode(tc); \
        if (md) { \
            _Pragma("unroll") for (int kb = 0; kb < 2; ++kb) _Pragma("unroll") for (int r = 0; r < 16; ++r) scur[kb][r] = EXP2(scur[kb][r]); \
            if (md == 2) { const int lim_hi = tf.lim_hi(tc), lim_lo = tf.lim_lo(tc); _Pragma("unroll") for (int kb = 0; kb < 2; ++kb) _Pragma("unroll") for (int r = 0; r < 16; ++r) { const int kc_ = 32 * kb + (r & 3) + 8 * (r >> 2); if (kc_ > lim_hi || kc_ < lim_lo) scur[kb][r] = 0.f; } } \
            bf16x8 pb[4]; \
            if constexpr (LSEL) { const bool sel = tf.lanesel(tc); const float sm = sel ? 1.f : 0.f; const unsigned am = sel ? 0xffffffffu : 0u; { const f32x16 t16_ = scur[0] + scur[1]; const f32x8 t8_ = t16_.lo + t16_.hi; lsum = lsum + (t8_.lo + t8_.hi) * sm; } \
                _Pragma("unroll") for (int j = 0; j < 4; ++j) { const int kb = j >> 1, r0 = 8 * (j & 1); u32x4 w; w.x = cvtpk(scur[kb][r0], scur[kb][r0 + 1]) & am; w.y = cvtpk(scur[kb][r0 + 2], scur[kb][r0 + 3]) & am; w.z = cvtpk(scur[kb][r0 + 4], scur[kb][r0 + 5]) & am; w.w = cvtpk(scur[kb][r0 + 6], scur[kb][r0 + 7]) & am; pb[j] = __builtin_bit_cast(bf16x8, w); } \
            } else { { const f32x16 t16_ = scur[0] + scur[1]; const f32x8 t8_ = t16_.lo + t16_.hi; lsum = lsum + (t8_.lo + t8_.hi); } \
                _Pragma("unroll") for (int j = 0; j < 4; ++j) { const int kb = j >> 1, r0 = 8 * (j & 1); u32x4 w; w.x = cvtpk(scur[kb][r0], scur[kb][r0 + 1]); w.y = cvtpk(scur[kb][r0 + 2], scur[kb][r0 + 3]); w.z = cvtpk(scur[kb][r0 + 4], scur[kb][r0 + 5]); w.w = cvtpk(scur[kb][r0 + 6], scur[kb][r0 + 7]); pb[j] = __builtin_bit_cast(bf16x8, w); } } \
            const LAS bf16_t* Vt_ = (const LAS bf16_t*)(lds + bc * ABF) + 64 * TROW; \
            _Pragma("unroll") for (int db = 0; db < DV / 32; ++db) { bf16x8 vf[4]; \
                _Pragma("unroll") for (int j = 0; j < 4; ++j) vf[j] = *(const LAS bf16x8*)(Vt_ + (32 * db + r32) * TROW + 16 * j + 8 * hi); \
                _Pragma("unroll") for (int j = 0; j < 4; ++j) o[db] = MFMA32(vf[j], pb[j], o[db]); } \
        } \
        tc = tn; tn = tnn; bc = bn; \
    } while (0)
    for (;;) {
        AF_STEP(sA, sB); if (tc < 0) break;
        AF_STEP(sB, sA); if (tc < 0) break;
    }
    __syncthreads();
#undef AF_LOAD
#undef AF_STORE
#undef AF_STEP
}
__device__ __forceinline__ float hsum4(const f32x4& v) { return (v[0] + v[1]) + (v[2] + v[3]); }

struct DiffTF { int qlo, qpos, hi4; __device__ __forceinline__ int mode(int t) const { return 64 * t > qlo + 31 ? 0 : (64 * t + 63 > qlo ? 2 : 1); }
    __device__ __forceinline__ int lim_hi(int t) const { return qpos - 64 * t - hi4; } __device__ __forceinline__ int lim_lo(int t) const { return -(1 << 30); } };
template <bool FAST>
__device__ __forceinline__ void diff_unit(const Params& P, LAS unsigned char* lds, int b, int h, int qb, float lam, bool dry) {
    const int tid = threadIdx.x, lane = tid & 63, wave = tid >> 6, r32 = lane & 31, hi = lane >> 5;
    unsigned char* ws = P.ws;
    const int q0 = qb * 256, qpos = q0 + 32 * wave + r32;
    bf16_t* DQ = (bf16_t*)(ws + WS_DQ); const bf16_t* DK = (const bf16_t*)(ws + WS_DK); const bf16_t* DVT = (const bf16_t*)(ws + WS_DVT);
    bf16_t* qrow = DQ + (size_t)(b * SEQ + qpos) * 1024 + h * 128;
    const unsigned long long tmask = (qb == 15) ? ~0ull : ((1ull << (4 * qb + 4)) - 1ull);
    DiffTF tf; tf.qlo = q0 + 32 * wave; tf.qpos = qpos; tf.hi4 = 4 * hi;
    LAS unsigned* o0p = (LAS unsigned*)(lds + L_O0P) + wave * 32 * 64 + lane;
    f32x16 o0[4];
#pragma unroll
    for (int c = 0; c < 2; ++c) {
        bf16x8 qf[4]; load_q(qrow + 64 * c, hi, qf);
        f32x16 o[4];
#pragma unroll
        for (int db = 0; db < 4; ++db) o[db] = (f32x16){};
        float m = -1e30f, l = 0.f;
        if (FAST) { f32x4 ls = {}; attn_loop_fast<128, false, DiffTF>(lds, DK + (size_t)b * SEQ * 1024 + (h * 2 + c) * 64, 1024, DVT + (size_t)((b * 8 + h) * 128) * SEQ, SEQ, tmask, qf, o, ls, tf); l = hsum4(ls); }
        else attn_loop<128, DiffTF>(lds, DK + (size_t)b * SEQ * 1024 + (h * 2 + c) * 64, 1024, DVT + (size_t)((b * 8 + h) * 128) * SEQ, SEQ, tmask, qf, o, m, l, tf);
        l += __shfl_xor(l, 32);
        const float inv = 1.0f / fmaxf(l, 1e-30f);
        if (c == 0) {
#pragma unroll
            for (int db = 0; db < 4; ++db)
#pragma unroll
                for (int r = 0; r < 8; ++r) o0p[(db * 8 + r) * 64] = cvtpk(o[db][2 * r] * inv, o[db][2 * r + 1] * inv);
        } else {
            const float il = inv * lam;
#pragma unroll
            for (int db = 0; db < 4; ++db)
#pragma unroll
                for (int r = 0; r < 8; ++r) { const unsigned pw = o0p[(db * 8 + r) * 64]; o0[db][2 * r] = __uint_as_float(pw << 16) - o[db][2 * r] * il; o0[db][2 * r + 1] = __uint_as_float(pw & 0xffff0000u) - o[db][2 * r + 1] * il; }
        }
    }
    float ss = 0.f;
#pragma unroll
    for (int db = 0; db < 4; ++db)
#pragma unroll
        for (int r = 0; r < 16; ++r) ss += o0[db][r] * o0[db][r];
    ss += __shfl_xor(ss, 32);
    const float rstd = rsqrtf(ss * (1.f / 128.f) + EPS) * 0.8f;
    const float* sg = P.in[9];
#pragma unroll
    for (int db = 0; db < 4; ++db)
#pragma unroll
        for (int u = 0; u < 4; ++u) { const int d = 32 * db + 8 * u + 4 * hi; const f32x4 g4 = *(const f32x4*)(sg + d);
            u32x2 w; w.x = cvtpk(o0[db][4 * u] * rstd * g4.x, o0[db][4 * u + 1] * rstd * g4.y); w.y = cvtpk(o0[db][4 * u + 2] * rstd * g4.z, o0[db][4 * u + 3] * rstd * g4.w);
            if (!dry) *(u32x2*)(qrow + d) = w; }
}

__device__ __forceinline__ void compress_unit(const Params& P, LAS unsigned char* lds, int which, int pm) {
    unsigned char* ws = P.ws;
    bf16_t* HID = (bf16_t*)(ws + WS_HID) + (size_t)which * 4096 * 256;
    {
        pg8::Gemm g = pg8::make_gemm((const bf16_t*)(ws + (which ? WS_VC : WS_KC)), (const bf16_t*)(ws + WS_W1T) + (size_t)which * 256 * 2048, 4096, 256, 2048);
        g.lda = 4096; g.kstepA = 512; g.a_sh = 2; g.a_lo = (size_t)256 * 4096 * 2; g.a_hi = 128;
        LAS float* pbs = (LAS float*)(lds + 131072);
        if (threadIdx.x < 256) { const float* pp = (const float*)(ws + WS_PB) + which * 16 * 256 + threadIdx.x; float sacc = 0.f;
#pragma unroll
            for (int kc = 0; kc < 16; ++kc) sacc += pp[kc * 256];
            pbs[threadIdx.x] = sacc; }
        __syncthreads();
        OneUnit S{pm, 0}; EpiHid E{HID, pbs};
        pg8::gemm_phase<EpiHid, OneUnit, false, true>((PG8_LAS unsigned char*)lds, g, S, E);
    }
    __threadfence(); __syncthreads(); __threadfence();
    int tid = threadIdx.x; asm volatile("" : "+v"(tid));
    const int lane = tid & 63, wave = tid >> 6, r32 = lane & 31, hi = lane >> 5;
    const bf16_t* W2T = (const bf16_t*)(ws + WS_W2T) + which * 64 * 256;
    const int rowl = 32 * wave + r32; const bf16_t* hrow = HID + (size_t)(pm * 256 + rowl) * 256;
    f32x16 c0 = {}, c1 = {};
#pragma unroll 2
    for (int ks = 0; ks < 16; ++ks) {
        const bf16x8 a0 = *(const bf16x8*)(W2T + r32 * 256 + 16 * ks + 8 * hi), a1 = *(const bf16x8*)(W2T + (32 + r32) * 256 + 16 * ks + 8 * hi), bf = *(const bf16x8*)(hrow + 16 * ks + 8 * hi);
        c0 = MFMA32(a0, bf, c0); c1 = MFMA32(a1, bf, c1);
    }
    const int g = pm >> 2, b = pm & 3, n = rowl;
    if (which == 0) {
        float ss = 0.f;
#pragma unroll
        for (int r = 0; r < 16; ++r) ss += c0[r] * c0[r] + c1[r] * c1[r];
        ss += __shfl_xor(ss, 32);
        const float rstd = (n < 255) ? rsqrtf(ss * (1.f / 64.f) + EPS) : 0.f;
        const float* gk = P.in[11]; const float* CC = (const float*)(ws + WS_CCOS) + n * 32; const float* CS = (const float*)(ws + WS_CSIN) + n * 32;
        bf16_t* kr = (bf16_t*)(ws + WS_KCMP) + (size_t)((b * 4 + g) * 256 + n) * 64;
#pragma unroll
        for (int u = 0; u < 4; ++u) { const int i = 8 * u + 4 * hi; const f32x4 g1 = *(const f32x4*)(gk + i), g2 = *(const f32x4*)(gk + 32 + i), cc = *(const f32x4*)(CC + i), sn = *(const f32x4*)(CS + i);
            float o1[4], o2[4];
#pragma unroll
            for (int j = 0; j < 4; ++j) { const float x1 = c0[4 * u + j] * rstd * g1[j], x2 = c1[4 * u + j] * rstd * g2[j]; o1[j] = x1 * cc[j] - x2 * sn[j]; o2[j] = x2 * cc[j] + x1 * sn[j]; }
            u32x2 w; w.x = cvtpk(o1[0], o1[1]); w.y = cvtpk(o1[2], o1[3]); *(u32x2*)(kr + i) = w; w.x = cvtpk(o2[0], o2[1]); w.y = cvtpk(o2[2], o2[3]); *(u32x2*)(kr + 32 + i) = w; }
    } else {
        bf16_t* vt = (bf16_t*)(ws + WS_VCMPT) + (size_t)((b * 4 + g) * 64) * 256 + perm16(n);
        const float z = (n < 255) ? 1.f : 0.f;
#pragma unroll
        for (int r = 0; r < 16; ++r) { const int d = crow(r, hi); vt[(size_t)d * 256] = f2bf(c0[r] * z); vt[(size_t)(d + 32) * 256] = f2bf(c1[r] * z); }
    }
}

struct SlcTF { unsigned long long mymask, wu; int qpos, hi4; __device__ __forceinline__ int mode(int t) const { return ((wu >> t) & 1ull) ? 2 : 0; }
    __device__ __forceinline__ int lim_hi(int t) const { return ((mymask >> t) & 1ull) ? qpos - 64 * t - hi4 : -(1 << 30); } __device__ __forceinline__ int lim_lo(int t) const { return -(1 << 30); } };
struct SlcTFF { unsigned long long mymask, wu; int qpos, c, hi4; __device__ __forceinline__ int mode(int t) const { return ((wu >> t) & 1ull) ? (t == c ? 2 : 1) : 0; }
    __device__ __forceinline__ bool lanesel(int t) const { return (mymask >> t) & 1ull; }
    __device__ __forceinline__ int lim_hi(int t) const { return qpos - 64 * t - hi4; } __device__ __forceinline__ int lim_lo(int t) const { return -(1 << 30); } };
struct WinTF { int c, qpos, hi4; __device__ __forceinline__ int mode(int t) const { return (t == c || t == c - 8) ? 2 : 1; }
    __device__ __forceinline__ int lim_hi(int t) const { return qpos - 64 * t - hi4; } __device__ __forceinline__ int lim_lo(int t) const { return qpos - 511 - 64 * t - hi4; } };
template <bool FAST>
__device__ __forceinline__ void nsa_unit(const Params& P, LAS unsigned char* lds, int b, int g, int c, bool dry) {
    const int tid = threadIdx.x, lane = tid & 63, wave = tid >> 6, r32 = lane & 31, hi = lane >> 5;
    unsigned char* ws = P.ws;
    const int q0 = 64 * c, tk = r32 >> 2, hg = r32 & 3, tokl = 8 * wave + tk, qpos = q0 + tokl;
    bf16_t* qrow = (bf16_t*)(ws + WS_NQ) + (size_t)(b * SEQ + qpos) * 1024 + (g * 4 + hg) * 64;
    bf16x8 qf[4]; load_q(qrow, hi, qf);
    const float* ngp = (const float*)(ws + WS_NG) + (size_t)(b * SEQ + qpos) * 48 + (g * 4 + hg) * 3;
    const float gate0 = ngp[0], gate1 = ngp[1], gate2 = ngp[2];
    f32x16 yt[2]; yt[0] = (f32x16){}; yt[1] = (f32x16){};
    const int ntl = (4 * c + 2) / 64 + 1;
    LAS bf16_t* CK = (LAS bf16_t*)(lds + L_CK); LAS bf16_t* CV = (LAS bf16_t*)(lds + L_CV);
    LAS float* IMP = (LAS float*)(lds + L_IMP); LAS unsigned long long* SEL = (LAS unsigned long long*)(lds + L_SEL);
    {
        const bf16_t* kc = (const bf16_t*)(ws + WS_KCMP) + (size_t)((b * 4 + g) * 256) * 64; const bf16_t* vc = (const bf16_t*)(ws + WS_VCMPT) + (size_t)((b * 4 + g) * 64) * 256;
        u32x4 kr[4], vr[4]; const int srow = tid >> 3, sch = tid & 7;
#pragma unroll
        for (int it = 0; it < 4; ++it) if (it < ntl) { kr[it] = *(const u32x4*)(kc + (64 * it + srow) * 64 + sch * 8); vr[it] = *(const u32x4*)(vc + srow * 256 + (sch + 8 * it) * 8); }
#pragma unroll
        for (int it = 0; it < 4; ++it) if (it < ntl) { *(LAS u32x4*)(CK + (64 * it + srow) * CKROW + sch * 8) = kr[it]; *(LAS u32x4*)(CV + srow * CVROW + (sch + 8 * it) * 8) = vr[it]; }
    }
    __syncthreads();
    if constexpr (FAST) {
        const int nlim = ((qpos - 31) >> 4) - 4 * hi;
        f32x16 o[2]; o[0] = (f32x16){}; o[1] = (f32x16){};
        float lrow = 0.f, carry = 0.f; float ivq[4][8];
#pragma unroll
        for (int T = 0; T < 4; ++T) {
#pragma unroll
            for (int i = 0; i < 8; ++i) ivq[T][i] = 0.f;
            if (T < ntl) {
                f32x16 s[2]; qk_tile<CKROW>(CK + T * 64 * CKROW, qf, s, r32, hi);
#pragma unroll
                for (int kb = 0; kb < 2; ++kb)
#pragma unroll
                    for (int r = 0; r < 16; ++r) { const int kc_ = 32 * kb + (r & 3) + 8 * (r >> 2); const float e = EXP2(s[kb][r]); s[kb][r] = (kc_ > nlim - 64 * T) ? 0.f : e; }
#pragma unroll
                for (int kb = 0; kb < 2; ++kb)
#pragma unroll
                    for (int u = 0; u < 4; ++u) {
                        const float qs = (s[kb][4 * u] + s[kb][4 * u + 1]) + (s[kb][4 * u + 2] + s[kb][4 * u + 3]);
                        lrow += qs;
                        const float x = __shfl_xor(s[kb][4 * u + 3], 32);
                        ivq[T][kb * 4 + u] = qs + (hi ? x : carry); carry = x;
                    }
                pv_tile<64, CVROW>(CV + 64 * T, s, o, r32, hi);
            }
        }
        lrow += __shfl_xor(lrow, 32);
        const float invl = 1.0f / fmaxf(lrow, 1e-30f);
#pragma unroll
        for (int T = 0; T < 4; ++T)
            if (T < ntl) {
#pragma unroll
                for (int i = 0; i < 8; ++i) { float iv = ivq[T][i] * invl; iv += __shfl_xor(iv, 1); iv += __shfl_xor(iv, 2); if (hg == 0) IMP[tokl * 64 + 16 * T + 2 * i + hi] = iv; }
            }
        const float gs = gate0 * invl;
#pragma unroll
        for (int db = 0; db < 2; ++db) yt[db] = o[db] * gs;
    } else {
        const int nlim = ((qpos - 31) >> 4) - 4 * hi;
        float m = -1e30f, l = 0.f;
        for (int T = 0; T < ntl; ++T) {
            f32x16 s[2]; qk_tile<CKROW>(CK + T * 64 * CKROW, qf, s, r32, hi);
            float mx = -INFINITY;
#pragma unroll
            for (int kb = 0; kb < 2; ++kb)
#pragma unroll
                for (int r = 0; r < 16; ++r) { const int kc_ = 32 * kb + (r & 3) + 8 * (r >> 2); if (kc_ > nlim - 64 * T) s[kb][r] = -INFINITY; mx = fmaxf(mx, s[kb][r]); }
            mx = fmaxf(mx, __shfl_xor(mx, 32));
            const float mn = fmaxf(m, mx), alpha = EXP2(m - mn); m = mn; float rs = 0.f;
#pragma unroll
            for (int kb = 0; kb < 2; ++kb)
#pragma unroll
                for (int r = 0; r < 16; ++r) rs += EXP2(s[kb][r] - mn);
            l = l * alpha + rs;
        }
        l += __shfl_xor(l, 32);
        const float invl = 1.0f / fmaxf(l, 1e-30f);
        f32x16 o[2]; o[0] = (f32x16){}; o[1] = (f32x16){};
        float carry = 0.f;
        for (int T = 0; T < ntl; ++T) {
            f32x16 s[2]; qk_tile<CKROW>(CK + T * 64 * CKROW, qf, s, r32, hi);
#pragma unroll
            for (int kb = 0; kb < 2; ++kb)
#pragma unroll
                for (int r = 0; r < 16; ++r) { const int kc_ = 32 * kb + (r & 3) + 8 * (r >> 2); s[kb][r] = (kc_ > nlim - 64 * T) ? 0.f : EXP2(s[kb][r] - m) * invl; }
#pragma unroll
            for (int kb = 0; kb < 2; ++kb)
#pragma unroll
                for (int u = 0; u < 4; ++u) {
                    const float qs = (s[kb][4 * u] + s[kb][4 * u + 1]) + (s[kb][4 * u + 2] + s[kb][4 * u + 3]);
                    const float x = __shfl_xor(s[kb][4 * u + 3], 32);
                    float iv = qs + (hi ? x : carry); carry = x;
                    iv += __shfl_xor(iv, 1); iv += __shfl_xor(iv, 2);
                    if (hg == 0) IMP[tokl * 64 + 16 * T + 8 * kb + 2 * u + hi] = iv;
                }
            pv_tile<64, CVROW>(CV + 64 * T, s, o, r32, hi);
        }
#pragma unroll
        for (int db = 0; db < 2; ++db) yt[db] = o[db] * gate0;
    }
    __syncthreads();
    LAS float* yst = (LAS float*)(lds + L_CK) + tid;
#pragma unroll
    for (int db = 0; db < 2; ++db)
#pragma unroll
        for (int r = 0; r < 16; ++r) yst[(db * 16 + r) * NTHREADS] = yt[db][r];
    for (int i = 0; i < 8; ++i) {
        const int tl = 8 * wave + i; const int j = lane;
        const bool forced = (j == 0) || (j == c) || (j == c - 1);
        const float v = forced ? 1e4f : IMP[tl * 64 + j];
        const bool okj = (j <= c);
        const unsigned key = okj ? (__float_as_uint(v) + 1u) : 0u;
        unsigned thr = 0u;
        for (int bit = 31; bit >= 0; --bit) { const unsigned cand = thr | (1u << bit); if (__popcll(__ballot(key >= cand)) >= 16) thr = cand; }
        const unsigned long long gtm = __ballot(key > thr), eqm = __ballot(key == thr);
        const int need = 16 - __popcll(gtm);
        const bool selj = (key > thr) || (key == thr && __popcll(eqm & ((1ull << j) - 1ull)) < need);
        const unsigned long long msk = __ballot(selj && okj);
        if (lane == 0) SEL[tl] = msk;
    }
    __syncthreads();
    unsigned long long mymask = SEL[tokl], wu = 0ull;
#pragma unroll
    for (int i = 0; i < 8; ++i) wu |= SEL[8 * wave + i];
    {
        SlcTF tf; tf.mymask = mymask; tf.wu = wu; tf.qpos = qpos; tf.hi4 = 4 * hi;
        const unsigned long long tmask = (c == 63) ? ~0ull : ((1ull << (c + 1)) - 1ull);
        f32x16 o[2]; o[0] = (f32x16){}; o[1] = (f32x16){}; float m = -1e30f, l = 0.f;
        if (FAST) { SlcTFF tff; tff.mymask = mymask; tff.wu = wu; tff.qpos = qpos; tff.c = c; tff.hi4 = 4 * hi; f32x4 ls = {};
            attn_loop_fast<64, true, SlcTFF>(lds, (const bf16_t*)(ws + WS_KSL) + (size_t)b * SEQ * 256 + g * 64, 256, (const bf16_t*)(ws + WS_VSLT) + (size_t)((b * 4 + g) * 64) * SEQ, SEQ, tmask, qf, o, ls, tff); l = hsum4(ls); }
        else attn_loop<64, SlcTF>(lds, (const bf16_t*)(ws + WS_KSL) + (size_t)b * SEQ * 256 + g * 64, 256, (const bf16_t*)(ws + WS_VSLT) + (size_t)((b * 4 + g) * 64) * SEQ, SEQ, tmask, qf, o, m, l, tf);
        l += __shfl_xor(l, 32); const float sc = gate1 / fmaxf(l, 1e-30f);
#pragma unroll
        for (int db = 0; db < 2; ++db)
#pragma unroll
            for (int r = 0; r < 16; ++r) yst[(db * 16 + r) * NTHREADS] += o[db][r] * sc;
    }
    {
        WinTF tf; tf.c = c; tf.qpos = qpos; tf.hi4 = 4 * hi;
        const int tlo = c >= 8 ? c - 8 : 0;
        const unsigned long long hi_m = (c == 63) ? ~0ull : ((1ull << (c + 1)) - 1ull), tmask = hi_m & ~((1ull << tlo) - 1ull);
        f32x16 o[2]; o[0] = (f32x16){}; o[1] = (f32x16){}; float m = -1e30f, l = 0.f;
        if (FAST) { f32x4 ls = {}; attn_loop_fast<64, false, WinTF>(lds, (const bf16_t*)(ws + WS_KWN) + (size_t)b * SEQ * 256 + g * 64, 256, (const bf16_t*)(ws + WS_VWNT) + (size_t)((b * 4 + g) * 64) * SEQ, SEQ, tmask, qf, o, ls, tf); l = hsum4(ls); }
        else attn_loop<64, WinTF>(lds, (const bf16_t*)(ws + WS_KWN) + (size_t)b * SEQ * 256 + g * 64, 256, (const bf16_t*)(ws + WS_VWNT) + (size_t)((b * 4 + g) * 64) * SEQ, SEQ, tmask, qf, o, m, l, tf);
        l += __shfl_xor(l, 32); const float sc = gate2 / fmaxf(l, 1e-30f);
#pragma unroll
        for (int db = 0; db < 2; ++db)
#pragma unroll
            for (int r = 0; r < 16; ++r) yt[db][r] = yst[(db * 16 + r) * NTHREADS] + o[db][r] * sc;
    }
#pragma unroll
    for (int db = 0; db < 2; ++db)
#pragma unroll
        for (int u = 0; u < 4; ++u) { const int d = 32 * db + 8 * u + 4 * hi; u32x2 w; w.x = cvtpk(yt[db][4 * u], yt[db][4 * u + 1]); w.y = cvtpk(yt[db][4 * u + 2], yt[db][4 * u + 3]); if (!dry) *(u32x2*)(qrow + d) = w; }
}

#define XB_TMO      128
#define XB_XCNT(j)  (256  + 64 * (j))
#define XB_XSUB(j)  (1280 + 64 * (j))
#define XB_XGEN(j)  (2304 + 64 * (j))
#define XB_TOP      3328
#define XB_TOPGEN   3392
#define XCD_BAR_WORDS 3456
#define XB_SPIN_CAP (1u << 18)

__device__ __forceinline__ unsigned xb_ld(unsigned* p)              { return __hip_atomic_load(p, __ATOMIC_RELAXED, __HIP_MEMORY_SCOPE_AGENT); }
__device__ __forceinline__ unsigned xb_add(unsigned* p, unsigned v) { return __hip_atomic_fetch_add(p, v, __ATOMIC_RELAXED, __HIP_MEMORY_SCOPE_AGENT); }
__device__ __forceinline__ unsigned xb_xcc_id() { return (unsigned)__builtin_amdgcn_s_getreg((3 << 11) | 20) & 0xFu; }
#define XB_SPIN(cond, bar) do { unsigned _sp = 0; while (cond) { __builtin_amdgcn_s_sleep(1); \
    if ((++_sp & 255u) == 0u) { if (xb_ld(&(bar)[XB_TMO])) break; if (_sp > XB_SPIN_CAP) { atomicAdd(&(bar)[XB_TMO], 1u); break; } } } } while (0)

struct XcdBarrier {
    unsigned* bar; unsigned x;
    volatile LAS unsigned* st;
};

__device__ __forceinline__ XcdBarrier xcd_barrier_post(unsigned* bar, volatile LAS unsigned* st) {
    XcdBarrier b; b.bar = bar; b.x = xb_xcc_id(); b.st = st;
    if (threadIdx.x == 0) (void)xb_add(&bar[XB_XCNT(b.x)], 1u);
    return b;
}
__device__ __forceinline__ void xcd_barrier_complete(unsigned* bar, unsigned x, unsigned& nloc, unsigned& nx) {
    const unsigned G = gridDim.x * gridDim.y * gridDim.z;
    unsigned sum, cnt, mine, sp = 0u;
    for (;;) {
        sum = 0u; cnt = 0u; mine = 0u;
#pragma unroll
        for (unsigned j = 0; j < 16; ++j) { const unsigned c = xb_ld(&bar[XB_XCNT(j)]); sum += c; cnt += (c > 0u) ? 1u : 0u; mine = (j == x) ? c : mine; }
        if (sum == G) break;
        __builtin_amdgcn_s_sleep(1);
        if ((++sp & 255u) == 0u) { if (xb_ld(&bar[XB_TMO])) break; if (sp > XB_SPIN_CAP) { atomicAdd(&bar[XB_TMO], 1u); break; } }
    }
    nloc = mine > 0u ? mine : 1u; nx = cnt > 0u ? cnt : 1u;
}

__device__ __forceinline__ void xcd_barrier(const XcdBarrier& b) {
    asm volatile("s_waitcnt vmcnt(0)" ::: "memory");
    __syncthreads();
    if (threadIdx.x == 0) {
        unsigned* bar = b.bar;
        __builtin_amdgcn_s_waitcnt(0);
        unsigned nloc = b.st[0], nx = b.st[1];
        if (nloc == 0u) { xcd_barrier_complete(bar, b.x, nloc, nx); b.st[0] = nloc; b.st[1] = nx; }
        const unsigned old = xb_add(&bar[XB_XSUB(b.x)], 1u);
        const unsigned gen = old / nloc;
        if (old + 1u == (gen + 1u) * nloc) {
            __builtin_amdgcn_fence(__ATOMIC_RELEASE, "agent");
            asm volatile("s_waitcnt vmcnt(0)" ::: "memory");
            const unsigned og = xb_add(&bar[XB_TOP], 1u);
            const unsigned tg = og / nx;
            if (og + 1u == (tg + 1u) * nx) xb_add(&bar[XB_TOPGEN], 1u);
            else XB_SPIN(xb_ld(&bar[XB_TOPGEN]) == tg, bar);
            __builtin_amdgcn_fence(__ATOMIC_ACQUIRE, "agent");
            xb_add(&bar[XB_XGEN(b.x)], 1u);
            asm volatile("s_waitcnt vmcnt(0)" ::: "memory");
        } else {
            XB_SPIN(xb_ld(&bar[XB_XGEN(b.x)]) == gen, bar);
            __builtin_amdgcn_fence(__ATOMIC_ACQUIRE, "agent");
            asm volatile("s_waitcnt vmcnt(0)" ::: "memory");
        }
    }
    __syncthreads();
}

__device__ __forceinline__ int next_item(unsigned* counter, LAS int* slot) {
    __syncthreads();
    if (threadIdx.x == 0) *slot = (int)atomicAdd(counter, 1u);
    __syncthreads();
    return *slot;
}

__global__ void __launch_bounds__(NTHREADS) fwd_megakernel(Params P) {
    extern __shared__ __attribute__((aligned(16))) unsigned char lds_raw[];
    LAS unsigned char* lds = (LAS unsigned char*)lds_raw;
    cg::grid_group grid = cg::this_grid();
    const int G = gridDim.x, bx = blockIdx.x;
    const int vb = (G % 8 == 0) ? (bx % 8) * (G / 8) + bx / 8 : bx;
    unsigned char* ws = P.ws;
    unsigned* ctl = (unsigned*)(ws + WS_CTL);
    LAS int* slot = (LAS int*)(lds + L_SLOT);
    if (threadIdx.x < 8) ((LAS unsigned*)(lds + L_SLOT))[threadIdx.x] = 0u;
    __syncthreads();
    XcdBarrier xbar = xcd_barrier_post(ctl + CW_BAR, (volatile LAS unsigned*)(lds + L_SLOT + 16));
    const int lo = P.ph_lo, hi = P.ph_hi;
#ifdef PROBE_PHASE
    const unsigned long long t_start = __builtin_amdgcn_s_memrealtime(); unsigned long long t_probe = 0ull;
#define STAMP(k) do { if ((k) == PROBE_PHASE) t_probe = __builtin_amdgcn_s_memrealtime(); } while (0)
#else
#define STAMP(k) do { } while (0)
#endif
#ifndef PHMASK
#define PHMASK 0xff
#endif
#define IN(k) (((PHMASK >> (k)) & 1) && lo <= (k) && (k) < hi)
#define SEAM(k) do { if (IN(k) && IN((k) + 1)) { if (P.ph_lo < 0) grid.sync(); else xcd_barrier(xbar); } STAMP(k); } while (0)

    if (IN(0)) p0_prologue(P, lds, vb, G);
    SEAM(0);
    if (IN(1)) {
        pg8::Gemm g = pg8::make_gemm((const bf16_t*)(ws + WS_XN), (const bf16_t*)(ws + WS_WIN), MTOK, NPAD, 1024);
        pg8::StaticOrder S; S.init(MTOK, NPAD, G, bx);
        EpiProj E; E.ws = ws; E.gq = P.in[3]; E.gk = P.in[4]; E.gnq = P.in[10]; E.gnk = P.in[11]; E.mgp = (unsigned char*)P.out;
        pg8::gemm_phase<EpiProj, pg8::StaticOrder, true, true>((PG8_LAS unsigned char*)lds, g, S, E);
        for (;;) {
            const int it = next_item(ctl + 320, slot);
            if (it >= 704) break;
            late_weight_item(P, lds, it);
        }
    }
    SEAM(1);
    if (IN(2)) {
        float lam;
        bool fast;
        { const int lane = threadIdx.x & 63; const float a = wave_sum(P.in[5][lane] * P.in[6][lane]), b2 = wave_sum(P.in[7][lane] * P.in[8][lane]); lam = expf(a) - expf(b2) + 0.2f;
          float gq = fabsf(P.in[3][lane]), gk = fabsf(P.in[4][lane]);
#pragma unroll
          for (int o_ = 1; o_ < 64; o_ <<= 1) { gq = fmaxf(gq, __shfl_xor(gq, o_)); gk = fmaxf(gk, __shfl_xor(gk, o_)); }
          fast = (QSCALE * 64.f * gq * gk <= 40.f); }
        for (;;) {
            const int it = next_item(ctl + 128, slot);
            if (it >= 32) break;
            compress_unit(P, lds, it >> 4, it & 15);
        }
        for (;;) {
            const int it = next_item(ctl + 0, slot);
            if (it >= 512) break;
            const int qb = 15 - (it >> 5), bh = it & 31;
            if (fast) diff_unit<true>(P, lds, bh >> 3, bh & 7, qb, lam, P.dup != 0); else diff_unit<false>(P, lds, bh >> 3, bh & 7, qb, lam, P.dup != 0);
        }
    }
    SEAM(2);
    if (IN(3)) {
        bool fast;
        { const int lane = threadIdx.x & 63; float gq = fabsf(P.in[10][lane]), gk = fmaxf(fabsf(P.in[11][lane]), fmaxf(fabsf(P.in[11][64 + lane]), fabsf(P.in[11][128 + lane])));
#pragma unroll
          for (int o_ = 1; o_ < 64; o_ <<= 1) { gq = fmaxf(gq, __shfl_xor(gq, o_)); gk = fmaxf(gk, __shfl_xor(gk, o_)); }
          fast = (QSCALE * 64.f * gq * gk <= 40.f); }
        for (;;) {
            const int it = next_item(ctl + 64, slot);
            if (it >= 1024) break;
            const int c = 63 - (it >> 4), bg = it & 15;
            if (fast) nsa_unit<true>(P, lds, bg >> 2, bg & 3, c, P.dup != 0); else nsa_unit<false>(P, lds, bg >> 2, bg & 3, c, P.dup != 0);
        }
    }
    SEAM(3);
    if (IN(4)) {
        static_assert(WS_WPN == WS_WPD + (size_t)1024 * 1024 * 2 && WS_NQ > WS_DQ, "the two branch GEMMs are addressed as one virtual GEMM");
        TwoSched S; S.S.init(MTOK, 1024, G, bx);
        pg8::Gemm g = pg8::make_gemm((const bf16_t*)(ws + WS_DQ), (const bf16_t*)(ws + WS_WPD), MTOK, 2048, 1024);
        g.a_sh = 6; g.a_lo = (size_t)256 * 1024 * 2; g.a_hi = WS_NQ - WS_DQ;
        EpiMerge2 E{(const bf16_t*)P.out, (bf16_t*)(ws + WS_MIXED)};
        pg8::gemm_phase<EpiMerge2, TwoSched, true, true>((PG8_LAS unsigned char*)lds, g, S, E);
    }
    SEAM(4);
    if (IN(5)) {
        pg8::Gemm g = pg8::make_gemm((const bf16_t*)(ws + WS_MIXED), (const bf16_t*)(ws + WS_WOUT), MTOK, 1024, 1024);
        pg8::StaticOrder S; S.init(MTOK, 1024, G, bx);
        EpiRes1 E{P.in[0], P.out, (bf16_t*)(ws + WS_XB1), (float*)(ws + WS_PART)};
        pg8::gemm_phase<EpiRes1, pg8::StaticOrder, true, true>((PG8_LAS unsigned char*)lds, g, S, E);
    }
    SEAM(5);
    if (IN(6)) {
        pg8::Gemm g = pg8::make_gemm((const bf16_t*)(ws + WS_XB1), (const bf16_t*)(ws + WS_WUP), MTOK, DFF, 1024);
        pg8::StaticOrder S; S.init(MTOK, DFF, G, bx);
        EpiUp E{(const float*)(ws + WS_PART), (bf16_t*)(ws + WS_HB)};
        pg8::gemm_phase<EpiUp, pg8::StaticOrder, true, true>((PG8_LAS unsigned char*)lds, g, S, E);
    }
    SEAM(6);
    if (IN(7)) {
        pg8::Gemm g = pg8::make_gemm((const bf16_t*)(ws + WS_HB), (const bf16_t*)(ws + WS_WDN), MTOK, 1024, DFF);
        pg8::StaticOrder S; S.init(MTOK, 1024, G, bx);
        EpiRes2 E{P.out, 1.f, (const bf16_t*)(ws + WS_XB1)};
        pg8::gemm_phase<EpiRes2, pg8::StaticOrder, true, true>((PG8_LAS unsigned char*)lds, g, S, E);
    }
#ifdef PROBE_PHASE
    grid.sync();
    if (blockIdx.x == 0 && threadIdx.x == 0) P.out[0] = 1000.0f + (float)(t_probe - t_start) * 0.01f;
#endif
#undef IN
#undef SEAM
}

#ifndef PROBE_DUP
#define PROBE_DUP -1
#endif
extern "C" void kernel_launch(void* const* d_in, const int* in_sizes, int n_in, void* d_out, int out_size, void* d_ws, size_t ws_size, hipStream_t stream) {
    static int grid = 0;
    if (grid == 0) {
        if (n_in != 24 || out_size != MTOK * DM || ws_size < WS_END) { fprintf(stderr, "kernel_launch: unexpected shapes (n_in %d out %d ws %zu)\n", n_in, out_size, ws_size); grid = -1; return; }
        int dev = 0, cus = 0, per_cu = 0;
        hipGetDevice(&dev); hipDeviceGetAttribute(&cus, hipDeviceAttributeMultiprocessorCount, dev);
        if (hipFuncSetAttribute((const void*)fwd_megakernel, hipFuncAttributeMaxDynamicSharedMemorySize, LDS_BYTES) != hipSuccess) { fprintf(stderr, "kernel_launch: hipFuncSetAttribute failed\n"); grid = -1; return; }
        if (hipOccupancyMaxActiveBlocksPerMultiprocessor(&per_cu, (const void*)fwd_megakernel, NTHREADS, LDS_BYTES) != hipSuccess || per_cu < 1) { fprintf(stderr, "kernel_launch: occupancy query says %d\n", per_cu); per_cu = 1; }
        (void)hipGetLastError();
        grid = cus * 1;
        fprintf(stderr, "kernel_launch: grid %d (cus %d, per_cu %d)\n", grid, cus, per_cu);
    }
    if (grid < 0) return;
    hipMemsetAsync((char*)d_ws + WS_CTL, 0, CTL_BYTES, stream);
    Params p{};
    for (int i = 0; i < 24; ++i) p.in[i] = (const float*)d_in[i];
    p.out = (float*)d_out; p.ws = (unsigned char*)d_ws;
    for (int i = 0; i < 32; ++i) p.invfreq[i] = (double)powf(10000.0f, -(float)i / 32.0f);
    p.pad = 0;
    int plan[3][3] = {{0, 8, 0}, {0, 0, 0}, {0, 0, 0}}; int nl = 1;
    if (PROBE_DUP >= 0) { const int k = PROBE_DUP; const bool inplace = (k == 2 || k == 3 || k == 7); plan[0][0] = 0; plan[0][1] = k + (inplace ? 0 : 1); plan[0][2] = 0; plan[1][0] = k; plan[1][1] = k + 1; plan[1][2] = inplace ? 1 : 0; plan[2][0] = k + (inplace ? 0 : 1); plan[2][1] = 8; plan[2][2] = 0; nl = 3; }
    for (int li = 0; li < nl; ++li) {
        if (plan[li][0] >= plan[li][1]) continue;
        if (li > 0) hipMemsetAsync((char*)d_ws + WS_CTL, 0, CTL_BYTES, stream);
        p.ph_lo = plan[li][0]; p.ph_hi = plan[li][1]; p.dup = plan[li][2];
        void* args[] = {&p};
        hipError_t e = hipLaunchCooperativeKernel((const void*)fwd_megakernel, dim3(grid), dim3(NTHREADS), args, LDS_BYTES, stream);
        if (e != hipSuccess) fprintf(stderr, "kernel_launch: cooperative launch failed: %s (grid %d)\n", hipGetErrorString(e), grid);
    }
}
```

```cpp
#include <hip/hip_runtime.h>
#include <hip/hip_cooperative_groups.h>
#include <cstdio>
#include <cstdint>
#include <cmath>
namespace cg = cooperative_groups;

namespace pg8 {
#define PG8_LAS __attribute__((address_space(3)))
typedef unsigned short bf16_t;
typedef short bf16x8 __attribute__((ext_vector_type(8)));
typedef float f32x4 __attribute__((ext_vector_type(4)));
typedef unsigned u32x4 __attribute__((ext_vector_type(4)));
constexpr int BM = 256, BK = 64, HALF = 128, HTB = HALF * BK * 2  , STAGE_BYTES = 8 * HTB, NXCD = 8, WGM = 8;

__host__ __device__ __forceinline__ int lds_byte(int r, int c) { const int st = (r >> 4) * 2 + (c >> 5), rr = r & 15, cc = c & 31, ob = rr * 64 + cc * 2; return st * 1024 + (ob ^ (((ob >> 9) & 1) << 5)); }
__host__ __device__ __forceinline__ void stage_rc(int b, int& R, int& C) { const int st = b / 1024, sb = b % 1024, swz = sb ^ (((sb >> 9) & 1) << 5); R = (st >> 1) * 16 + swz / 64; C = (st & 1) * 32 + (swz % 64) / 2; }
__host__ __device__ __forceinline__ int perm32(int rho) { const int n = rho >> 4, i = rho & 15; return 8 * (i >> 2) + 4 * n + (i & 3); }

struct Unit { int pm, pn; };
struct Gemm { const bf16_t* A; const bf16_t* Bt; int M, N, K; int lda; int kstepA; int a_sh; size_t a_lo, a_hi; };
__host__ __device__ __forceinline__ Gemm make_gemm(const bf16_t* A, const bf16_t* Bt, int M, int N, int K) { Gemm g; g.A = A; g.Bt = Bt; g.M = M; g.N = N; g.K = K; g.lda = K; g.kstepA = BK * 2; g.a_sh = 24; g.a_lo = (size_t)BM * K * 2; g.a_hi = 0; return g; }
__device__ __forceinline__ const char* a_tile(const Gemm& g, int pm) { return (const char*)g.A + (size_t)(pm >> g.a_sh) * g.a_hi + (size_t)(pm & ((1 << g.a_sh) - 1)) * g.a_lo; }

struct StaticOrder {
    int nM, nN, nwg, G, c;
    __host__ __device__ void init(int M, int N, int G_, int c_) { nM = M / BM; nN = N / BM; nwg = nM * nN; G = G_; c = c_; }
    __host__ __device__ bool next(int i, Unit& u) const {
        const long L = (long)i * G + c; if (L >= nwg) return false;
        int wgid = (int)L; { const int q = nwg / NXCD, r = nwg % NXCD, xcd = wgid % NXCD, off = wgid / NXCD; wgid = (xcd < r ? xcd * (q + 1) : r * (q + 1) + (xcd - r) * q) + off; }
        const int nig = WGM * nN, gid = wgid / nig, fm = gid * WGM, gsz = (nM - fm) < WGM ? (nM - fm) : WGM;
        u.pm = fm + ((wgid % nig) % gsz); u.pn = (wgid % nig) / gsz; return true;
    }
    __device__ __forceinline__ void a_ready(const Unit&) const {}
    __device__ __forceinline__ void done(const Unit&) const {}
};


template <class Epi, class Sched, bool ALIGN_EPI = false, bool SP2 = false>
__device__ __forceinline__ void gemm_phase(PG8_LAS unsigned char* lds, const Gemm g, const Sched& S, const Epi& E) {
    const int tid = threadIdx.x, wid = __builtin_amdgcn_readfirstlane(tid >> 6), lane = tid & 63, wr = wid >> 2, wc = wid & 3, fr = lane & 15, fq = lane >> 4;
    const int K = g.K, nt = K / BK;
    unsigned voffA[2], voffB[2];
#pragma unroll
    for (int i = 0; i < 2; ++i) { int R, C; stage_rc(tid * 16 + i * 8192, R, C); const int Rb = Epi::PERM ? ((R & ~31) + perm32(R & 31)) : R;
        voffA[i] = (unsigned)(R * g.lda + C) * 2u; voffB[i] = (unsigned)(Rb * K + C) * 2u; }
    const size_t kstep = (size_t)(BK * 2); const size_t kstepA = (size_t)g.kstepA; const size_t hstepA = (size_t)HALF * g.lda * 2;
    const size_t hstep = (size_t)HALF * K * 2;
    const size_t tstep = 2 * hstep;
    const unsigned ldsw = (unsigned)wid * 1024u;
    const int aoff = lds_byte(wr * 64 + fr, fq * 8), boff = lds_byte(wc * 32 + fr, fq * 8);
#define PG8_SA(b, h) (((b) * 2 + (h)) * HTB)
#define PG8_SB(b, h) ((4 + (b) * 2 + (h)) * HTB)
#define PG8_STAGE(bufoff, gbase, voff) do { _Pragma("unroll") for (int _i = 0; _i < 2; ++_i) \
        __builtin_amdgcn_global_load_lds((const unsigned*)((const char*)(gbase) + (voff)[_i]), (PG8_LAS unsigned*)(lds + (bufoff) + ldsw + _i * 8192), 16, 0, 0); } while (0)
#define PG8_LDA(dst, b, h) do { _Pragma("unroll") for (int m = 0; m < 4; ++m) _Pragma("unroll") for (int k = 0; k < 2; ++k) dst[m][k] = *(const PG8_LAS bf16x8*)(lds + PG8_SA(b, h) + aoff + m * 2048 + k * 1024); } while (0)
#define PG8_LDB(dst, b, h) do { _Pragma("unroll") for (int n = 0; n < 2; ++n) _Pragma("unroll") for (int k = 0; k < 2; ++k) dst[n][k] = *(const PG8_LAS bf16x8*)(lds + PG8_SB(b, h) + boff + n * 2048 + k * 1024); } while (0)
#define PG8_MMA(ai, bj, At, Bt) do { __builtin_amdgcn_s_setprio(1); _Pragma("unroll") for (int m = 0; m < 4; ++m) _Pragma("unroll") for (int n = 0; n < 2; ++n) _Pragma("unroll") for (int k = 0; k < 2; ++k) \
        acc[ai][bj][m][n] = __builtin_amdgcn_mfma_f32_16x16x32_bf16(Bt[n][k], At[m][k], acc[ai][bj][m][n], 0, 0, 0); __builtin_amdgcn_s_setprio(0); } while (0)
#define PG8_WAIT_V(n) asm volatile("s_waitcnt vmcnt(" #n ")" ::: "memory")
#define PG8_WAIT_L(n) asm volatile("s_waitcnt lgkmcnt(" #n ")" ::: "memory")
#define PG8_BAR __builtin_amdgcn_s_barrier()
#define PG8_SCHED __builtin_amdgcn_sched_barrier(0)
    Unit cur, nxt; int ui = 0;
    if (!S.next(0, cur)) return;
    f32x4 acc[2][2][4][2];
#pragma unroll
    for (int a = 0; a < 2; ++a)
#pragma unroll
        for (int b = 0; b < 2; ++b)
#pragma unroll
            for (int m = 0; m < 4; ++m)
#pragma unroll
                for (int n = 0; n < 2; ++n) acc[a][b][m][n] = (f32x4){0.f, 0.f, 0.f, 0.f};
    bf16x8 At[4][2], B0[2][2], B1[2][2];
    const char* cA = a_tile(g, cur.pm); const char* cB = (const char*)g.Bt + (size_t)cur.pn * tstep;
    S.a_ready(cur);
    if constexpr (SP2) {
        PG8_STAGE(PG8_SB(0, 0), cB, voffB); PG8_STAGE(PG8_SB(0, 1), cB + hstep, voffB); PG8_STAGE(PG8_SA(0, 0), cA, voffA); PG8_STAGE(PG8_SA(0, 1), cA + hstepA, voffA);
        if (wr == 1) PG8_BAR;
        PG8_WAIT_V(2); PG8_BAR;
        PG8_STAGE(PG8_SB(1, 0), cB + kstep, voffB); PG8_STAGE(PG8_SA(1, 0), cA + kstepA, voffA); PG8_STAGE(PG8_SB(1, 1), cB + hstep + kstep, voffB);
        PG8_WAIT_V(6); PG8_BAR;
    } else {
        PG8_STAGE(PG8_SB(0, 0), cB, voffB); PG8_STAGE(PG8_SA(0, 0), cA, voffA); PG8_STAGE(PG8_SB(0, 1), cB + hstep, voffB); PG8_STAGE(PG8_SA(0, 1), cA + hstepA, voffA);
        if (wr == 1) PG8_BAR;
        PG8_WAIT_V(4); PG8_BAR;
        PG8_STAGE(PG8_SB(1, 0), cB + kstep, voffB); PG8_STAGE(PG8_SA(1, 0), cA + kstepA, voffA); PG8_STAGE(PG8_SB(1, 1), cB + hstep + kstep, voffB);
        PG8_WAIT_V(6); PG8_BAR;
    }
    for (;;) {
        const bool has_next = S.next(ui + 1, nxt);
        const char* nA = has_next ? a_tile(g, nxt.pm) : cA; const char* nB = has_next ? (const char*)g.Bt + (size_t)nxt.pn * tstep : cB;
        for (int t = 0; t < nt; t += 2) {
            const bool last = (t == nt - 2);
            const char* a1 = cA + (size_t)(t + 1) * kstepA;
            const char* a2 = last ? nA : cA + (size_t)(t + 2) * kstepA; const char* b2 = last ? nB : cB + (size_t)(t + 2) * kstep;
            const char* a3 = a2 + kstepA; const char* b3 = b2 + kstep;
            if (last && has_next) S.a_ready(nxt);
            if constexpr (SP2) {
            PG8_LDB(B0, 0, 0); PG8_LDB(B1, 0, 1); PG8_SCHED; PG8_LDA(At, 0, 0); PG8_STAGE(PG8_SA(1, 1), a1 + hstepA, voffA);
            PG8_WAIT_V(8); PG8_WAIT_L(0); PG8_BAR; PG8_MMA(0, 0, At, B0); PG8_MMA(0, 1, At, B1); PG8_BAR; PG8_SCHED;
            PG8_LDA(At, 0, 1); PG8_STAGE(PG8_SB(0, 0), b2, voffB); PG8_STAGE(PG8_SB(0, 1), b2 + hstep, voffB); PG8_STAGE(PG8_SA(0, 0), a2, voffA);
            PG8_WAIT_V(8); PG8_WAIT_L(0); PG8_BAR; PG8_MMA(1, 0, At, B0); PG8_MMA(1, 1, At, B1); PG8_BAR; PG8_SCHED;
            PG8_LDB(B0, 1, 0); PG8_LDB(B1, 1, 1); PG8_SCHED; PG8_LDA(At, 1, 0); PG8_STAGE(PG8_SA(0, 1), a2 + hstepA, voffA);
            PG8_WAIT_V(8); PG8_WAIT_L(0); PG8_BAR; PG8_MMA(0, 0, At, B0); PG8_MMA(0, 1, At, B1); PG8_BAR; PG8_SCHED;
            PG8_LDA(At, 1, 1); PG8_STAGE(PG8_SB(1, 0), b3, voffB); PG8_STAGE(PG8_SB(1, 1), b3 + hstep, voffB); PG8_STAGE(PG8_SA(1, 0), a3, voffA);
            PG8_WAIT_V(8); PG8_WAIT_L(0); PG8_BAR; PG8_MMA(1, 0, At, B0); PG8_MMA(1, 1, At, B1); PG8_BAR; PG8_SCHED;
            } else {
            PG8_LDB(B0, 0, 0); PG8_SCHED; PG8_LDA(At, 0, 0); PG8_STAGE(PG8_SA(1, 1), a1 + hstepA, voffA);
            PG8_WAIT_L(8); PG8_BAR; PG8_WAIT_L(0); PG8_MMA(0, 0, At, B0); PG8_BAR; PG8_SCHED;
            PG8_LDB(B1, 0, 1); PG8_STAGE(PG8_SB(0, 0), b2, voffB);
            PG8_BAR; PG8_WAIT_L(0); PG8_MMA(0, 1, At, B1); PG8_BAR;
            PG8_LDA(At, 0, 1); PG8_STAGE(PG8_SA(0, 0), a2, voffA);
            PG8_BAR; PG8_WAIT_L(0); PG8_MMA(1, 0, At, B0); PG8_BAR; PG8_SCHED;
            PG8_STAGE(PG8_SB(0, 1), b2 + hstep, voffB);
            PG8_WAIT_V(6); PG8_BAR; PG8_MMA(1, 1, At, B1); PG8_BAR;
            PG8_LDB(B0, 1, 0); PG8_SCHED; PG8_LDA(At, 1, 0); PG8_STAGE(PG8_SA(0, 1), a2 + hstepA, voffA);
            PG8_WAIT_L(8); PG8_BAR; PG8_WAIT_L(0); PG8_MMA(0, 0, At, B0); PG8_BAR; PG8_SCHED;
            PG8_LDB(B1, 1, 1); PG8_STAGE(PG8_SB(1, 0), b3, voffB);
            PG8_BAR; PG8_WAIT_L(0); PG8_MMA(0, 1, At, B1); PG8_BAR;
            PG8_LDA(At, 1, 1); PG8_STAGE(PG8_SA(1, 0), a3, voffA);
            PG8_BAR; PG8_WAIT_L(0); PG8_MMA(1, 0, At, B0); PG8_BAR; PG8_SCHED;
            PG8_STAGE(PG8_SB(1, 1), b3 + hstep, voffB);
            PG8_WAIT_V(6); PG8_BAR; PG8_MMA(1, 1, At, B1); PG8_BAR;
            }
        }
        if constexpr (ALIGN_EPI) { if (wr == 0) PG8_BAR; }
        if constexpr (!Epi::AFTER_DRAIN) { E(acc, cur, wr, wc, fr, fq); S.done(cur); }
        if (!has_next) break;
#pragma unroll
        for (int a = 0; a < 2; ++a)
#pragma unroll
            for (int b = 0; b < 2; ++b)
#pragma unroll
                for (int m = 0; m < 4; ++m)
#pragma unroll
                    for (int n = 0; n < 2; ++n) acc[a][b][m][n] = (f32x4){0.f, 0.f, 0.f, 0.f};
        cur = nxt; cA = nA; cB = nB; ++ui;
        if constexpr (ALIGN_EPI) { if (wr == 1) PG8_BAR; }
    }
    PG8_WAIT_V(0);
    if constexpr (!ALIGN_EPI) { if (wr == 0) PG8_BAR; }
    PG8_BAR;
    if constexpr (Epi::AFTER_DRAIN) { E.fused(acc, cur, wr, wc, fr, fq, lds, wid, lane); S.done(cur); }
#undef PG8_SA
#undef PG8_SB
#undef PG8_STAGE
#undef PG8_LDA
#undef PG8_LDB
#undef PG8_MMA
#undef PG8_WAIT_V
#undef PG8_WAIT_L
#undef PG8_BAR
#undef PG8_SCHED
}
}

#define LAS __attribute__((address_space(3)))
typedef unsigned short bf16_t;
typedef short bf16x8 __attribute__((ext_vector_type(8)));
typedef float f32x4 __attribute__((ext_vector_type(4)));
typedef float f32x16 __attribute__((ext_vector_type(16)));
typedef float f32x8 __attribute__((ext_vector_type(8)));
typedef unsigned u32x4 __attribute__((ext_vector_type(4)));
typedef unsigned u32x2 __attribute__((ext_vector_type(2)));
typedef float f32x2_t __attribute__((ext_vector_type(2)));
typedef __bf16 bf16x2_t __attribute__((ext_vector_type(2)));

constexpr int NB = 4, SEQ = 4096, DM = 1024, MTOK = NB * SEQ, DIN = 7728, NPAD = 7936, DFF = 4096;
constexpr float QSCALE = 0.125f * 1.4426950408889634f;
constexpr float EPS = 1e-6f;
constexpr int NTHREADS = 512, NWAVES = 8;

constexpr size_t MiB = 1u << 20;
constexpr size_t WS_CTL = 0, CTL_BYTES = 65536;
constexpr int CW_BAR = 4096;
constexpr size_t WS_COS = 1 * MiB, WS_SIN = WS_COS + 4096 * 32 * 4, WS_CCOS = WS_SIN + 4096 * 32 * 4, WS_CSIN = WS_CCOS + 256 * 32 * 4;
constexpr size_t WS_PB = 3 * MiB;
constexpr size_t WS_W2T = 3 * MiB + 65536;
constexpr size_t WS_W1T = 4 * MiB;
constexpr size_t WS_WPD = 6 * MiB, WS_WPN = 8 * MiB, WS_WOUT = 10 * MiB, WS_WUP = 12 * MiB, WS_WDN = 20 * MiB, WS_WIN = 28 * MiB;
constexpr size_t WS_XN = 45 * MiB;
constexpr size_t WS_HID = WS_XN, WS_KCMP = WS_XN + 4 * MiB, WS_VCMPT = WS_XN + 5 * MiB, WS_MIXED = WS_XN;
constexpr size_t WS_DQ = 77 * MiB, WS_DK = 109 * MiB, WS_DVT = 141 * MiB, WS_NQ = 173 * MiB;
constexpr size_t WS_KC = 205 * MiB, WS_VC = 213 * MiB, WS_KSL = 221 * MiB, WS_KWN = 229 * MiB, WS_VSLT = 237 * MiB, WS_VWNT = 245 * MiB, WS_NG = 253 * MiB;
constexpr size_t WS_T1 = WS_DK;
constexpr size_t WS_XB1 = WS_KC;
constexpr size_t WS_PART = WS_NG;
constexpr size_t WS_HB = WS_DQ;
constexpr size_t WS_END = 256 * MiB;

constexpr int LDS_BYTES = 151552;
constexpr int TROW = 72;
constexpr int ABUF = 64 * TROW * 2 + 128 * TROW * 2;
constexpr int L_O0P = 83968;
constexpr int L_CK = 57344, CKROW = 72;
constexpr int L_CV = L_CK + 256 * CKROW * 2, CVROW = 264;
constexpr int L_IMP = L_CV + 64 * CVROW * 2;
constexpr int L_SEL = L_IMP + 16384;
constexpr int L_SLOT = 149504;
static_assert(L_SEL + 512 <= L_SLOT && L_O0P + 65536 <= L_SLOT && 3 * ABUF <= L_O0P && 3 * (128 * TROW * 2) <= L_CK, "lds map 2");
static_assert(L_SLOT + 64 <= LDS_BYTES, "lds map");

struct Params { const float* in[24]; float* out; unsigned char* ws; double invfreq[32]; int ph_lo, ph_hi, dup, pad; };

__device__ __forceinline__ unsigned cvtpk(float lo, float hi) { f32x2_t v = {lo, hi}; bf16x2_t b = __builtin_convertvector(v, bf16x2_t); return __builtin_bit_cast(unsigned, b); }
__device__ __forceinline__ bf16_t f2bf(float f) { return (bf16_t)(cvtpk(f, 0.f) & 0xffffu); }
__device__ __forceinline__ int crow(int r, int hi) { return (r & 3) + 8 * (r >> 2) + 4 * hi; }
__device__ __forceinline__ int perm16(int t) { return (t & ~12) | ((t & 4) << 1) | ((t & 8) >> 1); }
__device__ __forceinline__ float wave_sum(float v) {
#pragma unroll
    for (int o = 1; o < 64; o <<= 1) v += __shfl_xor(v, o);
    return v;
}
__device__ __forceinline__ float sigmoidf_(float v) { return __builtin_amdgcn_rcpf(1.0f + __expf(-v)); }
__device__ __forceinline__ float gelu_tanh(float x) { const float u = 0.7978845608028654f * (x + 0.044715f * x * x * x); return x * __builtin_amdgcn_rcpf(1.0f + __expf(-2.0f * u)); }

__device__ __forceinline__ void tr_item(const float* W, int ldw, int col0, int nvalid, const float* kscale, bf16_t* WT, int ldt, int row0, int k0, LAS float* scr, int lane) {
    const int cl = lane & 31;
#pragma unroll 8
    for (int i = 0; i < 32; ++i) { const int kk = 2 * i + (lane >> 5); float v = 0.f; if (cl < nvalid) { v = __builtin_nontemporal_load(W + (size_t)(k0 + kk) * ldw + col0 + cl); if (kscale) v *= kscale[k0 + kk]; } scr[kk * 33 + cl] = v; }
    asm volatile("s_waitcnt lgkmcnt(0)" ::: "memory");
    const int c = lane & 7;
#pragma unroll
    for (int j = 0; j < 4; ++j) { const int n = (lane >> 3) + 8 * j; const LAS float* s = scr + (8 * c) * 33 + n;
        u32x4 o; o.x = cvtpk(s[0 * 33], s[1 * 33]); o.y = cvtpk(s[2 * 33], s[3 * 33]); o.z = cvtpk(s[4 * 33], s[5 * 33]); o.w = cvtpk(s[6 * 33], s[7 * 33]);
        *(u32x4*)(WT + (size_t)(row0 + n) * ldt + k0 + 8 * c) = o; }
    asm volatile("s_waitcnt lgkmcnt(0)" ::: "memory");
}
__device__ __forceinline__ void tr_plain(const float* W, int K, int N, const float* kscale, bf16_t* WT, LAS float* scr, int item, int lane) {
    const int nblk = N / 32, kb = item / nblk, nb = item % nblk;
    tr_item(W, N, 32 * nb, 32, kscale, WT, K, 32 * nb, 64 * kb, scr, lane);
}
__device__ __forceinline__ void sincos_d(double ang, float& s, float& c) {
    const double k = rint(ang * 0.15915494309189535);
    double r = fma(-k, 6.283185307179586, ang); r = fma(-k, 2.4492935982947064e-16, r);
    const double r2 = r * r; double ts = r, tc = 1.0, ss = r, cs = 1.0;
#pragma unroll
    for (int n = 1; n <= 14; ++n) { tc *= -r2 * (1.0 / ((2.0 * n - 1.0) * (2.0 * n))); cs += tc; ts *= -r2 * (1.0 / ((2.0 * n) * (2.0 * n + 1.0))); ss += ts; }
    s = (float)ss; c = (float)cs;
}

__device__ __forceinline__ void late_weight_item(const Params& P, LAS unsigned char* lds, int item) {
    const int tid = threadIdx.x, lane = tid & 63, wave = tid >> 6;
    LAS float* scr = (LAS float*)(lds + wave * 16384);
    unsigned char* ws = P.ws;
    int it = item * NWAVES + wave;
    if (it < 512) { tr_plain(P.in[18], 1024, 1024, nullptr, (bf16_t*)(ws + WS_WPD), scr, it, lane); return; } it -= 512;
    if (it < 512) { tr_plain(P.in[19], 1024, 1024, nullptr, (bf16_t*)(ws + WS_WPN), scr, it, lane); return; } it -= 512;
    if (it < 512) { tr_plain(P.in[20], 1024, 1024, nullptr, (bf16_t*)(ws + WS_WOUT), scr, it, lane); return; } it -= 512;
    if (it < 2048) { tr_plain(P.in[22], 1024, 4096, P.in[21], (bf16_t*)(ws + WS_WUP), scr, it, lane); return; } it -= 2048;
    tr_plain(P.in[23], 4096, 1024, nullptr, (bf16_t*)(ws + WS_WDN), scr, it, lane);
}
__device__ __forceinline__ void p0_prologue(const Params& P, LAS unsigned char* lds, int vb, int G) {
    const int tid = threadIdx.x, lane = tid & 63, wave = tid >> 6;
    LAS float* scr = (LAS float*)(lds + wave * 16384);
    const int gw = vb * NWAVES + wave, NGW = G * NWAVES;
    unsigned char* ws = P.ws;
    for (int it = gw; it < 16 * 248; it += NGW) {
        const int kb = it / 248, nb = it % 248, n0 = 32 * nb, pn = n0 >> 8, p = n0 & 255, bj = p >> 7, wc = (p >> 5) & 3, L0 = 64 * wc + 32 * bj;
        const int srcbase = pn < 22 ? 256 * pn : (pn < 30 ? 5680 + 256 * (pn - 22) : 5632), tv = pn < 30 ? 256 : 48;
        int nv = tv - L0; nv = nv < 0 ? 0 : (nv > 32 ? 32 : nv);
        tr_item(P.in[2], DIN, srcbase + L0, nv, nullptr, (bf16_t*)(ws + WS_WIN), 1024, n0, 64 * kb, scr, lane);
    }
    for (int it = gw; it < 32 * 8; it += NGW) tr_plain(P.in[14], 2048, 256, nullptr, (bf16_t*)(ws + WS_W1T), scr, it, lane);
    for (int it = gw; it < 32 * 8; it += NGW) tr_plain(P.in[16], 2048, 256, nullptr, (bf16_t*)(ws + WS_W1T) + 256 * 2048, scr, it, lane);
    for (int it = gw; it < 4 * 2; it += NGW) tr_plain(P.in[15], 256, 64, nullptr, (bf16_t*)(ws + WS_W2T), scr, it, lane);
    for (int it = gw; it < 4 * 2; it += NGW) tr_plain(P.in[17], 256, 64, nullptr, (bf16_t*)(ws + WS_W2T) + 64 * 256, scr, it, lane);
    for (int it = NGW - 1 - gw; it < 128; it += NGW) {
        const int which = it >> 6, kc = (it >> 2) & 15, j = 64 * (it & 3) + lane; const float* pos = P.in[which ? 13 : 12] + 128 * kc; const float* W1 = P.in[which ? 16 : 14] + (size_t)128 * kc * 256;
        float a0 = 0.f, a1 = 0.f, a2 = 0.f, a3 = 0.f;
#pragma unroll 4
        for (int k = 0; k < 128; k += 4) { a0 += pos[k] * W1[(size_t)k * 256 + j]; a1 += pos[k + 1] * W1[(size_t)(k + 1) * 256 + j]; a2 += pos[k + 2] * W1[(size_t)(k + 2) * 256 + j]; a3 += pos[k + 3] * W1[(size_t)(k + 3) * 256 + j]; }
        ((float*)(ws + WS_PB))[(which * 16 + kc) * 256 + j] = (a0 + a1) + (a2 + a3);
    }
    for (int idx = vb * NTHREADS + tid; idx < (4096 + 256) * 32; idx += G * NTHREADS) {
        const int i = idx & 31, p = idx >> 5; float s, c;
        if (p < 4096) { sincos_d((double)p * P.invfreq[i], s, c); ((float*)(ws + WS_COS))[p * 32 + i] = c; ((float*)(ws + WS_SIN))[p * 32 + i] = s; }
        else { const int n = p - 4096; sincos_d(((double)n * 16.0 + 15.5) * P.invfreq[i], s, c); ((float*)(ws + WS_CCOS))[n * 32 + i] = c; ((float*)(ws + WS_CSIN))[n * 32 + i] = s; }
    }
    const float* x = P.in[0]; const float* g = P.in[1]; bf16_t* XN = (bf16_t*)(ws + WS_XN);
    f32x4 gv[4];
#pragma unroll
    for (int j = 0; j < 4; ++j) gv[j] = ((const f32x4*)g)[lane + 64 * j];
    for (int m0 = gw; m0 < MTOK; m0 += 4 * NGW) {
        f32x4 v[4][4];
#pragma unroll
        for (int r = 0; r < 4; ++r) { const int m = m0 + r * NGW; if (m < MTOK) { const f32x4* xr = (const f32x4*)(x + (size_t)m * DM) + lane;
#pragma unroll
            for (int j = 0; j < 4; ++j) v[r][j] = __builtin_nontemporal_load(xr + 64 * j); } }
#pragma unroll
        for (int r = 0; r < 4; ++r) { const int m = m0 + r * NGW; if (m < MTOK) { float s = 0.f;
#pragma unroll
            for (int j = 0; j < 4; ++j) s += (v[r][j].x * v[r][j].x + v[r][j].y * v[r][j].y) + (v[r][j].z * v[r][j].z + v[r][j].w * v[r][j].w);
            const float rstd = rsqrtf(wave_sum(s) * (1.f / DM) + EPS);
            u32x2* o8 = (u32x2*)(XN + (size_t)m * DM) + lane;
#pragma unroll
            for (int j = 0; j < 4; ++j) { const f32x4 y = v[r][j] * rstd * gv[j]; u32x2 w; w.x = cvtpk(y.x, y.y); w.y = cvtpk(y.z, y.w); o8[64 * j] = w; } } }
    }
}

struct EpiProj {
    static constexpr bool PERM = true, AFTER_DRAIN = false;
    unsigned char* ws; const float *gq, *gk, *gnq, *gnk;
    __device__ __forceinline__ void operator()(const f32x4 (&acc)[2][2][4][2], const pg8::Unit& u, int wr, int wc, int fr, int fq) const {
        const int pn = u.pn; const int row0 = u.pm * 256 + wr * 64 + fr;
        int type, ld = 1024, cb = 0; bf16_t* dst = nullptr; const float* gain = nullptr; float qs = 1.f;
        if (pn < 4) { type = 0; dst = (bf16_t*)(ws + WS_DQ); cb = 256 * pn; gain = gq; qs = QSCALE; }
        else if (pn < 8) { type = 0; dst = (bf16_t*)(ws + WS_DK); cb = 256 * (pn - 4); gain = gk; }
        else if (pn < 12) { type = 2; dst = (bf16_t*)(ws + WS_DVT); }
        else if (pn < 16) { type = 0; dst = (bf16_t*)(ws + WS_NQ); cb = 256 * (pn - 12); gain = gnq; qs = QSCALE; }
        else if (pn == 16) { type = 1; dst = (bf16_t*)(ws + WS_KC); ld = 256; }
        else if (pn == 17) { type = 1; dst = (bf16_t*)(ws + WS_VC); ld = 256; }
        else if (pn == 18) { type = 0; dst = (bf16_t*)(ws + WS_KSL); ld = 256; gain = gnk + 64; }
        else if (pn == 19) { type = 2; dst = (bf16_t*)(ws + WS_VSLT); }
        else if (pn == 20) { type = 0; dst = (bf16_t*)(ws + WS_KWN); ld = 256; gain = gnk + 128; }
        else if (pn == 21) { type = 2; dst = (bf16_t*)(ws + WS_VWNT); }
        else if (pn < 30) { type = 3; dst = (bf16_t*)P_MG(); ld = 2048; cb = 256 * (pn - 22); }
        else { type = 4; }
        const int lc = 64 * wc + 8 * fq;
        if (type == 0) {
            const float* COS = (const float*)(ws + WS_COS); const float* SIN = (const float*)(ws + WS_SIN);
            f32x4 g1[2], g2[2];
#pragma unroll
            for (int n = 0; n < 2; ++n) { g1[n] = *(const f32x4*)(gain + 8 * fq + 4 * n); g2[n] = *(const f32x4*)(gain + 32 + 8 * fq + 4 * n); }
#pragma unroll
            for (int ai = 0; ai < 2; ++ai)
#pragma unroll
                for (int m = 0; m < 4; ++m) {
                    const int row = row0 + ai * 128 + m * 16, pos = row & (SEQ - 1);
                    float ss = 0.f;
#pragma unroll
                    for (int bj = 0; bj < 2; ++bj)
#pragma unroll
                        for (int n = 0; n < 2; ++n) { const f32x4 v = acc[ai][bj][m][n]; ss += (v.x * v.x + v.y * v.y) + (v.z * v.z + v.w * v.w); }
                    ss += __shfl_xor(ss, 16); ss += __shfl_xor(ss, 32);
                    const float rstd = rsqrtf(ss * (1.f / 64.f) + EPS);
                    f32x4 o1[2], o2[2];
#pragma unroll
                    for (int n = 0; n < 2; ++n) {
                        const f32x4 c4 = *(const f32x4*)(COS + pos * 32 + 8 * fq + 4 * n), s4 = *(const f32x4*)(SIN + pos * 32 + 8 * fq + 4 * n);
                        const f32x4 x1 = acc[ai][0][m][n] * rstd * g1[n], x2 = acc[ai][1][m][n] * rstd * g2[n];
                        o1[n] = (x1 * c4 - x2 * s4) * qs; o2[n] = (x2 * c4 + x1 * s4) * qs;
                    }
                    bf16_t* rp = dst + (size_t)row * ld + cb + lc;
                    u32x4 w; w.x = cvtpk(o1[0].x, o1[0].y); w.y = cvtpk(o1[0].z, o1[0].w); w.z = cvtpk(o1[1].x, o1[1].y); w.w = cvtpk(o1[1].z, o1[1].w); *(u32x4*)rp = w;
                    w.x = cvtpk(o2[0].x, o2[0].y); w.y = cvtpk(o2[0].z, o2[0].w); w.z = cvtpk(o2[1].x, o2[1].y); w.w = cvtpk(o2[1].z, o2[1].w); *(u32x4*)(rp + 32) = w;
                }
        } else if (type == 1 || type == 3) {
#pragma unroll
            for (int ai = 0; ai < 2; ++ai)
#pragma unroll
                for (int m = 0; m < 4; ++m) {
                    const int row = row0 + ai * 128 + m * 16; bf16_t* rp = dst + (size_t)row * ld + cb + lc;
#pragma unroll
                    for (int bj = 0; bj < 2; ++bj) {
                        f32x4 a = acc[ai][bj][m][0], b = acc[ai][bj][m][1];
                        if (type == 3) { a.x = sigmoidf_(a.x); a.y = sigmoidf_(a.y); a.z = sigmoidf_(a.z); a.w = sigmoidf_(a.w); b.x = sigmoidf_(b.x); b.y = sigmoidf_(b.y); b.z = sigmoidf_(b.z); b.w = sigmoidf_(b.w); }
                        u32x4 w; w.x = cvtpk(a.x, a.y); w.y = cvtpk(a.z, a.w); w.z = cvtpk(b.x, b.y); w.w = cvtpk(b.z, b.w); *(u32x4*)(rp + 32 * bj) = w;
                    }
                }
        } else if (type == 2) {
            int nh, dv, vh, dbase;
            if (pn < 12) { nh = 8; dv = 128; vh = 2 * (pn - 8) + (wc >> 1); dbase = 64 * (wc & 1); } else { nh = 4; dv = 64; vh = wc; dbase = 0; }
#pragma unroll
            for (int ai = 0; ai < 2; ++ai)
#pragma unroll
                for (int m = 0; m < 4; ++m) {
                    const int row = row0 + ai * 128 + m * 16, b = row >> 12, t = row & (SEQ - 1);
                    bf16_t* bp = dst + ((size_t)(b * nh + vh) * dv + dbase + 8 * fq) * SEQ + perm16(t);
#pragma unroll
                    for (int bj = 0; bj < 2; ++bj)
#pragma unroll
                        for (int n = 0; n < 2; ++n) { const f32x4 v = acc[ai][bj][m][n]; bf16_t* q = bp + (size_t)(32 * bj + 4 * n) * SEQ;
                            q[0] = f2bf(v.x); q[SEQ] = f2bf(v.y); q[2 * SEQ] = f2bf(v.z); q[3 * SEQ] = f2bf(v.w); }
                }
        } else {
            float* NG = (float*)(ws + WS_NG);
            if (wc == 0) {
#pragma unroll
                for (int ai = 0; ai < 2; ++ai)
#pragma unroll
                    for (int m = 0; m < 4; ++m) {
                        const int row = row0 + ai * 128 + m * 16;
#pragma unroll
                        for (int bj = 0; bj < 2; ++bj)
#pragma unroll
                            for (int n = 0; n < 2; ++n) { const int L = 32 * bj + 8 * fq + 4 * n; if (L < 48) { const f32x4 v = acc[ai][bj][m][n];
                                f32x4 o; o.x = sigmoidf_(v.x); o.y = sigmoidf_(v.y); o.z = sigmoidf_(v.z); o.w = sigmoidf_(v.w); *(f32x4*)(NG + (size_t)row * 48 + L) = o; } }
                    }
            }
        }
    }
    unsigned char* mgp;
    __device__ __forceinline__ unsigned char* P_MG() const { return mgp; }
};
struct EpiHid {
    static constexpr bool PERM = true, AFTER_DRAIN = false;
    bf16_t* HID; const LAS float* pb;
    __device__ __forceinline__ void operator()(const f32x4 (&acc)[2][2][4][2], const pg8::Unit& u, int wr, int wc, int fr, int fq) const {
        const int row0 = u.pm * 256 + wr * 64 + fr, col0 = wc * 32 + 8 * fq;
#pragma unroll
        for (int ai = 0; ai < 2; ++ai)
#pragma unroll
            for (int m = 0; m < 4; ++m) { bf16_t* rp = HID + (size_t)(row0 + ai * 128 + m * 16) * 256 + col0;
#pragma unroll
                for (int bj = 0; bj < 2; ++bj) { const f32x4 b0 = *(const LAS f32x4*)(pb + col0 + 128 * bj), b1 = *(const LAS f32x4*)(pb + col0 + 128 * bj + 4);
                    const f32x4 a = acc[ai][bj][m][0] + b0, b = acc[ai][bj][m][1] + b1;
                    u32x4 w; w.x = cvtpk(gelu_tanh(a.x), gelu_tanh(a.y)); w.y = cvtpk(gelu_tanh(a.z), gelu_tanh(a.w)); w.z = cvtpk(gelu_tanh(b.x), gelu_tanh(b.y)); w.w = cvtpk(gelu_tanh(b.z), gelu_tanh(b.w));
                    *(u32x4*)(rp + 128 * bj) = w; asm volatile("" ::: "memory"); } }
    }
};
template <int MODE> struct EpiMerge {
    static constexpr bool PERM = false, AFTER_DRAIN = false;
    const bf16_t* MG; float* T1; bf16_t* MIXED;
    __device__ __forceinline__ void operator()(const f32x4 (&acc)[2][2][4][2], const pg8::Unit& u, int wr, int wc, int fr, int fq) const {
        const int row0 = u.pm * 256 + wr * 64 + fr, col0 = u.pn * 256 + wc * 32 + 4 * fq;
#pragma unroll
        for (int ai = 0; ai < 2; ++ai)
#pragma unroll
            for (int m = 0; m < 4; ++m) { const size_t row = row0 + ai * 128 + m * 16;
#pragma unroll
                for (int bj = 0; bj < 2; ++bj)
#pragma unroll
                    for (int n = 0; n < 2; ++n) { const int col = col0 + 128 * bj + 16 * n;
                        const u32x2 gw = *(const u32x2*)(MG + row * 2048 + MODE * 1024 + col);
                        f32x4 gt; gt.x = __uint_as_float(gw.x << 16); gt.y = __uint_as_float(gw.x & 0xffff0000u); gt.z = __uint_as_float(gw.y << 16); gt.w = __uint_as_float(gw.y & 0xffff0000u);
                        if (MODE == 0) { const f32x4 v = gt * acc[ai][bj][m][n]; u32x2 w; w.x = cvtpk(v.x, v.y); w.y = cvtpk(v.z, v.w); *(u32x2*)(MIXED + row * 1024 + col) = w; }
                        else { const u32x2 tw = *(const u32x2*)(MIXED + row * 1024 + col); f32x4 t1; t1.x = __uint_as_float(tw.x << 16); t1.y = __uint_as_float(tw.x & 0xffff0000u); t1.z = __uint_as_float(tw.y << 16); t1.w = __uint_as_float(tw.y & 0xffff0000u); const f32x4 v = t1 + gt * acc[ai][bj][m][n]; u32x2 w; w.x = cvtpk(v.x, v.y); w.y = cvtpk(v.z, v.w); *(u32x2*)(MIXED + row * 1024 + col) = w; }
                    } }
    }
};
struct EpiMerge2 {
    static constexpr bool PERM = false, AFTER_DRAIN = false;
    const bf16_t* MG; bf16_t* MIXED;
    template <int W> __device__ __forceinline__ void run(const f32x4 (&acc)[2][2][4][2], const pg8::Unit& u, int wr, int wc, int fr, int fq) const {
        const int row0 = (u.pm & 63) * 256 + wr * 64 + fr, col0 = (u.pn & 3) * 256 + wc * 32 + 4 * fq;
#pragma unroll
        for (int ai = 0; ai < 2; ++ai) {
            u32x2 gwv[4][2][2], twv[4][2][2];
#pragma unroll
            for (int m = 0; m < 4; ++m)
#pragma unroll
                for (int bj = 0; bj < 2; ++bj)
#pragma unroll
                    for (int n = 0; n < 2; ++n) { const size_t row = row0 + ai * 128 + m * 16; const int col = col0 + 128 * bj + 16 * n;
                        gwv[m][bj][n] = *(const u32x2*)(MG + row * 2048 + W * 1024 + col);
                        if (W) twv[m][bj][n] = *(const u32x2*)(MIXED + row * 1024 + col); }
            asm volatile("" ::: "memory");
#pragma unroll
            for (int m = 0; m < 4; ++m)
#pragma unroll
                for (int bj = 0; bj < 2; ++bj)
#pragma unroll
                    for (int n = 0; n < 2; ++n) { const size_t row = row0 + ai * 128 + m * 16; const int col = col0 + 128 * bj + 16 * n; const u32x2 gw = gwv[m][bj][n];
                        f32x4 gt; gt.x = __uint_as_float(gw.x << 16); gt.y = __uint_as_float(gw.x & 0xffff0000u); gt.z = __uint_as_float(gw.y << 16); gt.w = __uint_as_float(gw.y & 0xffff0000u);
                        f32x4 v = gt * acc[ai][bj][m][n];
                        if (W) { const u32x2 tw = twv[m][bj][n]; f32x4 t1; t1.x = __uint_as_float(tw.x << 16); t1.y = __uint_as_float(tw.x & 0xffff0000u); t1.z = __uint_as_float(tw.y << 16); t1.w = __uint_as_float(tw.y & 0xffff0000u); v = v + t1; }
                        u32x2 wv; wv.x = cvtpk(v.x, v.y); wv.y = cvtpk(v.z, v.w); *(u32x2*)(MIXED + row * 1024 + col) = wv; }
            asm volatile("" ::: "memory");
        }
    }
    __device__ __forceinline__ void operator()(const f32x4 (&acc)[2][2][4][2], const pg8::Unit& u, int wr, int wc, int fr, int fq) const {
        if ((u.pm >> 6) == 0) run<0>(acc, u, wr, wc, fr, fq); else run<1>(acc, u, wr, wc, fr, fq);
    }
};
struct TwoSched {
    pg8::StaticOrder S;
    __device__ __forceinline__ bool next(int i, pg8::Unit& u) const { pg8::Unit b; if (!S.next(i >> 1, b)) return false; const int w = i & 1; u.pm = b.pm + 64 * w; u.pn = b.pn + 4 * w; return true; }
    __device__ __forceinline__ void a_ready(const pg8::Unit&) const {}
    __device__ __forceinline__ void done(const pg8::Unit&) const {}
};
struct EpiRes1 {
    static constexpr bool PERM = false, AFTER_DRAIN = false;
    const float* x; float* out; bf16_t* XB1; float* PART;
    __device__ __forceinline__ void operator()(const f32x4 (&acc)[2][2][4][2], const pg8::Unit& u, int wr, int wc, int fr, int fq) const {
        const int row0 = u.pm * 256 + wr * 64 + fr, col0 = u.pn * 256 + wc * 32 + 4 * fq;
#pragma unroll
        for (int ai = 0; ai < 2; ++ai) {
            f32x4 xv[4][2][2];
#pragma unroll
            for (int m = 0; m < 4; ++m)
#pragma unroll
                for (int bj = 0; bj < 2; ++bj)
#pragma unroll
                    for (int n = 0; n < 2; ++n) xv[m][bj][n] = *(const f32x4*)(x + (size_t)(row0 + ai * 128 + m * 16) * 1024 + col0 + 128 * bj + 16 * n);
            asm volatile("" ::: "memory");
#pragma unroll
            for (int m = 0; m < 4; ++m) { const size_t row = row0 + ai * 128 + m * 16; float ss = 0.f;
#pragma unroll
                for (int bj = 0; bj < 2; ++bj)
#pragma unroll
                    for (int n = 0; n < 2; ++n) { const int col = col0 + 128 * bj + 16 * n;
                        const f32x4 v = xv[m][bj][n] + acc[ai][bj][m][n];
                        u32x2 w; w.x = cvtpk(v.x, v.y); w.y = cvtpk(v.z, v.w); *(u32x2*)(XB1 + row * 1024 + col) = w;
                        ss += (v.x * v.x + v.y * v.y) + (v.z * v.z + v.w * v.w); }
                ss += __shfl_xor(ss, 16); ss += __shfl_xor(ss, 32);
                if (fq == 0) PART[row * 16 + u.pn * 4 + wc] = ss; }
            asm volatile("" ::: "memory");
        }
    }
};
struct EpiUp {
    static constexpr bool PERM = true, AFTER_DRAIN = false;
    const float* PART; bf16_t* HB;
    __device__ __forceinline__ void operator()(const f32x4 (&acc)[2][2][4][2], const pg8::Unit& u, int wr, int wc, int fr, int fq) const {
        const int row0 = u.pm * 256 + wr * 64 + fr, col0 = u.pn * 256 + wc * 32 + 8 * fq;
#pragma unroll
        for (int ai = 0; ai < 2; ++ai)
#pragma unroll
            for (int m = 0; m < 4; ++m) { const size_t row = row0 + ai * 128 + m * 16;
                const f32x4* pp = (const f32x4*)(PART + row * 16); const f32x4 p0 = pp[0], p1 = pp[1], p2 = pp[2], p3 = pp[3];
                const float ss = ((p0.x + p0.y) + (p0.z + p0.w)) + ((p1.x + p1.y) + (p1.z + p1.w)) + ((p2.x + p2.y) + (p2.z + p2.w)) + ((p3.x + p3.y) + (p3.z + p3.w));
                const float rstd = rsqrtf(ss * (1.f / 1024.f) + EPS);
#pragma unroll
                for (int bj = 0; bj < 2; ++bj) { f32x4 a = acc[ai][bj][m][0] * rstd, b = acc[ai][bj][m][1] * rstd;
                    a.x = fmaxf(a.x, 0.f); a.y = fmaxf(a.y, 0.f); a.z = fmaxf(a.z, 0.f); a.w = fmaxf(a.w, 0.f); b.x = fmaxf(b.x, 0.f); b.y = fmaxf(b.y, 0.f); b.z = fmaxf(b.z, 0.f); b.w = fmaxf(b.w, 0.f);
                    a = a * a; b = b * b;
                    u32x4 w; w.x = cvtpk(a.x, a.y); w.y = cvtpk(a.z, a.w); w.z = cvtpk(b.x, b.y); w.w = cvtpk(b.z, b.w); *(u32x4*)(HB + row * 4096 + col0 + 128 * bj) = w; } }
    }
};
struct EpiRes2 {
    static constexpr bool PERM = false, AFTER_DRAIN = false;
    float* out; float scale; const bf16_t* XB1;
    __device__ __forceinline__ void operator()(const f32x4 (&acc)[2][2][4][2], const pg8::Unit& u, int wr, int wc, int fr, int fq) const {
        const int row0 = u.pm * 256 + wr * 64 + fr, col0 = u.pn * 256 + wc * 32 + 4 * fq;
#pragma unroll
        for (int ai = 0; ai < 2; ++ai) {
            u32x2 xw[4][2][2];
#pragma unroll
            for (int m = 0; m < 4; ++m)
#pragma unroll
                for (int bj = 0; bj < 2; ++bj)
#pragma unroll
                    for (int n = 0; n < 2; ++n) xw[m][bj][n] = *(const u32x2*)(XB1 + (size_t)(row0 + ai * 128 + m * 16) * 1024 + col0 + 128 * bj + 16 * n);
            asm volatile("" ::: "memory");
#pragma unroll
            for (int m = 0; m < 4; ++m)
#pragma unroll
                for (int bj = 0; bj < 2; ++bj)
#pragma unroll
                    for (int n = 0; n < 2; ++n) { const size_t off = (size_t)(row0 + ai * 128 + m * 16) * 1024 + col0 + 128 * bj + 16 * n; const u32x2 w = xw[m][bj][n];
                        f32x4 x1; x1.x = __uint_as_float(w.x << 16); x1.y = __uint_as_float(w.x & 0xffff0000u); x1.z = __uint_as_float(w.y << 16); x1.w = __uint_as_float(w.y & 0xffff0000u);
                        *(f32x4*)(out + off) = x1 + acc[ai][bj][m][n] * scale; }
            asm volatile("" ::: "memory");
        }
    }
};
struct OneUnit {
    int pm, pn;
    __device__ bool next(int i, pg8::Unit& u) const { if (i > 0) return false; u.pm = pm; u.pn = pn; return true; }
    __device__ __forceinline__ void a_ready(const pg8::Unit&) const {}
    __device__ __forceinline__ void done(const pg8::Unit&) const {}
};

#define MFMA32(a, b, c) __builtin_amdgcn_mfma_f32_32x32x16_bf16((a), (b), (c), 0, 0, 0)
#define EXP2(x) __builtin_amdgcn_exp2f(x)

__device__ __forceinline__ void load_q(const bf16_t* qrow, int hi, bf16x8 (&qf)[4]) {
#pragma unroll
    for (int ds = 0; ds < 4; ++ds) qf[ds] = *(const bf16x8*)(qrow + 16 * ds + 8 * hi);
    asm volatile("" : "+v"(qf[0]), "+v"(qf[1]), "+v"(qf[2]), "+v"(qf[3]));
}
template <int KROW>
__device__ __forceinline__ void qk_tile(const LAS bf16_t* Kt, const bf16x8 (&qf)[4], f32x16 (&s)[2], int r32, int hi) {
#pragma unroll
    for (int kb = 0; kb < 2; ++kb) {
        f32x16 a = {};
#pragma unroll
        for (int ds = 0; ds < 4; ++ds) { const bf16x8 kf = *(const LAS bf16x8*)(Kt + (32 * kb + r32) * KROW + 16 * ds + 8 * hi); a = MFMA32(kf, qf[ds], a); }
        s[kb] = a;
    }
}
template <int DV, int VROW>
__device__ __forceinline__ void pv_tile(const LAS bf16_t* Vt, const f32x16 (&p)[2], f32x16 (&o)[DV / 32], int r32, int hi) {
    bf16x8 pb[4];
#pragma unroll
    for (int j = 0; j < 4; ++j) { const int kb = j >> 1, r0 = 8 * (j & 1); u32x4 w; w.x = cvtpk(p[kb][r0], p[kb][r0 + 1]); w.y = cvtpk(p[kb][r0 + 2], p[kb][r0 + 3]); w.z = cvtpk(p[kb][r0 + 4], p[kb][r0 + 5]); w.w = cvtpk(p[kb][r0 + 6], p[kb][r0 + 7]); pb[j] = __builtin_bit_cast(bf16x8, w); }
#pragma unroll
    for (int db = 0; db < DV / 32; ++db) {
        bf16x8 vf[4];
#pragma unroll
        for (int j = 0; j < 4; ++j) vf[j] = *(const LAS bf16x8*)(Vt + (32 * db + r32) * VROW + 16 * j + 8 * hi);
#pragma unroll
        for (int j = 0; j < 4; ++j) o[db] = MFMA32(vf[j], pb[j], o[db]);
        __builtin_amdgcn_sched_barrier(0);
    }
}
template <int DV, class TF>
__device__ __forceinline__ void attn_loop(LAS unsigned char* lds, const bf16_t* Kg, int ldk, const bf16_t* VTg, int ldv, unsigned long long tmask,
                                          const bf16x8 (&qf)[4], f32x16 (&o)[DV / 32], float& m, float& l, const TF& tf) {
    const int tid = threadIdx.x, lane = tid & 63, r32 = lane & 31, hi = lane >> 5, srow = tid >> 3, sch = tid & 7;
    u32x4 kreg, vreg[DV / 64];
    int buf = 0;
    if (tmask) { const int t = __builtin_ctzll(tmask); kreg = *(const u32x4*)(Kg + (size_t)(64 * t + srow) * ldk + sch * 8);
#pragma unroll
        for (int i = 0; i < DV / 64; ++i) vreg[i] = *(const u32x4*)(VTg + (size_t)(srow + 64 * i) * ldv + 64 * t + sch * 8); }
    while (tmask) {
        const int t = __builtin_ctzll(tmask); tmask &= tmask - 1;
        LAS bf16_t* Kt = (LAS bf16_t*)(lds + buf * ABUF); LAS bf16_t* Vt = Kt + 64 * TROW;
        *(LAS u32x4*)(Kt + srow * TROW + sch * 8) = kreg;
#pragma unroll
        for (int i = 0; i < DV / 64; ++i) *(LAS u32x4*)(Vt + (srow + 64 * i) * TROW + sch * 8) = vreg[i];
        __syncthreads();
        if (tmask) { const int tn = __builtin_ctzll(tmask); kreg = *(const u32x4*)(Kg + (size_t)(64 * tn + srow) * ldk + sch * 8);
#pragma unroll
            for (int i = 0; i < DV / 64; ++i) vreg[i] = *(const u32x4*)(VTg + (size_t)(srow + 64 * i) * ldv + 64 * tn + sch * 8); }
        const int md = tf.mode(t);
        if (md) {
            f32x16 s[2];
            qk_tile<TROW>(Kt, qf, s, r32, hi);
            if (md == 2) {
                const int lim_hi = tf.lim_hi(t), lim_lo = tf.lim_lo(t);
#pragma unroll
                for (int kb = 0; kb < 2; ++kb)
#pragma unroll
                    for (int r = 0; r < 16; ++r) { const int kc_ = 32 * kb + (r & 3) + 8 * (r >> 2); if (kc_ > lim_hi || kc_ < lim_lo) s[kb][r] = -INFINITY; }
            }
            float mx = fmaxf(s[0][0], s[1][0]);
#pragma unroll
            for (int r = 1; r < 16; ++r) mx = fmaxf(mx, fmaxf(s[0][r], s[1][r]));
            mx = fmaxf(mx, __shfl_xor(mx, 32));
            const float mn = fmaxf(m, mx), alpha = EXP2(m - mn); m = mn;
            float rs = 0.f;
#pragma unroll
            for (int kb = 0; kb < 2; ++kb)
#pragma unroll
                for (int r = 0; r < 16; ++r) { const float e = EXP2(s[kb][r] - mn); s[kb][r] = e; rs += e; }
            l = l * alpha + rs;
            if (!__all(alpha == 1.0f)) {
#pragma unroll
                for (int db = 0; db < DV / 32; ++db) o[db] = o[db] * alpha;
            }
            pv_tile<DV, TROW>(Vt, s, o, r32, hi);
        }
        buf ^= 1;
    }
    __syncthreads();
}


template <int DV, bool LSEL, class TF>
__device__ __forceinline__ void attn_loop_fast(LAS unsigned char* lds, const bf16_t* Kg, int ldk, const bf16_t* VTg, int ldv, unsigned long long tmask,
                                               const bf16x8 (&qf)[4], f32x16 (&o)[DV / 32], f32x4& lsum, const TF& tf) {
    constexpr int ABF = (64 + DV) * TROW * 2;
    const int tid = threadIdx.x, lane = tid & 63, r32 = lane & 31, hi = lane >> 5, srow = tid >> 3, sch = tid & 7;
    if (!tmask) return;
    u32x4 kreg, vreg[DV / 64];
#define AF_LOAD(t) do { kreg = *(const u32x4*)(Kg + (size_t)(64 * (t) + srow) * ldk + sch * 8); _Pragma("unroll") for (int i_ = 0; i_ < DV / 64; ++i_) vreg[i_] = *(const u32x4*)(VTg + (size_t)(srow + 64 * i_) * ldv + 64 * (t) + sch * 8); } while (0)
#define AF_STORE(b) do { LAS bf16_t* Kt_ = (LAS bf16_t*)(lds + (b) * ABF); *(LAS u32x4*)(Kt_ + srow * TROW + sch * 8) = kreg; _Pragma("unroll") for (int i_ = 0; i_ < DV / 64; ++i_) *(LAS u32x4*)(Kt_ + 64 * TROW + (srow + 64 * i_) * TROW + sch * 8) = vreg[i_]; } while (0)
    int tc = __builtin_ctzll(tmask); tmask &= tmask - 1;
    AF_LOAD(tc); AF_STORE(0);
    int tn = -1; if (tmask) { tn = __builtin_ctzll(tmask); tmask &= tmask - 1; AF_LOAD(tn); }
    __syncthreads();
    f32x16 sA[2], sB[2];
    int bc = 0;
    if (tf.mode(tc)) qk_tile<TROW>((const LAS bf16_t*)(lds), qf, sA, r32, hi);
#define AF_STEP(scur, snxt) do { \
        const int bn = (bc == 2) ? 0 : bc + 1; \
        if (tn >= 0) AF_STORE(bn); \
        __syncthreads(); \
        int tnn = -1; if (tmask) { tnn = __builtin_ctzll(tmask); tmask &= tmask - 1; AF_LOAD(tnn); } \
        if (tn >= 0 && tf.mode(tn)) qk_tile<TROW>((const LAS bf16_t*)(lds + bn * ABF), qf, snxt, r32, hi); \
        const int md = tf.mode(tc); \
        if (md) { \
            _Pragma("unroll") for (int kb = 0; kb < 2; ++kb) _Pragma("unroll") for (int r = 0; r < 16; ++r) scur[kb][r] = EXP2(scur[kb][r]); \
            if (md == 2) { const int lim_hi = tf.lim_hi(tc), lim_lo = tf.lim_lo(tc); _Pragma("unroll") for (int kb = 0; kb < 2; ++kb) _Pragma("unroll") for (int r = 0; r < 16; ++r) { const int kc_ = 32 * kb + (r & 3) + 8 * (r >> 2); if (kc_ > lim_hi || kc_ < lim_lo) scur[kb][r] = 0.f; } } \
            bf16x8 pb[4]; \
            if constexpr (LSEL) { const bool sel = tf.lanesel(tc); const float sm = sel ? 1.f : 0.f; const unsigned am = sel ? 0xffffffffu : 0u; { const f32x16 t16_ = scur[0] + scur[1]; const f32x8 t8_ = t16_.lo + t16_.hi; lsum = lsum + (t8_.lo + t8_.hi) * sm; } \
                _Pragma("unroll") for (int j = 0; j < 4; ++j) { const int kb = j >> 1, r0 = 8 * (j & 1); u32x4 w; w.x = cvtpk(scur[kb][r0], scur[kb][r0 + 1]) & am; w.y = cvtpk(scur[kb][r0 + 2], scur[kb][r0 + 3]) & am; w.z = cvtpk(scur[kb][r0 + 4], scur[kb][r0 + 5]) & am; w.w = cvtpk(scur[kb][r0 + 6], scur[kb][r0 + 7]) & am; pb[j] = __builtin_bit_cast(bf16x8, w); } \
            } else { { const f32x16 t16_ = scur[0] + scur[1]; const f32x8 t8_ = t16_.lo + t16_.hi; lsum = lsum + (t8_.lo + t8_.hi); } \
                _Pragma("unroll") for (int j = 0; j < 4; ++j) { const int kb = j >> 1, r0 = 8 * (j & 1); u32x4 w; w.x = cvtpk(scur[kb][r0], scur[kb][r0 + 1]); w.y = cvtpk(scur[kb][r0 + 2], scur[kb][r0 + 3]); w.z = cvtpk(scur[kb][r0 + 4], scur[kb][r0 + 5]); w.w = cvtpk(scur[kb][r0 + 6], scur[kb][r0 + 7]); pb[j] = __builtin_bit_cast(bf16x8, w); } } \
            const LAS bf16_t* Vt_ = (const LAS bf16_t*)(lds + bc * ABF) + 64 * TROW; \
            _Pragma("unroll") for (int db = 0; db < DV / 32; ++db) { bf16x8 vf[4]; \
                _Pragma("unroll") for (int j = 0; j < 4; ++j) vf[j] = *(const LAS bf16x8*)(Vt_ + (32 * db + r32) * TROW + 16 * j + 8 * hi); \
                _Pragma("unroll") for (int j = 0; j < 4; ++j) o[db] = MFMA32(vf[j], pb[j], o[db]); } \
        } \
        tc = tn; tn = tnn; bc = bn; \
    } while (0)
    for (;;) {
        AF_STEP(sA, sB); if (tc < 0) break;
        AF_STEP(sB, sA); if (tc < 0) break;
    }
    __syncthreads();
#undef AF_LOAD
#undef AF_STORE
#undef AF_STEP
}
__device__ __forceinline__ float hsum4(const f32x4& v) { return (v[0] + v[1]) + (v[2] + v[3]); }

struct DiffTF { int qlo, qpos, hi4; __device__ __forceinline__ int mode(int t) const { return 64 * t > qlo + 31 ? 0 : (64 * t + 63 > qlo ? 2 : 1); }
    __device__ __forceinline__ int lim_hi(int t) const { return qpos - 64 * t - hi4; } __device__ __forceinline__ int lim_lo(int t) const { return -(1 << 30); } };
template <bool FAST>
__device__ __forceinline__ void diff_unit(const Params& P, LAS unsigned char* lds, int b, int h, int qb, float lam, bool dry) {
    const int tid = threadIdx.x, lane = tid & 63, wave = tid >> 6, r32 = lane & 31, hi = lane >> 5;
    unsigned char* ws = P.ws;
    const int q0 = qb * 256, qpos = q0 + 32 * wave + r32;
    bf16_t* DQ = (bf16_t*)(ws + WS_DQ); const bf16_t* DK = (const bf16_t*)(ws + WS_DK); const bf16_t* DVT = (const bf16_t*)(ws + WS_DVT);
    bf16_t* qrow = DQ + (size_t)(b * SEQ + qpos) * 1024 + h * 128;
    const unsigned long long tmask = (qb == 15) ? ~0ull : ((1ull << (4 * qb + 4)) - 1ull);
    DiffTF tf; tf.qlo = q0 + 32 * wave; tf.qpos = qpos; tf.hi4 = 4 * hi;
    LAS unsigned* o0p = (LAS unsigned*)(lds + L_O0P) + wave * 32 * 64 + lane;
    f32x16 o0[4];
#pragma unroll
    for (int c = 0; c < 2; ++c) {
        bf16x8 qf[4]; load_q(qrow + 64 * c, hi, qf);
        f32x16 o[4];
#pragma unroll
        for (int db = 0; db < 4; ++db) o[db] = (f32x16){};
        float m = -1e30f, l = 0.f;
        if (FAST) { f32x4 ls = {}; attn_loop_fast<128, false, DiffTF>(lds, DK + (size_t)b * SEQ * 1024 + (h * 2 + c) * 64, 1024, DVT + (size_t)((b * 8 + h) * 128) * SEQ, SEQ, tmask, qf, o, ls, tf); l = hsum4(ls); }
        else attn_loop<128, DiffTF>(lds, DK + (size_t)b * SEQ * 1024 + (h * 2 + c) * 64, 1024, DVT + (size_t)((b * 8 + h) * 128) * SEQ, SEQ, tmask, qf, o, m, l, tf);
        l += __shfl_xor(l, 32);
        const float inv = 1.0f / fmaxf(l, 1e-30f);
        if (c == 0) {
#pragma unroll
            for (int db = 0; db < 4; ++db)
#pragma unroll
                for (int r = 0; r < 8; ++r) o0p[(db * 8 + r) * 64] = cvtpk(o[db][2 * r] * inv, o[db][2 * r + 1] * inv);
        } else {
            const float il = inv * lam;
#pragma unroll
            for (int db = 0; db < 4; ++db)
#pragma unroll
                for (int r = 0; r < 8; ++r) { const unsigned pw = o0p[(db * 8 + r) * 64]; o0[db][2 * r] = __uint_as_float(pw << 16) - o[db][2 * r] * il; o0[db][2 * r + 1] = __uint_as_float(pw & 0xffff0000u) - o[db][2 * r + 1] * il; }
        }
    }
    float ss = 0.f;
#pragma unroll
    for (int db = 0; db < 4; ++db)
#pragma unroll
        for (int r = 0; r < 16; ++r) ss += o0[db][r] * o0[db][r];
    ss += __shfl_xor(ss, 32);
    const float rstd = rsqrtf(ss * (1.f / 128.f) + EPS) * 0.8f;
    const float* sg = P.in[9];
#pragma unroll
    for (int db = 0; db < 4; ++db)
#pragma unroll
        for (int u = 0; u < 4; ++u) { const int d = 32 * db + 8 * u + 4 * hi; const f32x4 g4 = *(const f32x4*)(sg + d);
            u32x2 w; w.x = cvtpk(o0[db][4 * u] * rstd * g4.x, o0[db][4 * u + 1] * rstd * g4.y); w.y = cvtpk(o0[db][4 * u + 2] * rstd * g4.z, o0[db][4 * u + 3] * rstd * g4.w);
            if (!dry) *(u32x2*)(qrow + d) = w; }
}

__device__ __forceinline__ void compress_unit(const Params& P, LAS unsigned char* lds, int which, int pm) {
    unsigned char* ws = P.ws;
    bf16_t* HID = (bf16_t*)(ws + WS_HID) + (size_t)which * 4096 * 256;
    {
        pg8::Gemm g = pg8::make_gemm((const bf16_t*)(ws + (which ? WS_VC : WS_KC)), (const bf16_t*)(ws + WS_W1T) + (size_t)which * 256 * 2048, 4096, 256, 2048);
        g.lda = 4096; g.kstepA = 512; g.a_sh = 2; g.a_lo = (size_t)256 * 4096 * 2; g.a_hi = 128;
        LAS float* pbs = (LAS float*)(lds + 131072);
        if (threadIdx.x < 256) { const float* pp = (const float*)(ws + WS_PB) + which * 16 * 256 + threadIdx.x; float sacc = 0.f;
#pragma unroll
            for (int kc = 0; kc < 16; ++kc) sacc += pp[kc * 256];
            pbs[threadIdx.x] = sacc; }
        __syncthreads();
        OneUnit S{pm, 0}; EpiHid E{HID, pbs};
        pg8::gemm_phase<EpiHid, OneUnit, false, true>((PG8_LAS unsigned char*)lds, g, S, E);
    }
    __threadfence(); __syncthreads(); __threadfence();
    int tid = threadIdx.x; asm volatile("" : "+v"(tid));
    const int lane = tid & 63, wave = tid >> 6, r32 = lane & 31, hi = lane >> 5;
    const bf16_t* W2T = (const bf16_t*)(ws + WS_W2T) + which * 64 * 256;
    const int rowl = 32 * wave + r32; const bf16_t* hrow = HID + (size_t)(pm * 256 + rowl) * 256;
    f32x16 c0 = {}, c1 = {};
#pragma unroll 2
    for (int ks = 0; ks < 16; ++ks) {
        const bf16x8 a0 = *(const bf16x8*)(W2T + r32 * 256 + 16 * ks + 8 * hi), a1 = *(const bf16x8*)(W2T + (32 + r32) * 256 + 16 * ks + 8 * hi), bf = *(const bf16x8*)(hrow + 16 * ks + 8 * hi);
        c0 = MFMA32(a0, bf, c0); c1 = MFMA32(a1, bf, c1);
    }
    const int g = pm >> 2, b = pm & 3, n = rowl;
    if (which == 0) {
        float ss = 0.f;
#pragma unroll
        for (int r = 0; r < 16; ++r) ss += c0[r] * c0[r] + c1[r] * c1[r];
        ss += __shfl_xor(ss, 32);
        const float rstd = (n < 255) ? rsqrtf(ss * (1.f / 64.f) + EPS) : 0.f;
        const float* gk = P.in[11]; const float* CC = (const float*)(ws + WS_CCOS) + n * 32; const float* CS = (const float*)(ws + WS_CSIN) + n * 32;
        bf16_t* kr = (bf16_t*)(ws + WS_KCMP) + (size_t)((b * 4 + g) * 256 + n) * 64;
#pragma unroll
        for (int u = 0; u < 4; ++u) { const int i = 8 * u + 4 * hi; const f32x4 g1 = *(const f32x4*)(gk + i), g2 = *(const f32x4*)(gk + 32 + i), cc = *(const f32x4*)(CC + i), sn = *(const f32x4*)(CS + i);
            float o1[4], o2[4];
#pragma unroll
            for (int j = 0; j < 4; ++j) { const float x1 = c0[4 * u + j] * rstd * g1[j], x2 = c1[4 * u + j] * rstd * g2[j]; o1[j] = x1 * cc[j] - x2 * sn[j]; o2[j] = x2 * cc[j] + x1 * sn[j]; }
            u32x2 w; w.x = cvtpk(o1[0], o1[1]); w.y = cvtpk(o1[2], o1[3]); *(u32x2*)(kr + i) = w; w.x = cvtpk(o2[0], o2[1]); w.y = cvtpk(o2[2], o2[3]); *(u32x2*)(kr + 32 + i) = w; }
    } else {
        bf16_t* vt = (bf16_t*)(ws + WS_VCMPT) + (size_t)((b * 4 + g) * 64) * 256 + perm16(n);
        const float z = (n < 255) ? 1.f : 0.f;
#pragma unroll
        for (int r = 0; r < 16; ++r) { const int d = crow(r, hi); vt[(size_t)d * 256] = f2bf(c0[r] * z); vt[(size_t)(d + 32) * 256] = f2bf(c1[r] * z); }
    }
}

struct SlcTF { unsigned long long mymask, wu; int qpos, hi4; __device__ __forceinline__ int mode(int t) const { return ((wu >> t) & 1ull) ? 2 : 0; }
    __device__ __forceinline__ int lim_hi(int t) const { return ((mymask >> t) & 1ull) ? qpos - 64 * t - hi4 : -(1 << 30); } __device__ __forceinline__ int lim_lo(int t) const { return -(1 << 30); } };
struct SlcTFF { unsigned long long mymask, wu; int qpos, c, hi4; __device__ __forceinline__ int mode(int t) const { return ((wu >> t) & 1ull) ? (t == c ? 2 : 1) : 0; }
    __device__ __forceinline__ bool lanesel(int t) const { return (mymask >> t) & 1ull; }
    __device__ __forceinline__ int lim_hi(int t) const { return qpos - 64 * t - hi4; } __device__ __forceinline__ int lim_lo(int t) const { return -(1 << 30); } };
struct WinTF { int c, qpos, hi4; __device__ __forceinline__ int mode(int t) const { return (t == c || t == c - 8) ? 2 : 1; }
    __device__ __forceinline__ int lim_hi(int t) const { return qpos - 64 * t - hi4; } __device__ __forceinline__ int lim_lo(int t) const { return qpos - 511 - 64 * t - hi4; } };
template <bool FAST>
__device__ __forceinline__ void nsa_unit(const Params& P, LAS unsigned char* lds, int b, int g, int c, bool dry) {
    const int tid = threadIdx.x, lane = tid & 63, wave = tid >> 6, r32 = lane & 31, hi = lane >> 5;
    unsigned char* ws = P.ws;
    const int q0 = 64 * c, tk = r32 >> 2, hg = r32 & 3, tokl = 8 * wave + tk, qpos = q0 + tokl;
    bf16_t* qrow = (bf16_t*)(ws + WS_NQ) + (size_t)(b * SEQ + qpos) * 1024 + (g * 4 + hg) * 64;
    bf16x8 qf[4]; load_q(qrow, hi, qf);
    const float* ngp = (const float*)(ws + WS_NG) + (size_t)(b * SEQ + qpos) * 48 + (g * 4 + hg) * 3;
    const float gate0 = ngp[0], gate1 = ngp[1], gate2 = ngp[2];
    f32x16 yt[2]; yt[0] = (f32x16){}; yt[1] = (f32x16){};
    const int ntl = (4 * c + 2) / 64 + 1;
    LAS bf16_t* CK = (LAS bf16_t*)(lds + L_CK); LAS bf16_t* CV = (LAS bf16_t*)(lds + L_CV);
    LAS float* IMP = (LAS float*)(lds + L_IMP); LAS unsigned long long* SEL = (LAS unsigned long long*)(lds + L_SEL);
    {
        const bf16_t* kc = (const bf16_t*)(ws + WS_KCMP) + (size_t)((b * 4 + g) * 256) * 64; const bf16_t* vc = (const bf16_t*)(ws + WS_VCMPT) + (size_t)((b * 4 + g) * 64) * 256;
        u32x4 kr[4], vr[4]; const int srow = tid >> 3, sch = tid & 7;
#pragma unroll
        for (int it = 0; it < 4; ++it) if (it < ntl) { kr[it] = *(const u32x4*)(kc + (64 * it + srow) * 64 + sch * 8); vr[it] = *(const u32x4*)(vc + srow * 256 + (sch + 8 * it) * 8); }
#pragma unroll
        for (int it = 0; it < 4; ++it) if (it < ntl) { *(LAS u32x4*)(CK + (64 * it + srow) * CKROW + sch * 8) = kr[it]; *(LAS u32x4*)(CV + srow * CVROW + (sch + 8 * it) * 8) = vr[it]; }
    }
    __syncthreads();
    if constexpr (FAST) {
        const int nlim = ((qpos - 31) >> 4) - 4 * hi;
        f32x16 o[2]; o[0] = (f32x16){}; o[1] = (f32x16){};
        float lrow = 0.f, carry = 0.f; float ivq[4][8];
#pragma unroll
        for (int T = 0; T < 4; ++T) {
#pragma unroll
            for (int i = 0; i < 8; ++i) ivq[T][i] = 0.f;
            if (T < ntl) {
                f32x16 s[2]; qk_tile<CKROW>(CK + T * 64 * CKROW, qf, s, r32, hi);
#pragma unroll
                for (int kb = 0; kb < 2; ++kb)
#pragma unroll
                    for (int r = 0; r < 16; ++r) { const int kc_ = 32 * kb + (r & 3) + 8 * (r >> 2); const float e = EXP2(s[kb][r]); s[kb][r] = (kc_ > nlim - 64 * T) ? 0.f : e; }
#pragma unroll
                for (int kb = 0; kb < 2; ++kb)
#pragma unroll
                    for (int u = 0; u < 4; ++u) {
                        const float qs = (s[kb][4 * u] + s[kb][4 * u + 1]) + (s[kb][4 * u + 2] + s[kb][4 * u + 3]);
                        lrow += qs;
                        const float x = __shfl_xor(s[kb][4 * u + 3], 32);
                        ivq[T][kb * 4 + u] = qs + (hi ? x : carry); carry = x;
                    }
                pv_tile<64, CVROW>(CV + 64 * T, s, o, r32, hi);
            }
        }
        lrow += __shfl_xor(lrow, 32);
        const float invl = 1.0f / fmaxf(lrow, 1e-30f);
#pragma unroll
        for (int T = 0; T < 4; ++T)
            if (T < ntl) {
#pragma unroll
                for (int i = 0; i < 8; ++i) { float iv = ivq[T][i] * invl; iv += __shfl_xor(iv, 1); iv += __shfl_xor(iv, 2); if (hg == 0) IMP[tokl * 64 + 16 * T + 2 * i + hi] = iv; }
            }
        const float gs = gate0 * invl;
#pragma unroll
        for (int db = 0; db < 2; ++db) yt[db] = o[db] * gs;
    } else {
        const int nlim = ((qpos - 31) >> 4) - 4 * hi;
        float m = -1e30f, l = 0.f;
        for (int T = 0; T < ntl; ++T) {
            f32x16 s[2]; qk_tile<CKROW>(CK + T * 64 * CKROW, qf, s, r32, hi);
            float mx = -INFINITY;
#pragma unroll
            for (int kb = 0; kb < 2; ++kb)
#pragma unroll
                for (int r = 0; r < 16; ++r) { const int kc_ = 32 * kb + (r & 3) + 8 * (r >> 2); if (kc_ > nlim - 64 * T) s[kb][r] = -INFINITY; mx = fmaxf(mx, s[kb][r]); }
            mx = fmaxf(mx, __shfl_xor(mx, 32));
            const float mn = fmaxf(m, mx), alpha = EXP2(m - mn); m = mn; float rs = 0.f;
#pragma unroll
            for (int kb = 0; kb < 2; ++kb)
#pragma unroll
                for (int r = 0; r < 16; ++r) rs += EXP2(s[kb][r] - mn);
            l = l * alpha + rs;
        }
        l += __shfl_xor(l, 32);
        const float invl = 1.0f / fmaxf(l, 1e-30f);
        f32x16 o[2]; o[0] = (f32x16){}; o[1] = (f32x16){};
        float carry = 0.f;
        for (int T = 0; T < ntl; ++T) {
            f32x16 s[2]; qk_tile<CKROW>(CK + T * 64 * CKROW, qf, s, r32, hi);
#pragma unroll
            for (int kb = 0; kb < 2; ++kb)
#pragma unroll
                for (int r = 0; r < 16; ++r) { const int kc_ = 32 * kb + (r & 3) + 8 * (r >> 2); s[kb][r] = (kc_ > nlim - 64 * T) ? 0.f : EXP2(s[kb][r] - m) * invl; }
#pragma unroll
            for (int kb = 0; kb < 2; ++kb)
#pragma unroll
                for (int u = 0; u < 4; ++u) {
                    const float qs = (s[kb][4 * u] + s[kb][4 * u + 1]) + (s[kb][4 * u + 2] + s[kb][4 * u + 3]);
                    const float x = __shfl_xor(s[kb][4 * u + 3], 32);
                    float iv = qs + (hi ? x : carry); carry = x;
                    iv += __shfl_xor(iv, 1); iv += __shfl_xor(iv, 2);
                    if (hg == 0) IMP[tokl * 64 + 16 * T + 8 * kb + 2 * u + hi] = iv;
                }
            pv_tile<64, CVROW>(CV + 64 * T, s, o, r32, hi);
        }
#pragma unroll
        for (int db = 0; db < 2; ++db) yt[db] = o[db] * gate0;
    }
    __syncthreads();
    LAS float* yst = (LAS float*)(lds + L_CK) + tid;
#pragma unroll
    for (int db = 0; db < 2; ++db)
#pragma unroll
        for (int r = 0; r < 16; ++r) yst[(db * 16 + r) * NTHREADS] = yt[db][r];
    for (int i = 0; i < 8; ++i) {
        const int tl = 8 * wave + i; const int j = lane;
        const bool forced = (j == 0) || (j == c) || (j == c - 1);
        const float v = forced ? 1e4f : IMP[tl * 64 + j];
        const bool okj = (j <= c);
        const unsigned key = okj ? (__float_as_uint(v) + 1u) : 0u;
        unsigned thr = 0u;
        for (int bit = 31; bit >= 0; --bit) { const unsigned cand = thr | (1u << bit); if (__popcll(__ballot(key >= cand)) >= 16) thr = cand; }
        const unsigned long long gtm = __ballot(key > thr), eqm = __ballot(key == thr);
        const int need = 16 - __popcll(gtm);
        const bool selj = (key > thr) || (key == thr && __popcll(eqm & ((1ull << j) - 1ull)) < need);
        const unsigned long long msk = __ballot(selj && okj);
        if (lane == 0) SEL[tl] = msk;
    }
    __syncthreads();
    unsigned long long mymask = SEL[tokl], wu = 0ull;
#pragma unroll
    for (int i = 0; i < 8; ++i) wu |= SEL[8 * wave + i];
    {
        SlcTF tf; tf.mymask = mymask; tf.wu = wu; tf.qpos = qpos; tf.hi4 = 4 * hi;
        const unsigned long long tmask = (c == 63) ? ~0ull : ((1ull << (c + 1)) - 1ull);
        f32x16 o[2]; o[0] = (f32x16){}; o[1] = (f32x16){}; float m = -1e30f, l = 0.f;
        if (FAST) { SlcTFF tff; tff.mymask = mymask; tff.wu = wu; tff.qpos = qpos; tff.c = c; tff.hi4 = 4 * hi; f32x4 ls = {};
            attn_loop_fast<64, true, SlcTFF>(lds, (const bf16_t*)(ws + WS_KSL) + (size_t)b * SEQ * 256 + g * 64, 256, (const bf16_t*)(ws + WS_VSLT) + (size_t)((b * 4 + g) * 64) * SEQ, SEQ, tmask, qf, o, ls, tff); l = hsum4(ls); }
        else attn_loop<64, SlcTF>(lds, (const bf16_t*)(ws + WS_KSL) + (size_t)b * SEQ * 256 + g * 64, 256, (const bf16_t*)(ws + WS_VSLT) + (size_t)((b * 4 + g) * 64) * SEQ, SEQ, tmask, qf, o, m, l, tf);
        l += __shfl_xor(l, 32); const float sc = gate1 / fmaxf(l, 1e-30f);
#pragma unroll
        for (int db = 0; db < 2; ++db)
#pragma unroll
            for (int r = 0; r < 16; ++r) yst[(db * 16 + r) * NTHREADS] += o[db][r] * sc;
    }
    {
        WinTF tf; tf.c = c; tf.qpos = qpos; tf.hi4 = 4 * hi;
        const int tlo = c >= 8 ? c - 8 : 0;
        const unsigned long long hi_m = (c == 63) ? ~0ull : ((1ull << (c + 1)) - 1ull), tmask = hi_m & ~((1ull << tlo) - 1ull);
        f32x16 o[2]; o[0] = (f32x16){}; o[1] = (f32x16){}; float m = -1e30f, l = 0.f;
        if (FAST) { f32x4 ls = {}; attn_loop_fast<64, false, WinTF>(lds, (const bf16_t*)(ws + WS_KWN) + (size_t)b * SEQ * 256 + g * 64, 256, (const bf16_t*)(ws + WS_VWNT) + (size_t)((b * 4 + g) * 64) * SEQ, SEQ, tmask, qf, o, ls, tf); l = hsum4(ls); }
        else attn_loop<64, WinTF>(lds, (const bf16_t*)(ws + WS_KWN) + (size_t)b * SEQ * 256 + g * 64, 256, (const bf16_t*)(ws + WS_VWNT) + (size_t)((b * 4 + g) * 64) * SEQ, SEQ, tmask, qf, o, m, l, tf);
        l += __shfl_xor(l, 32); const float sc = gate2 / fmaxf(l, 1e-30f);
#pragma unroll
        for (int db = 0; db < 2; ++db)
#pragma unroll
            for (int r = 0; r < 16; ++r) yt[db][r] = yst[(db * 16 + r) * NTHREADS] + o[db][r] * sc;
    }
#pragma unroll
    for (int db = 0; db < 2; ++db)
#pragma unroll
        for (int u = 0; u < 4; ++u) { const int d = 32 * db + 8 * u + 4 * hi; u32x2 w; w.x = cvtpk(yt[db][4 * u], yt[db][4 * u + 1]); w.y = cvtpk(yt[db][4 * u + 2], yt[db][4 * u + 3]); if (!dry) *(u32x2*)(qrow + d) = w; }
}

#define XB_TMO      128
#define XB_XCNT(j)  (256  + 64 * (j))
#define XB_XSUB(j)  (1280 + 64 * (j))
#define XB_XGEN(j)  (2304 + 64 * (j))
#define XB_TOP      3328
#define XB_TOPGEN   3392
#define XCD_BAR_WORDS 3456
#define XB_SPIN_CAP (1u << 18)

__device__ __forceinline__ unsigned xb_ld(unsigned* p)              { return __hip_atomic_load(p, __ATOMIC_RELAXED, __HIP_MEMORY_SCOPE_AGENT); }
__device__ __forceinline__ unsigned xb_add(unsigned* p, unsigned v) { return __hip_atomic_fetch_add(p, v, __ATOMIC_RELAXED, __HIP_MEMORY_SCOPE_AGENT); }
__device__ __forceinline__ unsigned xb_xcc_id() { return (unsigned)__builtin_amdgcn_s_getreg((3 << 11) | 20) & 0xFu; }
#define XB_SPIN(cond, bar) do { unsigned _sp = 0; while (cond) { __builtin_amdgcn_s_sleep(1); \
    if ((++_sp & 255u) == 0u) { if (xb_ld(&(bar)[XB_TMO])) break; if (_sp > XB_SPIN_CAP) { atomicAdd(&(bar)[XB_TMO], 1u); break; } } } } while (0)

struct XcdBarrier {
    unsigned* bar; unsigned x;
    volatile LAS unsigned* st;
};

__device__ __forceinline__ XcdBarrier xcd_barrier_post(unsigned* bar, volatile LAS unsigned* st) {
    XcdBarrier b; b.bar = bar; b.x = xb_xcc_id(); b.st = st;
    if (threadIdx.x == 0) (void)xb_add(&bar[XB_XCNT(b.x)], 1u);
    return b;
}
__device__ __forceinline__ void xcd_barrier_complete(unsigned* bar, unsigned x, unsigned& nloc, unsigned& nx) {
    const unsigned G = gridDim.x * gridDim.y * gridDim.z;
    unsigned sum, cnt, mine, sp = 0u;
    for (;;) {
        sum = 0u; cnt = 0u; mine = 0u;
#pragma unroll
        for (unsigned j = 0; j < 16; ++j) { const unsigned c = xb_ld(&bar[XB_XCNT(j)]); sum += c; cnt += (c > 0u) ? 1u : 0u; mine = (j == x) ? c : mine; }
        if (sum == G) break;
        __builtin_amdgcn_s_sleep(1);
        if ((++sp & 255u) == 0u) { if (xb_ld(&bar[XB_TMO])) break; if (sp > XB_SPIN_CAP) { atomicAdd(&bar[XB_TMO], 1u); break; } }
    }
    nloc = mine > 0u ? mine : 1u; nx = cnt > 0u ? cnt : 1u;
}

__device__ __forceinline__ void xcd_barrier(const XcdBarrier& b) {
    asm volatile("s_waitcnt vmcnt(0)" ::: "memory");
    __syncthreads();
    if (threadIdx.x == 0) {
        unsigned* bar = b.bar;
        __builtin_amdgcn_s_waitcnt(0);
        unsigned nloc = b.st[0], nx = b.st[1];
        if (nloc == 0u) { xcd_barrier_complete(bar, b.x, nloc, nx); b.st[0] = nloc; b.st[1] = nx; }
        const unsigned old = xb_add(&bar[XB_XSUB(b.x)], 1u);
        const unsigned gen = old / nloc;
        if (old + 1u == (gen + 1u) * nloc) {
            __builtin_amdgcn_fence(__ATOMIC_RELEASE, "agent");
            asm volatile("s_waitcnt vmcnt(0)" ::: "memory");
            const unsigned og = xb_add(&bar[XB_TOP], 1u);
            const unsigned tg = og / nx;
            if (og + 1u == (tg + 1u) * nx) xb_add(&bar[XB_TOPGEN], 1u);
            else XB_SPIN(xb_ld(&bar[XB_TOPGEN]) == tg, bar);
            __builtin_amdgcn_fence(__ATOMIC_ACQUIRE, "agent");
            xb_add(&bar[XB_XGEN(b.x)], 1u);
            asm volatile("s_waitcnt vmcnt(0)" ::: "memory");
        } else {
            XB_SPIN(xb_ld(&bar[XB_XGEN(b.x)]) == gen, bar);
            __builtin_amdgcn_fence(__ATOMIC_ACQUIRE, "agent");
            asm volatile("s_waitcnt vmcnt(0)" ::: "memory");
        }
    }
    __syncthreads();
}

__device__ __forceinline__ int next_item(unsigned* counter, LAS int* slot) {
    __syncthreads();
    if (threadIdx.x == 0) *slot = (int)atomicAdd(counter, 1u);
    __syncthreads();
    return *slot;
}

__global__ void __launch_bounds__(NTHREADS) fwd_megakernel(Params P) {
    extern __shared__ __attribute__((aligned(16))) unsigned char lds_raw[];
    LAS unsigned char* lds = (LAS unsigned char*)lds_raw;
    cg::grid_group grid = cg::this_grid();
    const int G = gridDim.x, bx = blockIdx.x;
    const int vb = (G % 8 == 0) ? (bx % 8) * (G / 8) + bx / 8 : bx;
    unsigned char* ws = P.ws;
    unsigned* ctl = (unsigned*)(ws + WS_CTL);
    LAS int* slot = (LAS int*)(lds + L_SLOT);
    if (threadIdx.x < 8) ((LAS unsigned*)(lds + L_SLOT))[threadIdx.x] = 0u;
    __syncthreads();
    XcdBarrier xbar = xcd_barrier_post(ctl + CW_BAR, (volatile LAS unsigned*)(lds + L_SLOT + 16));
    const int lo = P.ph_lo, hi = P.ph_hi;
#ifdef PROBE_PHASE
    const unsigned long long t_start = __builtin_amdgcn_s_memrealtime(); unsigned long long t_probe = 0ull;
#define STAMP(k) do { if ((k) == PROBE_PHASE) t_probe = __builtin_amdgcn_s_memrealtime(); } while (0)
#else
#define STAMP(k) do { } while (0)
#endif
#ifndef PHMASK
#define PHMASK 0xff
#endif
#define IN(k) (((PHMASK >> (k)) & 1) && lo <= (k) && (k) < hi)
#define SEAM(k) do { if (IN(k) && IN((k) + 1)) { if (P.ph_lo < 0) grid.sync(); else xcd_barrier(xbar); } STAMP(k); } while (0)

    if (IN(0)) p0_prologue(P, lds, vb, G);
    SEAM(0);
    if (IN(1)) {
        pg8::Gemm g = pg8::make_gemm((const bf16_t*)(ws + WS_XN), (const bf16_t*)(ws + WS_WIN), MTOK, NPAD, 1024);
        pg8::StaticOrder S; S.init(MTOK, NPAD, G, bx);
        EpiProj E; E.ws = ws; E.gq = P.in[3]; E.gk = P.in[4]; E.gnq = P.in[10]; E.gnk = P.in[11]; E.mgp = (unsigned char*)P.out;
        pg8::gemm_phase<EpiProj, pg8::StaticOrder, true, true>((PG8_LAS unsigned char*)lds, g, S, E);
        for (;;) {
            const int it = next_item(ctl + 320, slot);
            if (it >= 704) break;
            late_weight_item(P, lds, it);
        }
    }
    SEAM(1);
    if (IN(2)) {
        float lam;
        bool fast;
        { const int lane = threadIdx.x & 63; const float a = wave_sum(P.in[5][lane] * P.in[6][lane]), b2 = wave_sum(P.in[7][lane] * P.in[8][lane]); lam = expf(a) - expf(b2) + 0.2f;
          float gq = fabsf(P.in[3][lane]), gk = fabsf(P.in[4][lane]);
#pragma unroll
          for (int o_ = 1; o_ < 64; o_ <<= 1) { gq = fmaxf(gq, __shfl_xor(gq, o_)); gk = fmaxf(gk, __shfl_xor(gk, o_)); }
          fast = (QSCALE * 64.f * gq * gk <= 40.f); }
        for (;;) {
            const int it = next_item(ctl + 128, slot);
            if (it >= 32) break;
            compress_unit(P, lds, it >> 4, it & 15);
        }
        for (;;) {
            const int it = next_item(ctl + 0, slot);
            if (it >= 512) break;
            const int qb = 15 - (it >> 5), bh = it & 31;
            if (fast) diff_unit<true>(P, lds, bh >> 3, bh & 7, qb, lam, P.dup != 0); else diff_unit<false>(P, lds, bh >> 3, bh & 7, qb, lam, P.dup != 0);
        }
    }
    SEAM(2);
    if (IN(3)) {
        bool fast;
        { const int lane = threadIdx.x & 63; float gq = fabsf(P.in[10][lane]), gk = fmaxf(fabsf(P.in[11][lane]), fmaxf(fabsf(P.in[11][64 + lane]), fabsf(P.in[11][128 + lane])));
#pragma unroll
          for (int o_ = 1; o_ < 64; o_ <<= 1) { gq = fmaxf(gq, __shfl_xor(gq, o_)); gk = fmaxf(gk, __shfl_xor(gk, o_)); }
          fast = (QSCALE * 64.f * gq * gk <= 40.f); }
        for (;;) {
            const int it = next_item(ctl + 64, slot);
            if (it >= 1024) break;
            const int c = 63 - (it >> 4), bg = it & 15;
            if (fast) nsa_unit<true>(P, lds, bg >> 2, bg & 3, c, P.dup != 0); else nsa_unit<false>(P, lds, bg >> 2, bg & 3, c, P.dup != 0);
        }
    }
    SEAM(3);
    if (IN(4)) {
        static_assert(WS_WPN == WS_WPD + (size_t)1024 * 1024 * 2 && WS_NQ > WS_DQ, "the two branch GEMMs are addressed as one virtual GEMM");
        TwoSched S; S.S.init(MTOK, 1024, G, bx);
        pg8::Gemm g = pg8::make_gemm((const bf16_t*)(ws + WS_DQ), (const bf16_t*)(ws + WS_WPD), MTOK, 2048, 1024);
        g.a_sh = 6; g.a_lo = (size_t)256 * 1024 * 2; g.a_hi = WS_NQ - WS_DQ;
        EpiMerge2 E{(const bf16_t*)P.out, (bf16_t*)(ws + WS_MIXED)};
        pg8::gemm_phase<EpiMerge2, TwoSched, true, true>((PG8_LAS unsigned char*)lds, g, S, E);
    }
    SEAM(4);
    if (IN(5)) {
        pg8::Gemm g = pg8::make_gemm((const bf16_t*)(ws + WS_MIXED), (const bf16_t*)(ws + WS_WOUT), MTOK, 1024, 1024);
        pg8::StaticOrder S; S.init(MTOK, 1024, G, bx);
        EpiRes1 E{P.in[0], P.out, (bf16_t*)(ws + WS_XB1), (float*)(ws + WS_PART)};
        pg8::gemm_phase<EpiRes1, pg8::StaticOrder, true, true>((PG8_LAS unsigned char*)lds, g, S, E);
    }
    SEAM(5);
    if (IN(6)) {
        pg8::Gemm g = pg8::make_gemm((const bf16_t*)(ws + WS_XB1), (const bf16_t*)(ws + WS_WUP), MTOK, DFF, 1024);
        pg8::StaticOrder S; S.init(MTOK, DFF, G, bx);
        EpiUp E{(const float*)(ws + WS_PART), (bf16_t*)(ws + WS_HB)};
        pg8::gemm_phase<EpiUp, pg8::StaticOrder, true, true>((PG8_LAS unsigned char*)lds, g, S, E);
    }
    SEAM(6);
    if (IN(7)) {
        pg8::Gemm g = pg8::make_gemm((const bf16_t*)(ws + WS_HB), (const bf16_t*)(ws + WS_WDN), MTOK, 1024, DFF);
        pg8::StaticOrder S; S.init(MTOK, 1024, G, bx);
        EpiRes2 E{P.out, 1.f, (const bf16_t*)(ws + WS_XB1)};
        pg8::gemm_phase<EpiRes2, pg8::StaticOrder, true, true>((PG8_LAS unsigned char*)lds, g, S, E);
    }
#ifdef PROBE_PHASE
    grid.sync();
    if (blockIdx.x == 0 && threadIdx.x == 0) P.out[0] = 1000.0f + (float)(t_probe - t_start) * 0.01f;
#endif
#undef IN
#undef SEAM
}

#ifndef PROBE_DUP
#define PROBE_DUP -1
#endif
extern "C" void kernel_launch(void* const* d_in, const int* in_sizes, int n_in, void* d_out, int out_size, void* d_ws, size_t ws_size, hipStream_t stream) {
    static int grid = 0;
    if (grid == 0) {
        if (n_in != 24 || out_size != MTOK * DM || ws_size < WS_END) { fprintf(stderr, "kernel_launch: unexpected shapes (n_in %d out %d ws %zu)\n", n_in, out_size, ws_size); grid = -1; return; }
        int dev = 0, cus = 0, per_cu = 0;
        hipGetDevice(&dev); hipDeviceGetAttribute(&cus, hipDeviceAttributeMultiprocessorCount, dev);
        if (hipFuncSetAttribute((const void*)fwd_megakernel, hipFuncAttributeMaxDynamicSharedMemorySize, LDS_BYTES) != hipSuccess) { fprintf(stderr, "kernel_launch: hipFuncSetAttribute failed\n"); grid = -1; return; }
        if (hipOccupancyMaxActiveBlocksPerMultiprocessor(&per_cu, (const void*)fwd_megakernel, NTHREADS, LDS_BYTES) != hipSuccess || per_cu < 1) { fprintf(stderr, "kernel_launch: occupancy query says %d\n", per_cu); per_cu = 1; }
        (void)hipGetLastError();
        grid = cus * 1;
        fprintf(stderr, "kernel_launch: grid %d (cus %d, per_cu %d)\n", grid, cus, per_cu);
    }
    if (grid < 0) return;
    hipMemsetAsync((char*)d_ws + WS_CTL, 0, CTL_BYTES, stream);
    Params p{};
    for (int i = 0; i < 24; ++i) p.in[i] = (const float*)d_in[i];
    p.out = (float*)d_out; p.ws = (unsigned char*)d_ws;
    for (int i = 0; i < 32; ++i) p.invfreq[i] = (double)powf(10000.0f, -(float)i / 32.0f);
    p.pad = 0;
    int plan[3][3] = {{0, 8, 0}, {0, 0, 0}, {0, 0, 0}}; int nl = 1;
    if (PROBE_DUP >= 0) { const int k = PROBE_DUP; const bool inplace = (k == 2 || k == 3 || k == 7); plan[0][0] = 0; plan[0][1] = k + (inplace ? 0 : 1); plan[0][2] = 0; plan[1][0] = k; plan[1][1] = k + 1; plan[1][2] = inplace ? 1 : 0; plan[2][0] = k + (inplace ? 0 : 1); plan[2][1] = 8; plan[2][2] = 0; nl = 3; }
    for (int li = 0; li < nl; ++li) {
        if (plan[li][0] >= plan[li][1]) continue;
        if (li > 0) hipMemsetAsync((char*)d_ws + WS_CTL, 0, CTL_BYTES, stream);
        p.ph_lo = plan[li][0]; p.ph_hi = plan[li][1]; p.dup = plan[li][2];
        void* args[] = {&p};
        hipError_t e = hipLaunchCooperativeKernel((const void*)fwd_megakernel, dim3(grid), dim3(NTHREADS), args, LDS_BYTES, stream);
        if (e != hipSuccess) fprintf(stderr, "kernel_launch: cooperative launch failed: %s (grid %d)\n", hipGetErrorString(e), grid);
    }
}
```

```cpp
#include <hip/hip_runtime.h>
#include <hip/hip_cooperative_groups.h>
#include <cstdio>
#include <cstdint>
#include <cmath>
namespace cg = cooperative_groups;

namespace pg8 {
#define PG8_LAS __attribute__((address_space(3)))
typedef unsigned short bf16_t;
typedef short bf16x8 __attribute__((ext_vector_type(8)));
typedef float f32x4 __attribute__((ext_vector_type(4)));
typedef unsigned u32x4 __attribute__((ext_vector_type(4)));
constexpr int BM = 256, BK = 64, HALF = 128, HTB = HALF * BK * 2  , STAGE_BYTES = 8 * HTB, NXCD = 8, WGM = 8;

__host__ __device__ __forceinline__ int lds_byte(int r, int c) { const int st = (r >> 4) * 2 + (c >> 5), rr = r & 15, cc = c & 31, ob = rr * 64 + cc * 2; return st * 1024 + (ob ^ (((ob >> 9) & 1) << 5)); }
__host__ __device__ __forceinline__ void stage_rc(int b, int& R, int& C) { const int st = b / 1024, sb = b % 1024, swz = sb ^ (((sb >> 9) & 1) << 5); R = (st >> 1) * 16 + swz / 64; C = (st & 1) * 32 + (swz % 64) / 2; }
__host__ __device__ __forceinline__ int perm32(int rho) { const int n = rho >> 4, i = rho & 15; return 8 * (i >> 2) + 4 * n + (i & 3); }

struct Unit { int pm, pn; };
struct Gemm { const bf16_t* A; const bf16_t* Bt; int M, N, K; int lda; int kstepA; int a_sh; size_t a_lo, a_hi; };
__host__ __device__ __forceinline__ Gemm make_gemm(const bf16_t* A, const bf16_t* Bt, int M, int N, int K) { Gemm g; g.A = A; g.Bt = Bt; g.M = M; g.N = N; g.K = K; g.lda = K; g.kstepA = BK * 2; g.a_sh = 24; g.a_lo = (size_t)BM * K * 2; g.a_hi = 0; return g; }
__device__ __forceinline__ const char* a_tile(const Gemm& g, int pm) { return (const char*)g.A + (size_t)(pm >> g.a_sh) * g.a_hi + (size_t)(pm & ((1 << g.a_sh) - 1)) * g.a_lo; }

struct StaticOrder {
    int nM, nN, nwg, G, c;
    __host__ __device__ void init(int M, int N, int G_, int c_) { nM = M / BM; nN = N / BM; nwg = nM * nN; G = G_; c = c_; }
    __host__ __device__ bool next(int i, Unit& u) const {
        const long L = (long)i * G + c; if (L >= nwg) return false;
        int wgid = (int)L; { const int q = nwg / NXCD, r = nwg % NXCD, xcd = wgid % NXCD, off = wgid / NXCD; wgid = (xcd < r ? xcd * (q + 1) : r * (q + 1) + (xcd - r) * q) + off; }
        const int nig = WGM * nN, gid = wgid / nig, fm = gid * WGM, gsz = (nM - fm) < WGM ? (nM - fm) : WGM;
        u.pm = fm + ((wgid % nig) % gsz); u.pn = (wgid % nig) / gsz; return true;
    }
    __device__ __forceinline__ void a_ready(const Unit&) const {}
    __device__ __forceinline__ void done(const Unit&) const {}
};


template <class Epi, class Sched, bool ALIGN_EPI = false, bool SP2 = false>
__device__ __forceinline__ void gemm_phase(PG8_LAS unsigned char* lds, const Gemm g, const Sched& S, const Epi& E) {
    const int tid = threadIdx.x, wid = __builtin_amdgcn_readfirstlane(tid >> 6), lane = tid & 63, wr = wid >> 2, wc = wid & 3, fr = lane & 15, fq = lane >> 4;
    const int K = g.K, nt = K / BK;
    unsigned voffA[2], voffB[2];
#pragma unroll
    for (int i = 0; i < 2; ++i) { int R, C; stage_rc(tid * 16 + i * 8192, R, C); const int Rb = Epi::PERM ? ((R & ~31) + perm32(R & 31)) : R;
        voffA[i] = (unsigned)(R * g.lda + C) * 2u; voffB[i] = (unsigned)(Rb * K + C) * 2u; }
    const size_t kstep = (size_t)(BK * 2); const size_t kstepA = (size_t)g.kstepA; const size_t hstepA = (size_t)HALF * g.lda * 2;
    const size_t hstep = (size_t)HALF * K * 2;
    const size_t tstep = 2 * hstep;
    const unsigned ldsw = (unsigned)wid * 1024u;
    const int aoff = lds_byte(wr * 64 + fr, fq * 8), boff = lds_byte(wc * 32 + fr, fq * 8);
#define PG8_SA(b, h) (((b) * 2 + (h)) * HTB)
#define PG8_SB(b, h) ((4 + (b) * 2 + (h)) * HTB)
#define PG8_STAGE(bufoff, gbase, voff) do { _Pragma("unroll") for (int _i = 0; _i < 2; ++_i) \
        __builtin_amdgcn_global_load_lds((const unsigned*)((const char*)(gbase) + (voff)[_i]), (PG8_LAS unsigned*)(lds + (bufoff) + ldsw + _i * 8192), 16, 0, 0); } while (0)
#define PG8_LDA(dst, b, h) do { _Pragma("unroll") for (int m = 0; m < 4; ++m) _Pragma("unroll") for (int k = 0; k < 2; ++k) dst[m][k] = *(const PG8_LAS bf16x8*)(lds + PG8_SA(b, h) + aoff + m * 2048 + k * 1024); } while (0)
#define PG8_LDB(dst, b, h) do { _Pragma("unroll") for (int n = 0; n < 2; ++n) _Pragma("unroll") for (int k = 0; k < 2; ++k) dst[n][k] = *(const PG8_LAS bf16x8*)(lds + PG8_SB(b, h) + boff + n * 2048 + k * 1024); } while (0)
#define PG8_MMA(ai, bj, At, Bt) do { __builtin_amdgcn_s_setprio(1); _Pragma("unroll") for (int m = 0; m < 4; ++m) _Pragma("unroll") for (int n = 0; n < 2; ++n) _Pragma("unroll") for (int k = 0; k < 2; ++k) \
        acc[ai][bj][m][n] = __builtin_amdgcn_mfma_f32_16x16x32_bf16(Bt[n][k], At[m][k], acc[ai][bj][m][n], 0, 0, 0); __builtin_amdgcn_s_setprio(0); } while (0)
#define PG8_WAIT_V(n) asm volatile("s_waitcnt vmcnt(" #n ")" ::: "memory")
#define PG8_WAIT_L(n) asm volatile("s_waitcnt lgkmcnt(" #n ")" ::: "memory")
#define PG8_BAR __builtin_amdgcn_s_barrier()
#define PG8_SCHED __builtin_amdgcn_sched_barrier(0)
    Unit cur, nxt; int ui = 0;
    if (!S.next(0, cur)) return;
    f32x4 acc[2][2][4][2];
#pragma unroll
    for (int a = 0; a < 2; ++a)
#pragma unroll
        for (int b = 0; b < 2; ++b)
#pragma unroll
            for (int m = 0; m < 4; ++m)
#pragma unroll
                for (int n = 0; n < 2; ++n) acc[a][b][m][n] = (f32x4){0.f, 0.f, 0.f, 0.f};
    bf16x8 At[4][2], B0[2][2], B1[2][2];
    const char* cA = a_tile(g, cur.pm); const char* cB = (const char*)g.Bt + (size_t)cur.pn * tstep;
    S.a_ready(cur);
    if constexpr (SP2) {
        PG8_STAGE(PG8_SB(0, 0), cB, voffB); PG8_STAGE(PG8_SB(0, 1), cB + hstep, voffB); PG8_STAGE(PG8_SA(0, 0), cA, voffA); PG8_STAGE(PG8_SA(0, 1), cA + hstepA, voffA);
        if (wr == 1) PG8_BAR;
        PG8_WAIT_V(2); PG8_BAR;
        PG8_STAGE(PG8_SB(1, 0), cB + kstep, voffB); PG8_STAGE(PG8_SA(1, 0), cA + kstepA, voffA); PG8_STAGE(PG8_SB(1, 1), cB + hstep + kstep, voffB);
        PG8_WAIT_V(6); PG8_BAR;
    } else {
        PG8_STAGE(PG8_SB(0, 0), cB, voffB); PG8_STAGE(PG8_SA(0, 0), cA, voffA); PG8_STAGE(PG8_SB(0, 1), cB + hstep, voffB); PG8_STAGE(PG8_SA(0, 1), cA + hstepA, voffA);
        if (wr == 1) PG8_BAR;
        PG8_WAIT_V(4); PG8_BAR;
        PG8_STAGE(PG8_SB(1, 0), cB + kstep, voffB); PG8_STAGE(PG8_SA(1, 0), cA + kstepA, voffA); PG8_STAGE(PG8_SB(1, 1), cB + hstep + kstep, voffB);
        PG8_WAIT_V(6); PG8_BAR;
    }
    for (;;) {
        const bool has_next = S.next(ui + 1, nxt);
        const char* nA = has_next ? a_tile(g, nxt.pm) : cA; const char* nB = has_next ? (const char*)g.Bt + (size_t)nxt.pn * tstep : cB;
        for (int t = 0; t < nt; t += 2) {
            const bool last = (t == nt - 2);
            const char* a1 = cA + (size_t)(t + 1) * kstepA;
            const char* a2 = last ? nA : cA + (size_t)(t + 2) * kstepA; const char* b2 = last ? nB : cB + (size_t)(t + 2) * kstep;
            const char* a3 = a2 + kstepA; const char* b3 = b2 + kstep;
            if (last && has_next) S.a_ready(nxt);
            if constexpr (SP2) {
            PG8_LDB(B0, 0, 0); PG8_LDB(B1, 0, 1); PG8_SCHED; PG8_LDA(At, 0, 0); PG8_STAGE(PG8_SA(1, 1), a1 + hstepA, voffA);
            PG8_WAIT_V(8); PG8_WAIT_L(0); PG8_BAR; PG8_MMA(0, 0, At, B0); PG8_MMA(0, 1, At, B1); PG8_BAR; PG8_SCHED;
            PG8_LDA(At, 0, 1); PG8_STAGE(PG8_SB(0, 0), b2, voffB); PG8_STAGE(PG8_SB(0, 1), b2 + hstep, voffB); PG8_STAGE(PG8_SA(0, 0), a2, voffA);
            PG8_WAIT_V(8); PG8_WAIT_L(0); PG8_BAR; PG8_MMA(1, 0, At, B0); PG8_MMA(1, 1, At, B1); PG8_BAR; PG8_SCHED;
            PG8_LDB(B0, 1, 0); PG8_LDB(B1, 1, 1); PG8_SCHED; PG8_LDA(At, 1, 0); PG8_STAGE(PG8_SA(0, 1), a2 + hstepA, voffA);
            PG8_WAIT_V(8); PG8_WAIT_L(0); PG8_BAR; PG8_MMA(0, 0, At, B0); PG8_MMA(0, 1, At, B1); PG8_BAR; PG8_SCHED;
            PG8_LDA(At, 1, 1); PG8_STAGE(PG8_SB(1, 0), b3, voffB); PG8_STAGE(PG8_SB(1, 1), b3 + hstep, voffB); PG8_STAGE(PG8_SA(1, 0), a3, voffA);
            PG8_WAIT_V(8); PG8_WAIT_L(0); PG8_BAR; PG8_MMA(1, 0, At, B0); PG8_MMA(1, 1, At, B1); PG8_BAR; PG8_SCHED;
            } else {
            PG8_LDB(B0, 0, 0); PG8_SCHED; PG8_LDA(At, 0, 0); PG8_STAGE(PG8_SA(1, 1), a1 + hstepA, voffA);
            PG8_WAIT_L(8); PG8_BAR; PG8_WAIT_L(0); PG8_MMA(0, 0, At, B0); PG8_BAR; PG8_SCHED;
            PG8_LDB(B1, 0, 1); PG8_STAGE(PG8_SB(0, 0), b2, voffB);
            PG8_BAR; PG8_WAIT_L(0); PG8_MMA(0, 1, At, B1); PG8_BAR;
            PG8_LDA(At, 0, 1); PG8_STAGE(PG8_SA(0, 0), a2, voffA);
            PG8_BAR; PG8_WAIT_L(0); PG8_MMA(1, 0, At, B0); PG8_BAR; PG8_SCHED;
            PG8_STAGE(PG8_SB(0, 1), b2 + hstep, voffB);
            PG8_WAIT_V(6); PG8_BAR; PG8_MMA(1, 1, At, B1); PG8_BAR;
            PG8_LDB(B0, 1, 0); PG8_SCHED; PG8_LDA(At, 1, 0); PG8_STAGE(PG8_SA(0, 1), a2 + hstepA, voffA);
            PG8_WAIT_L(8); PG8_BAR; PG8_WAIT_L(0); PG8_MMA(0, 0, At, B0); PG8_BAR; PG8_SCHED;
            PG8_LDB(B1, 1, 1); PG8_STAGE(PG8_SB(1, 0), b3, voffB);
            PG8_BAR; PG8_WAIT_L(0); PG8_MMA(0, 1, At, B1); PG8_BAR;
            PG8_LDA(At, 1, 1); PG8_STAGE(PG8_SA(1, 0), a3, voffA);
            PG8_BAR; PG8_WAIT_L(0); PG8_MMA(1, 0, At, B0); PG8_BAR; PG8_SCHED;
            PG8_STAGE(PG8_SB(1, 1), b3 + hstep, voffB);
            PG8_WAIT_V(6); PG8_BAR; PG8_MMA(1, 1, At, B1); PG8_BAR;
            }
        }
        if constexpr (ALIGN_EPI) { if (wr == 0) PG8_BAR; }
        if constexpr (!Epi::AFTER_DRAIN) { E(acc, cur, wr, wc, fr, fq); S.done(cur); }
        if (!has_next) break;
#pragma unroll
        for (int a = 0; a < 2; ++a)
#pragma unroll
            for (int b = 0; b < 2; ++b)
#pragma unroll
                for (int m = 0; m < 4; ++m)
#pragma unroll
                    for (int n = 0; n < 2; ++n) acc[a][b][m][n] = (f32x4){0.f, 0.f, 0.f, 0.f};
        cur = nxt; cA = nA; cB = nB; ++ui;
        if constexpr (ALIGN_EPI) { if (wr == 1) PG8_BAR; }
    }
    PG8_WAIT_V(0);
    if constexpr (!ALIGN_EPI) { if (wr == 0) PG8_BAR; }
    PG8_BAR;
    if constexpr (Epi::AFTER_DRAIN) { E.fused(acc, cur, wr, wc, fr, fq, lds, wid, lane); S.done(cur); }
#undef PG8_SA
#undef PG8_SB
#undef PG8_STAGE
#undef PG8_LDA
#undef PG8_LDB
#undef PG8_MMA
#undef PG8_WAIT_V
#undef PG8_WAIT_L
#undef PG8_BAR
#undef PG8_SCHED
}
}

#define LAS __attribute__((address_space(3)))
typedef unsigned short bf16_t;
typedef short bf16x8 __attribute__((ext_vector_type(8)));
typedef float f32x4 __attribute__((ext_vector_type(4)));
typedef float f32x16 __attribute__((ext_vector_type(16)));
typedef float f32x8 __attribute__((ext_vector_type(8)));
typedef unsigned u32x4 __attribute__((ext_vector_type(4)));
typedef unsigned u32x2 __attribute__((ext_vector_type(2)));
typedef float f32x2_t __attribute__((ext_vector_type(2)));
typedef __bf16 bf16x2_t __attribute__((ext_vector_type(2)));

constexpr int NB = 4, SEQ = 4096, DM = 1024, MTOK = NB * SEQ, DIN = 7728, NPAD = 7936, DFF = 4096;
constexpr float QSCALE = 0.125f * 1.4426950408889634f;
constexpr float EPS = 1e-6f;
constexpr int NTHREADS = 512, NWAVES = 8;

constexpr size_t MiB = 1u << 20;
constexpr size_t WS_CTL = 0, CTL_BYTES = 65536;
constexpr int CW_BAR = 4096;
constexpr size_t WS_COS = 1 * MiB, WS_SIN = WS_COS + 4096 * 32 * 4, WS_CCOS = WS_SIN + 4096 * 32 * 4, WS_CSIN = WS_CCOS + 256 * 32 * 4;
constexpr size_t WS_PB = 3 * MiB;
constexpr size_t WS_W2T = 3 * MiB + 65536;
constexpr size_t WS_W1T = 4 * MiB;
constexpr size_t WS_WPD = 6 * MiB, WS_WPN = 8 * MiB, WS_WOUT = 10 * MiB, WS_WUP = 12 * MiB, WS_WDN = 20 * MiB, WS_WIN = 28 * MiB;
constexpr size_t WS_XN = 45 * MiB;
constexpr size_t WS_HID = WS_XN, WS_KCMP = WS_XN + 4 * MiB, WS_VCMPT = WS_XN + 5 * MiB, WS_MIXED = WS_XN;
constexpr size_t WS_DQ = 77 * MiB, WS_DK = 109 * MiB, WS_DVT = 141 * MiB, WS_NQ = 173 * MiB;
constexpr size_t WS_KC = 205 * MiB, WS_VC = 213 * MiB, WS_KSL = 221 * MiB, WS_KWN = 229 * MiB, WS_VSLT = 237 * MiB, WS_VWNT = 245 * MiB, WS_NG = 253 * MiB;
constexpr size_t WS_T1 = WS_DK;
constexpr size_t WS_XB1 = WS_KC;
constexpr size_t WS_PART = WS_NG;
constexpr size_t WS_HB = WS_DQ;
constexpr size_t WS_END = 256 * MiB;

constexpr int LDS_BYTES = 151552;
constexpr int TROW = 72;
constexpr int ABUF = 64 * TROW * 2 + 128 * TROW * 2;
constexpr int L_O0P = 83968;
constexpr int L_CK = 57344, CKROW = 72;
constexpr int L_CV = L_CK + 256 * CKROW * 2, CVROW = 264;
constexpr int L_IMP = L_CV + 64 * CVROW * 2;
constexpr int L_SEL = L_IMP + 16384;
constexpr int L_SLOT = 149504;
static_assert(L_SEL + 512 <= L_SLOT && L_O0P + 65536 <= L_SLOT && 3 * ABUF <= L_O0P && 3 * (128 * TROW * 2) <= L_CK, "lds map 2");
static_assert(L_SLOT + 64 <= LDS_BYTES, "lds map");

struct Params { const float* in[24]; float* out; unsigned char* ws; double invfreq[32]; int ph_lo, ph_hi, dup, pad; };

__device__ __forceinline__ unsigned cvtpk(float lo, float hi) { f32x2_t v = {lo, hi}; bf16x2_t b = __builtin_convertvector(v, bf16x2_t); return __builtin_bit_cast(unsigned, b); }
__device__ __forceinline__ bf16_t f2bf(float f) { return (bf16_t)(cvtpk(f, 0.f) & 0xffffu); }
__device__ __forceinline__ int crow(int r, int hi) { return (r & 3) + 8 * (r >> 2) + 4 * hi; }
__device__ __forceinline__ int perm16(int t) { return (t & ~12) | ((t & 4) << 1) | ((t & 8) >> 1); }
__device__ __forceinline__ float wave_sum(float v) {
#pragma unroll
    for (int o = 1; o < 64; o <<= 1) v += __shfl_xor(v, o);
    return v;
}
__device__ __forceinline__ float sigmoidf_(float v) { return __builtin_amdgcn_rcpf(1.0f + __expf(-v)); }
__device__ __forceinline__ float gelu_tanh(float x) { const float u = 0.7978845608028654f * (x + 0.044715f * x * x * x); return x * __builtin_amdgcn_rcpf(1.0f + __expf(-2.0f * u)); }

__device__ __forceinline__ void tr_item(const float* W, int ldw, int col0, int nvalid, const float* kscale, bf16_t* WT, int ldt, int row0, int k0, LAS float* scr, int lane) {
    const int cl = lane & 31;
#pragma unroll 16
    for (int i = 0; i < 32; ++i) { const int kk = 2 * i + (lane >> 5); float v = 0.f; if (cl < nvalid) { v = __builtin_nontemporal_load(W + (size_t)(k0 + kk) * ldw + col0 + cl); if (kscale) v *= kscale[k0 + kk]; } scr[kk * 33 + cl] = v; }
    asm volatile("s_waitcnt lgkmcnt(0)" ::: "memory");
    const int c = lane & 7;
#pragma unroll
    for (int j = 0; j < 4; ++j) { const int n = (lane >> 3) + 8 * j; const LAS float* s = scr + (8 * c) * 33 + n;
        u32x4 o; o.x = cvtpk(s[0 * 33], s[1 * 33]); o.y = cvtpk(s[2 * 33], s[3 * 33]); o.z = cvtpk(s[4 * 33], s[5 * 33]); o.w = cvtpk(s[6 * 33], s[7 * 33]);
        *(u32x4*)(WT + (size_t)(row0 + n) * ldt + k0 + 8 * c) = o; }
    asm volatile("s_waitcnt lgkmcnt(0)" ::: "memory");
}
__device__ __forceinline__ void tr_plain(const float* W, int K, int N, const float* kscale, bf16_t* WT, LAS float* scr, int item, int lane) {
    const int nblk = N / 32, kb = item / nblk, nb = item % nblk;
    tr_item(W, N, 32 * nb, 32, kscale, WT, K, 32 * nb, 64 * kb, scr, lane);
}
__device__ __forceinline__ void sincos_d(double ang, float& s, float& c) {
    const double k = rint(ang * 0.15915494309189535);
    double r = fma(-k, 6.283185307179586, ang); r = fma(-k, 2.4492935982947064e-16, r);
    const double r2 = r * r; double ts = r, tc = 1.0, ss = r, cs = 1.0;
#pragma unroll
    for (int n = 1; n <= 14; ++n) { tc *= -r2 * (1.0 / ((2.0 * n - 1.0) * (2.0 * n))); cs += tc; ts *= -r2 * (1.0 / ((2.0 * n) * (2.0 * n + 1.0))); ss += ts; }
    s = (float)ss; c = (float)cs;
}

__device__ __forceinline__ void late_weight_item(const Params& P, LAS unsigned char* lds, int item) {
    const int tid = threadIdx.x, lane = tid & 63, wave = tid >> 6;
    LAS float* scr = (LAS float*)(lds + wave * 16384);
    unsigned char* ws = P.ws;
    int it = item * NWAVES + wave;
    if (it < 512) { tr_plain(P.in[18], 1024, 1024, nullptr, (bf16_t*)(ws + WS_WPD), scr, it, lane); return; } it -= 512;
    if (it < 512) { tr_plain(P.in[19], 1024, 1024, nullptr, (bf16_t*)(ws + WS_WPN), scr, it, lane); return; } it -= 512;
    if (it < 512) { tr_plain(P.in[20], 1024, 1024, nullptr, (bf16_t*)(ws + WS_WOUT), scr, it, lane); return; } it -= 512;
    if (it < 2048) { tr_plain(P.in[22], 1024, 4096, P.in[21], (bf16_t*)(ws + WS_WUP), scr, it, lane); return; } it -= 2048;
    tr_plain(P.in[23], 4096, 1024, nullptr, (bf16_t*)(ws + WS_WDN), scr, it, lane);
}
__device__ __forceinline__ void p0_prologue(const Params& P, LAS unsigned char* lds, int vb, int G) {
    const int tid = threadIdx.x, lane = tid & 63, wave = tid >> 6;
    LAS float* scr = (LAS float*)(lds + wave * 16384);
    const int gw = vb * NWAVES + wave, NGW = G * NWAVES;
    unsigned char* ws = P.ws;
    for (int it = gw; it < 16 * 248; it += NGW) {
        const int kb = it / 248, nb = it % 248, n0 = 32 * nb, pn = n0 >> 8, p = n0 & 255, bj = p >> 7, wc = (p >> 5) & 3, L0 = 64 * wc + 32 * bj;
        const int srcbase = pn < 22 ? 256 * pn : (pn < 30 ? 5680 + 256 * (pn - 22) : 5632), tv = pn < 30 ? 256 : 48;
        int nv = tv - L0; nv = nv < 0 ? 0 : (nv > 32 ? 32 : nv);
        tr_item(P.in[2], DIN, srcbase + L0, nv, nullptr, (bf16_t*)(ws + WS_WIN), 1024, n0, 64 * kb, scr, lane);
    }
    for (int it = gw; it < 32 * 8; it += NGW) tr_plain(P.in[14], 2048, 256, nullptr, (bf16_t*)(ws + WS_W1T), scr, it, lane);
    for (int it = gw; it < 32 * 8; it += NGW) tr_plain(P.in[16], 2048, 256, nullptr, (bf16_t*)(ws + WS_W1T) + 256 * 2048, scr, it, lane);
    for (int it = gw; it < 4 * 2; it += NGW) tr_plain(P.in[15], 256, 64, nullptr, (bf16_t*)(ws + WS_W2T), scr, it, lane);
    for (int it = gw; it < 4 * 2; it += NGW) tr_plain(P.in[17], 256, 64, nullptr, (bf16_t*)(ws + WS_W2T) + 64 * 256, scr, it, lane);
    for (int it = NGW - 1 - gw; it < 128; it += NGW) {
        const int which = it >> 6, kc = (it >> 2) & 15, j = 64 * (it & 3) + lane; const float* pos = P.in[which ? 13 : 12] + 128 * kc; const float* W1 = P.in[which ? 16 : 14] + (size_t)128 * kc * 256;
        float a0 = 0.f, a1 = 0.f, a2 = 0.f, a3 = 0.f;
#pragma unroll 4
        for (int k = 0; k < 128; k += 4) { a0 += pos[k] * W1[(size_t)k * 256 + j]; a1 += pos[k + 1] * W1[(size_t)(k + 1) * 256 + j]; a2 += pos[k + 2] * W1[(size_t)(k + 2) * 256 + j]; a3 += pos[k + 3] * W1[(size_t)(k + 3) * 256 + j]; }
        ((float*)(ws + WS_PB))[(which * 16 + kc) * 256 + j] = (a0 + a1) + (a2 + a3);
    }
    for (int idx = vb * NTHREADS + tid; idx < (4096 + 256) * 32; idx += G * NTHREADS) {
        const int i = idx & 31, p = idx >> 5; float s, c;
        if (p < 4096) { sincos_d((double)p * P.invfreq[i], s, c); ((float*)(ws + WS_COS))[p * 32 + i] = c; ((float*)(ws + WS_SIN))[p * 32 + i] = s; }
        else { const int n = p - 4096; sincos_d(((double)n * 16.0 + 15.5) * P.invfreq[i], s, c); ((float*)(ws + WS_CCOS))[n * 32 + i] = c; ((float*)(ws + WS_CSIN))[n * 32 + i] = s; }
    }
    const float* x = P.in[0]; const float* g = P.in[1]; bf16_t* XN = (bf16_t*)(ws + WS_XN);
    f32x4 gv[4];
#pragma unroll
    for (int j = 0; j < 4; ++j) gv[j] = ((const f32x4*)g)[lane + 64 * j];
    for (int m0 = gw; m0 < MTOK; m0 += 4 * NGW) {
        f32x4 v[4][4];
#pragma unroll
        for (int r = 0; r < 4; ++r) { const int m = m0 + r * NGW; if (m < MTOK) { const f32x4* xr = (const f32x4*)(x + (size_t)m * DM) + lane;
#pragma unroll
            for (int j = 0; j < 4; ++j) v[r][j] = __builtin_nontemporal_load(xr + 64 * j); } }
#pragma unroll
        for (int r = 0; r < 4; ++r) { const int m = m0 + r * NGW; if (m < MTOK) { float s = 0.f;
#pragma unroll
            for (int j = 0; j < 4; ++j) s += (v[r][j].x * v[r][j].x + v[r][j].y * v[r][j].y) + (v[r][j].z * v[r][j].z + v[r][j].w * v[r][j].w);
            const float rstd = rsqrtf(wave_sum(s) * (1.f / DM) + EPS);
            u32x2* o8 = (u32x2*)(XN + (size_t)m * DM) + lane;
#pragma unroll
            for (int j = 0; j < 4; ++j) { const f32x4 y = v[r][j] * rstd * gv[j]; u32x2 w; w.x = cvtpk(y.x, y.y); w.y = cvtpk(y.z, y.w); o8[64 * j] = w; } } }
    }
}

struct EpiProj {
    static constexpr bool PERM = true, AFTER_DRAIN = false;
    unsigned char* ws; const float *gq, *gk, *gnq, *gnk;
    __device__ __forceinline__ void operator()(const f32x4 (&acc)[2][2][4][2], const pg8::Unit& u, int wr, int wc, int fr, int fq) const {
        const int pn = u.pn; const int row0 = u.pm * 256 + wr * 64 + fr;
        int type, ld = 1024, cb = 0; bf16_t* dst = nullptr; const float* gain = nullptr; float qs = 1.f;
        if (pn < 4) { type = 0; dst = (bf16_t*)(ws + WS_DQ); cb = 256 * pn; gain = gq; qs = QSCALE; }
        else if (pn < 8) { type = 0; dst = (bf16_t*)(ws + WS_DK); cb = 256 * (pn - 4); gain = gk; }
        else if (pn < 12) { type = 2; dst = (bf16_t*)(ws + WS_DVT); }
        else if (pn < 16) { type = 0; dst = (bf16_t*)(ws + WS_NQ); cb = 256 * (pn - 12); gain = gnq; qs = QSCALE; }
        else if (pn == 16) { type = 1; dst = (bf16_t*)(ws + WS_KC); ld = 256; }
        else if (pn == 17) { type = 1; dst = (bf16_t*)(ws + WS_VC); ld = 256; }
        else if (pn == 18) { type = 0; dst = (bf16_t*)(ws + WS_KSL); ld = 256; gain = gnk + 64; }
        else if (pn == 19) { type = 2; dst = (bf16_t*)(ws + WS_VSLT); }
        else if (pn == 20) { type = 0; dst = (bf16_t*)(ws + WS_KWN); ld = 256; gain = gnk + 128; }
        else if (pn == 21) { type = 2; dst = (bf16_t*)(ws + WS_VWNT); }
        else if (pn < 30) { type = 3; dst = (bf16_t*)P_MG(); ld = 2048; cb = 256 * (pn - 22); }
        else { type = 4; }
        const int lc = 64 * wc + 8 * fq;
        if (type == 0) {
            const float* COS = (const float*)(ws + WS_COS); const float* SIN = (const float*)(ws + WS_SIN);
            f32x4 g1[2], g2[2];
#pragma unroll
            for (int n = 0; n < 2; ++n) { g1[n] = *(const f32x4*)(gain + 8 * fq + 4 * n); g2[n] = *(const f32x4*)(gain + 32 + 8 * fq + 4 * n); }
#pragma unroll
            for (int ai = 0; ai < 2; ++ai)
#pragma unroll
                for (int m = 0; m < 4; ++m) {
                    const int row = row0 + ai * 128 + m * 16, pos = row & (SEQ - 1);
                    float ss = 0.f;
#pragma unroll
                    for (int bj = 0; bj < 2; ++bj)
#pragma unroll
                        for (int n = 0; n < 2; ++n) { const f32x4 v = acc[ai][bj][m][n]; ss += (v.x * v.x + v.y * v.y) + (v.z * v.z + v.w * v.w); }
                    ss += __shfl_xor(ss, 16); ss += __shfl_xor(ss, 32);
                    const float rstd = rsqrtf(ss * (1.f / 64.f) + EPS);
                    f32x4 o1[2], o2[2];
#pragma unroll
                    for (int n = 0; n < 2; ++n) {
                        const f32x4 c4 = *(const f32x4*)(COS + pos * 32 + 8 * fq + 4 * n), s4 = *(const f32x4*)(SIN + pos * 32 + 8 * fq + 4 * n);
                        const f32x4 x1 = acc[ai][0][m][n] * rstd * g1[n], x2 = acc[ai][1][m][n] * rstd * g2[n];
                        o1[n] = (x1 * c4 - x2 * s4) * qs; o2[n] = (x2 * c4 + x1 * s4) * qs;
                    }
                    bf16_t* rp = dst + (size_t)row * ld + cb + lc;
                    u32x4 w; w.x = cvtpk(o1[0].x, o1[0].y); w.y = cvtpk(o1[0].z, o1[0].w); w.z = cvtpk(o1[1].x, o1[1].y); w.w = cvtpk(o1[1].z, o1[1].w); *(u32x4*)rp = w;
                    w.x = cvtpk(o2[0].x, o2[0].y); w.y = cvtpk(o2[0].z, o2[0].w); w.z = cvtpk(o2[1].x, o2[1].y); w.w = cvtpk(o2[1].z, o2[1].w); *(u32x4*)(rp + 32) = w;
                }
        } else if (type == 1 || type == 3) {
#pragma unroll
            for (int ai = 0; ai < 2; ++ai)
#pragma unroll
                for (int m = 0; m < 4; ++m) {
                    const int row = row0 + ai * 128 + m * 16; bf16_t* rp = dst + (size_t)row * ld + cb + lc;
#pragma unroll
                    for (int bj = 0; bj < 2; ++bj) {
                        f32x4 a = acc[ai][bj][m][0], b = acc[ai][bj][m][1];
                        if (type == 3) { a.x = sigmoidf_(a.x); a.y = sigmoidf_(a.y); a.z = sigmoidf_(a.z); a.w = sigmoidf_(a.w); b.x = sigmoidf_(b.x); b.y = sigmoidf_(b.y); b.z = sigmoidf_(b.z); b.w = sigmoidf_(b.w); }
                        u32x4 w; w.x = cvtpk(a.x, a.y); w.y = cvtpk(a.z, a.w); w.z = cvtpk(b.x, b.y); w.w = cvtpk(b.z, b.w); *(u32x4*)(rp + 32 * bj) = w;
                    }
                }
        } else if (type == 2) {
            int nh, dv, vh, dbase;
            if (pn < 12) { nh = 8; dv = 128; vh = 2 * (pn - 8) + (wc >> 1); dbase = 64 * (wc & 1); } else { nh = 4; dv = 64; vh = wc; dbase = 0; }
#pragma unroll
            for (int ai = 0; ai < 2; ++ai)
#pragma unroll
                for (int m = 0; m < 4; ++m) {
                    const int row = row0 + ai * 128 + m * 16, b = row >> 12, t = row & (SEQ - 1);
                    bf16_t* bp = dst + ((size_t)(b * nh + vh) * dv + dbase + 8 * fq) * SEQ + perm16(t);
#pragma unroll
                    for (int bj = 0; bj < 2; ++bj)
#pragma unroll
                        for (int n = 0; n < 2; ++n) { const f32x4 v = acc[ai][bj][m][n]; bf16_t* q = bp + (size_t)(32 * bj + 4 * n) * SEQ;
                            q[0] = f2bf(v.x); q[SEQ] = f2bf(v.y); q[2 * SEQ] = f2bf(v.z); q[3 * SEQ] = f2bf(v.w); }
                }
        } else {
            float* NG = (float*)(ws + WS_NG);
            if (wc == 0) {
#pragma unroll
                for (int ai = 0; ai < 2; ++ai)
#pragma unroll
                    for (int m = 0; m < 4; ++m) {
                        const int row = row0 + ai * 128 + m * 16;
#pragma unroll
                        for (int bj = 0; bj < 2; ++bj)
#pragma unroll
                            for (int n = 0; n < 2; ++n) { const int L = 32 * bj + 8 * fq + 4 * n; if (L < 48) { const f32x4 v = acc[ai][bj][m][n];
                                f32x4 o; o.x = sigmoidf_(v.x); o.y = sigmoidf_(v.y); o.z = sigmoidf_(v.z); o.w = sigmoidf_(v.w); *(f32x4*)(NG + (size_t)row * 48 + L) = o; } }
                    }
            }
        }
    }
    unsigned char* mgp;
    __device__ __forceinline__ unsigned char* P_MG() const { return mgp; }
};
struct EpiHid {
    static constexpr bool PERM = true, AFTER_DRAIN = false;
    bf16_t* HID; const LAS float* pb;
    __device__ __forceinline__ void operator()(const f32x4 (&acc)[2][2][4][2], const pg8::Unit& u, int wr, int wc, int fr, int fq) const {
        const int row0 = u.pm * 256 + wr * 64 + fr, col0 = wc * 32 + 8 * fq;
#pragma unroll
        for (int ai = 0; ai < 2; ++ai)
#pragma unroll
            for (int m = 0; m < 4; ++m) { bf16_t* rp = HID + (size_t)(row0 + ai * 128 + m * 16) * 256 + col0;
#pragma unroll
                for (int bj = 0; bj < 2; ++bj) { const f32x4 b0 = *(const LAS f32x4*)(pb + col0 + 128 * bj), b1 = *(const LAS f32x4*)(pb + col0 + 128 * bj + 4);
                    const f32x4 a = acc[ai][bj][m][0] + b0, b = acc[ai][bj][m][1] + b1;
                    u32x4 w; w.x = cvtpk(gelu_tanh(a.x), gelu_tanh(a.y)); w.y = cvtpk(gelu_tanh(a.z), gelu_tanh(a.w)); w.z = cvtpk(gelu_tanh(b.x), gelu_tanh(b.y)); w.w = cvtpk(gelu_tanh(b.z), gelu_tanh(b.w));
                    *(u32x4*)(rp + 128 * bj) = w; asm volatile("" ::: "memory"); } }
    }
};
template <int MODE> struct EpiMerge {
    static constexpr bool PERM = false, AFTER_DRAIN = false;
    const bf16_t* MG; float* T1; bf16_t* MIXED;
    __device__ __forceinline__ void operator()(const f32x4 (&acc)[2][2][4][2], const pg8::Unit& u, int wr, int wc, int fr, int fq) const {
        const int row0 = u.pm * 256 + wr * 64 + fr, col0 = u.pn * 256 + wc * 32 + 4 * fq;
#pragma unroll
        for (int ai = 0; ai < 2; ++ai)
#pragma unroll
            for (int m = 0; m < 4; ++m) { const size_t row = row0 + ai * 128 + m * 16;
#pragma unroll
                for (int bj = 0; bj < 2; ++bj)
#pragma unroll
                    for (int n = 0; n < 2; ++n) { const int col = col0 + 128 * bj + 16 * n;
                        const u32x2 gw = *(const u32x2*)(MG + row * 2048 + MODE * 1024 + col);
                        f32x4 gt; gt.x = __uint_as_float(gw.x << 16); gt.y = __uint_as_float(gw.x & 0xffff0000u); gt.z = __uint_as_float(gw.y << 16); gt.w = __uint_as_float(gw.y & 0xffff0000u);
                        if (MODE == 0) { const f32x4 v = gt * acc[ai][bj][m][n]; u32x2 w; w.x = cvtpk(v.x, v.y); w.y = cvtpk(v.z, v.w); *(u32x2*)(MIXED + row * 1024 + col) = w; }
                        else { const u32x2 tw = *(const u32x2*)(MIXED + row * 1024 + col); f32x4 t1; t1.x = __uint_as_float(tw.x << 16); t1.y = __uint_as_float(tw.x & 0xffff0000u); t1.z = __uint_as_float(tw.y << 16); t1.w = __uint_as_float(tw.y & 0xffff0000u); const f32x4 v = t1 + gt * acc[ai][bj][m][n]; u32x2 w; w.x = cvtpk(v.x, v.y); w.y = cvtpk(v.z, v.w); *(u32x2*)(MIXED + row * 1024 + col) = w; }
                    } }
    }
};
struct EpiMerge2 {
    static constexpr bool PERM = false, AFTER_DRAIN = false;
    const bf16_t* MG; bf16_t* MIXED;
    template <int W> __device__ __forceinline__ void run(const f32x4 (&acc)[2][2][4][2], const pg8::Unit& u, int wr, int wc, int fr, int fq) const {
        const int row0 = (u.pm & 63) * 256 + wr * 64 + fr, col0 = (u.pn & 3) * 256 + wc * 32 + 4 * fq;
#pragma unroll
        for (int ai = 0; ai < 2; ++ai) {
            u32x2 gwv[4][2][2], twv[4][2][2];
#pragma unroll
            for (int m = 0; m < 4; ++m)
#pragma unroll
                for (int bj = 0; bj < 2; ++bj)
#pragma unroll
                    for (int n = 0; n < 2; ++n) { const size_t row = row0 + ai * 128 + m * 16; const int col = col0 + 128 * bj + 16 * n;
                        gwv[m][bj][n] = *(const u32x2*)(MG + row * 2048 + W * 1024 + col);
                        if (W) twv[m][bj][n] = *(const u32x2*)(MIXED + row * 1024 + col); }
            asm volatile("" ::: "memory");
#pragma unroll
            for (int m = 0; m < 4; ++m)
#pragma unroll
                for (int bj = 0; bj < 2; ++bj)
#pragma unroll
                    for (int n = 0; n < 2; ++n) { const size_t row = row0 + ai * 128 + m * 16; const int col = col0 + 128 * bj + 16 * n; const u32x2 gw = gwv[m][bj][n];
                        f32x4 gt; gt.x = __uint_as_float(gw.x << 16); gt.y = __uint_as_float(gw.x & 0xffff0000u); gt.z = __uint_as_float(gw.y << 16); gt.w = __uint_as_float(gw.y & 0xffff0000u);
                        f32x4 v = gt * acc[ai][bj][m][n];
                        if (W) { const u32x2 tw = twv[m][bj][n]; f32x4 t1; t1.x = __uint_as_float(tw.x << 16); t1.y = __uint_as_float(tw.x & 0xffff0000u); t1.z = __uint_as_float(tw.y << 16); t1.w = __uint_as_float(tw.y & 0xffff0000u); v = v + t1; }
                        u32x2 wv; wv.x = cvtpk(v.x, v.y); wv.y = cvtpk(v.z, v.w); *(u32x2*)(MIXED + row * 1024 + col) = wv; }
            asm volatile("" ::: "memory");
        }
    }
    __device__ __forceinline__ void operator()(const f32x4 (&acc)[2][2][4][2], const pg8::Unit& u, int wr, int wc, int fr, int fq) const {
        if ((u.pm >> 6) == 0) run<0>(acc, u, wr, wc, fr, fq); else run<1>(acc, u, wr, wc, fr, fq);
    }
};
struct TwoSched {
    pg8::StaticOrder S;
    __device__ __forceinline__ bool next(int i, pg8::Unit& u) const { pg8::Unit b; if (!S.next(i >> 1, b)) return false; const int w = i & 1; u.pm = b.pm + 64 * w; u.pn = b.pn + 4 * w; return true; }
    __device__ __forceinline__ void a_ready(const pg8::Unit&) const {}
    __device__ __forceinline__ void done(const pg8::Unit&) const {}
};
struct EpiRes1 {
    static constexpr bool PERM = false, AFTER_DRAIN = false;
    const float* x; float* out; bf16_t* XB1; float* PART;
    __device__ __forceinline__ void operator()(const f32x4 (&acc)[2][2][4][2], const pg8::Unit& u, int wr, int wc, int fr, int fq) const {
        const int row0 = u.pm * 256 + wr * 64 + fr, col0 = u.pn * 256 + wc * 32 + 4 * fq;
#pragma unroll
        for (int ai = 0; ai < 2; ++ai) {
            f32x4 xv[4][2][2];
#pragma unroll
            for (int m = 0; m < 4; ++m)
#pragma unroll
                for (int bj = 0; bj < 2; ++bj)
#pragma unroll
                    for (int n = 0; n < 2; ++n) xv[m][bj][n] = *(const f32x4*)(x + (size_t)(row0 + ai * 128 + m * 16) * 1024 + col0 + 128 * bj + 16 * n);
            asm volatile("" ::: "memory");
#pragma unroll
            for (int m = 0; m < 4; ++m) { const size_t row = row0 + ai * 128 + m * 16; float ss = 0.f;
#pragma unroll
                for (int bj = 0; bj < 2; ++bj)
#pragma unroll
                    for (int n = 0; n < 2; ++n) { const int col = col0 + 128 * bj + 16 * n;
                        const f32x4 v = xv[m][bj][n] + acc[ai][bj][m][n];
                        u32x2 w; w.x = cvtpk(v.x, v.y); w.y = cvtpk(v.z, v.w); *(u32x2*)(XB1 + row * 1024 + col) = w;
                        ss += (v.x * v.x + v.y * v.y) + (v.z * v.z + v.w * v.w); }
                ss += __shfl_xor(ss, 16); ss += __shfl_xor(ss, 32);
                if (fq == 0) PART[row * 16 + u.pn * 4 + wc] = ss; }
            asm volatile("" ::: "memory");
        }
    }
};
struct EpiUp {
    static constexpr bool PERM = true, AFTER_DRAIN = false;
    const float* PART; bf16_t* HB;
    __device__ __forceinline__ void operator()(const f32x4 (&acc)[2][2][4][2], const pg8::Unit& u, int wr, int wc, int fr, int fq) const {
        const int row0 = u.pm * 256 + wr * 64 + fr, col0 = u.pn * 256 + wc * 32 + 8 * fq;
#pragma unroll
        for (int ai = 0; ai < 2; ++ai)
#pragma unroll
            for (int m = 0; m < 4; ++m) { const size_t row = row0 + ai * 128 + m * 16;
                const f32x4* pp = (const f32x4*)(PART + row * 16); const f32x4 p0 = pp[0], p1 = pp[1], p2 = pp[2], p3 = pp[3];
                const float ss = ((p0.x + p0.y) + (p0.z + p0.w)) + ((p1.x + p1.y) + (p1.z + p1.w)) + ((p2.x + p2.y) + (p2.z + p2.w)) + ((p3.x + p3.y) + (p3.z + p3.w));
                const float rstd = rsqrtf(ss * (1.f / 1024.f) + EPS);
#pragma unroll
                for (int bj = 0; bj < 2; ++bj) { f32x4 a = acc[ai][bj][m][0] * rstd, b = acc[ai][bj][m][1] * rstd;
                    a.x = fmaxf(a.x, 0.f); a.y = fmaxf(a.y, 0.f); a.z = fmaxf(a.z, 0.f); a.w = fmaxf(a.w, 0.f); b.x = fmaxf(b.x, 0.f); b.y = fmaxf(b.y, 0.f); b.z = fmaxf(b.z, 0.f); b.w = fmaxf(b.w, 0.f);
                    a = a * a; b = b * b;
                    u32x4 w; w.x = cvtpk(a.x, a.y); w.y = cvtpk(a.z, a.w); w.z = cvtpk(b.x, b.y); w.w = cvtpk(b.z, b.w); *(u32x4*)(HB + row * 4096 + col0 + 128 * bj) = w; } }
    }
};
struct EpiRes2 {
    static constexpr bool PERM = false, AFTER_DRAIN = false;
    float* out; float scale; const bf16_t* XB1;
    __device__ __forceinline__ void operator()(const f32x4 (&acc)[2][2][4][2], const pg8::Unit& u, int wr, int wc, int fr, int fq) const {
        const int row0 = u.pm * 256 + wr * 64 + fr, col0 = u.pn * 256 + wc * 32 + 4 * fq;
#pragma unroll
        for (int ai = 0; ai < 2; ++ai) {
            u32x2 xw[4][2][2];
#pragma unroll
            for (int m = 0; m < 4; ++m)
#pragma unroll
                for (int bj = 0; bj < 2; ++bj)
#pragma unroll
                    for (int n = 0; n < 2; ++n) xw[m][bj][n] = *(const u32x2*)(XB1 + (size_t)(row0 + ai * 128 + m * 16) * 1024 + col0 + 128 * bj + 16 * n);
            asm volatile("" ::: "memory");
#pragma unroll
            for (int m = 0; m < 4; ++m)
#pragma unroll
                for (int bj = 0; bj < 2; ++bj)
#pragma unroll
                    for (int n = 0; n < 2; ++n) { const size_t off = (size_t)(row0 + ai * 128 + m * 16) * 1024 + col0 + 128 * bj + 16 * n; const u32x2 w = xw[m][bj][n];
                        f32x4 x1; x1.x = __uint_as_float(w.x << 16); x1.y = __uint_as_float(w.x & 0xffff0000u); x1.z = __uint_as_float(w.y << 16); x1.w = __uint_as_float(w.y & 0xffff0000u);
                        *(f32x4*)(out + off) = x1 + acc[ai][bj][m][n] * scale; }
            asm volatile("" ::: "memory");
        }
    }
};
struct OneUnit {
    int pm, pn;
    __device__ bool next(int i, pg8::Unit& u) const { if (i > 0) return false; u.pm = pm; u.pn = pn; return true; }
    __device__ __forceinline__ void a_ready(const pg8::Unit&) const {}
    __device__ __forceinline__ void done(const pg8::Unit&) const {}
};

#define MFMA32(a, b, c) __builtin_amdgcn_mfma_f32_32x32x16_bf16((a), (b), (c), 0, 0, 0)
#define EXP2(x) __builtin_amdgcn_exp2f(x)

__device__ __forceinline__ void load_q(const bf16_t* qrow, int hi, bf16x8 (&qf)[4]) {
#pragma unroll
    for (int ds = 0; ds < 4; ++ds) qf[ds] = *(const bf16x8*)(qrow + 16 * ds + 8 * hi);
    asm volatile("" : "+v"(qf[0]), "+v"(qf[1]), "+v"(qf[2]), "+v"(qf[3]));
}
template <int KROW>
__device__ __forceinline__ void qk_tile(const LAS bf16_t* Kt, const bf16x8 (&qf)[4], f32x16 (&s)[2], int r32, int hi) {
#pragma unroll
    for (int kb = 0; kb < 2; ++kb) {
        f32x16 a = {};
#pragma unroll
        for (int ds = 0; ds < 4; ++ds) { const bf16x8 kf = *(const LAS bf16x8*)(Kt + (32 * kb + r32) * KROW + 16 * ds + 8 * hi); a = MFMA32(kf, qf[ds], a); }
        s[kb] = a;
    }
}
template <int DV, int VROW>
__device__ __forceinline__ void pv_tile(const LAS bf16_t* Vt, const f32x16 (&p)[2], f32x16 (&o)[DV / 32], int r32, int hi) {
    bf16x8 pb[4];
#pragma unroll
    for (int j = 0; j < 4; ++j) { const int kb = j >> 1, r0 = 8 * (j & 1); u32x4 w; w.x = cvtpk(p[kb][r0], p[kb][r0 + 1]); w.y = cvtpk(p[kb][r0 + 2], p[kb][r0 + 3]); w.z = cvtpk(p[kb][r0 + 4], p[kb][r0 + 5]); w.w = cvtpk(p[kb][r0 + 6], p[kb][r0 + 7]); pb[j] = __builtin_bit_cast(bf16x8, w); }
#pragma unroll
    for (int db = 0; db < DV / 32; ++db) {
        bf16x8 vf[4];
#pragma unroll
        for (int j = 0; j < 4; ++j) vf[j] = *(const LAS bf16x8*)(Vt + (32 * db + r32) * VROW + 16 * j + 8 * hi);
#pragma unroll
        for (int j = 0; j < 4; ++j) o[db] = MFMA32(vf[j], pb[j], o[db]);
        __builtin_amdgcn_sched_barrier(0);
    }
}
template <int DV, class TF>
__device__ __forceinline__ void attn_loop(LAS unsigned char* lds, const bf16_t* Kg, int ldk, const bf16_t* VTg, int ldv, unsigned long long tmask,
                                          const bf16x8 (&qf)[4], f32x16 (&o)[DV / 32], float& m, float& l, const TF& tf) {
    const int tid = threadIdx.x, lane = tid & 63, r32 = lane & 31, hi = lane >> 5, srow = tid >> 3, sch = tid & 7;
    u32x4 kreg, vreg[DV / 64];
    int buf = 0;
    if (tmask) { const int t = __builtin_ctzll(tmask); kreg = *(const u32x4*)(Kg + (size_t)(64 * t + srow) * ldk + sch * 8);
#pragma unroll
        for (int i = 0; i < DV / 64; ++i) vreg[i] = *(const u32x4*)(VTg + (size_t)(srow + 64 * i) * ldv + 64 * t + sch * 8); }
    while (tmask) {
        const int t = __builtin_ctzll(tmask); tmask &= tmask - 1;
        LAS bf16_t* Kt = (LAS bf16_t*)(lds + buf * ABUF); LAS bf16_t* Vt = Kt + 64 * TROW;
        *(LAS u32x4*)(Kt + srow * TROW + sch * 8) = kreg;
#pragma unroll
        for (int i = 0; i < DV / 64; ++i) *(LAS u32x4*)(Vt + (srow + 64 * i) * TROW + sch * 8) = vreg[i];
        __syncthreads();
        if (tmask) { const int tn = __builtin_ctzll(tmask); kreg = *(const u32x4*)(Kg + (size_t)(64 * tn + srow) * ldk + sch * 8);
#pragma unroll
            for (int i = 0; i < DV / 64; ++i) vreg[i] = *(const u32x4*)(VTg + (size_t)(srow + 64 * i) * ldv + 64 * tn + sch * 8); }
        const int md = tf.mode(t);
        if (md) {
            f32x16 s[2];
            qk_tile<TROW>(Kt, qf, s, r32, hi);
            if (md == 2) {
                const int lim_hi = tf.lim_hi(t), lim_lo = tf.lim_lo(t);
#pragma unroll
                for (int kb = 0; kb < 2; ++kb)
#pragma unroll
                    for (int r = 0; r < 16; ++r) { const int kc_ = 32 * kb + (r & 3) + 8 * (r >> 2); if (kc_ > lim_hi || kc_ < lim_lo) s[kb][r] = -INFINITY; }
            }
            float mx = fmaxf(s[0][0], s[1][0]);
#pragma unroll
            for (int r = 1; r < 16; ++r) mx = fmaxf(mx, fmaxf(s[0][r], s[1][r]));
            mx = fmaxf(mx, __shfl_xor(mx, 32));
            const float mn = fmaxf(m, mx), alpha = EXP2(m - mn); m = mn;
            float rs = 0.f;
#pragma unroll
            for (int kb = 0; kb < 2; ++kb)
#pragma unroll
                for (int r = 0; r < 16; ++r) { const float e = EXP2(s[kb][r] - mn); s[kb][r] = e; rs += e; }
            l = l * alpha + rs;
            if (!__all(alpha == 1.0f)) {
#pragma unroll
                for (int db = 0; db < DV / 32; ++db) o[db] = o[db] * alpha;
            }
            pv_tile<DV, TROW>(Vt, s, o, r32, hi);
        }
        buf ^= 1;
    }
    __syncthreads();
}


template <int DV, bool LSEL, class TF>
__device__ __forceinline__ void attn_loop_fast(LAS unsigned char* lds, const bf16_t* Kg, int ldk, const bf16_t* VTg, int ldv, unsigned long long tmask,
                                               const bf16x8 (&qf)[4], f32x16 (&o)[DV / 32], f32x4& lsum, const TF& tf) {
    constexpr int ABF = (64 + DV) * TROW * 2;
    const int tid = threadIdx.x, lane = tid & 63, r32 = lane & 31, hi = lane >> 5, srow = tid >> 3, sch = tid & 7;
    if (!tmask) return;
    u32x4 kreg, vreg[DV / 64];
#define AF_LOAD(t) do { kreg = *(const u32x4*)(Kg + (size_t)(64 * (t) + srow) * ldk + sch * 8); _Pragma("unroll") for (int i_ = 0; i_ < DV / 64; ++i_) vreg[i_] = *(const u32x4*)(VTg + (size_t)(srow + 64 * i_) * ldv + 64 * (t) + sch * 8); } while (0)
#define AF_STORE(b) do { LAS bf16_t* Kt_ = (LAS bf16_t*)(lds + (b) * ABF); *(LAS u32x4*)(Kt_ + srow * TROW + sch * 8) = kreg; _Pragma("unroll") for (int i_ = 0; i_ < DV / 64; ++i_) *(LAS u32x4*)(Kt_ + 64 * TROW + (srow + 64 * i_) * TROW + sch * 8) = vreg[i_]; } while (0)
    int tc = __builtin_ctzll(tmask); tmask &= tmask - 1;
    AF_LOAD(tc); AF_STORE(0);
    int tn = -1; if (tmask) { tn = __builtin_ctzll(tmask); tmask &= tmask - 1; AF_LOAD(tn); }
    __syncthreads();
    f32x16 sA[2], sB[2];
    int bc = 0;
    if (tf.mode(tc)) qk_tile<TROW>((const LAS bf16_t*)(lds), qf, sA, r32, hi);
#define AF_STEP(scur, snxt) do { \
        const int bn = (bc == 2) ? 0 : bc + 1; \
        if (tn >= 0) AF_STORE(bn); \
        __syncthreads(); \
        int tnn = -1; if (tmask) { tnn = __builtin_ctzll(tmask); tmask &= tmask - 1; AF_LOAD(tnn); } \
        if (tn >= 0 && tf.mode(tn)) qk_tile<TROW>((const LAS bf16_t*)(lds + bn * ABF), qf, snxt, r32, hi); \
        const int md = tf.mode(tc); \
        if (md) { \
            _Pragma("unroll") for (int kb = 0; kb < 2; ++kb) _Pragma("unroll") for (int r = 0; r < 16; ++r) scur[kb][r] = EXP2(scur[kb][r]); \
            if (md == 2) { const int lim_hi = tf.lim_hi(tc), lim_lo = tf.lim_lo(tc); _Pragma("unroll") for (int kb = 0; kb < 2; ++kb) _Pragma("unroll") for (int r = 0; r < 16; ++r) { const int kc_ = 32 * kb + (r & 3) + 8 * (r >> 2); if (kc_ > lim_hi || kc_ < lim_lo) scur[kb][r] = 0.f; } } \
            bf16x8 pb[4]; \
            if constexpr (LSEL) { const bool sel = tf.lanesel(tc); const float sm = sel ? 1.f : 0.f; const unsigned am = sel ? 0xffffffffu : 0u; { const f32x16 t16_ = scur[0] + scur[1]; const f32x8 t8_ = t16_.lo + t16_.hi; lsum = lsum + (t8_.lo + t8_.hi) * sm; } \
                _Pragma("unroll") for (int j = 0; j < 4; ++j) { const int kb = j >> 1, r0 = 8 * (j & 1); u32x4 w; w.x = cvtpk(scur[kb][r0], scur[kb][r0 + 1]) & am; w.y = cvtpk(scur[kb][r0 + 2], scur[kb][r0 + 3]) & am; w.z = cvtpk(scur[kb][r0 + 4], scur[kb][r0 + 5]) & am; w.w = cvtpk(scur[kb][r0 + 6], scur[kb][r0 + 7]) & am; pb[j] = __builtin_bit_cast(bf16x8, w); } \
            } else { { const f32x16 t16_ = scur[0] + scur[1]; const f32x8 t8_ = t16_.lo + t16_.hi; lsum = lsum + (t8_.lo + t8_.hi); } \
                _Pragma("unroll") for (int j = 0; j < 4; ++j) { const int kb = j >> 1, r0 = 8 * (j & 1); u32x4 w; w.x = cvtpk(scur[kb][r0], scur[kb][r0 + 1]); w.y = cvtpk(scur[kb][r0 + 2], scur[kb][r0 + 3]); w.z = cvtpk(scur[kb][r0 + 4], scur[kb][r0 + 5]); w.w = cvtpk(scur[kb][r0 + 6], scur[kb][r0 + 7]); pb[j] = __builtin_bit_cast(bf16x8, w); } } \
            const LAS bf16_t* Vt_ = (const LAS bf16_t*)(lds + bc * ABF) + 64 * TROW; \
            _Pragma("unroll") for (int db = 0; db < DV / 32; ++db) { bf16x8 vf[4]; \
                _Pragma("unroll") for (int j = 0; j < 4; ++j) vf[j] = *(const LAS bf16x8*)(Vt_ + (32 * db + r32) * TROW + 16 * j + 8 * hi); \
                _Pragma("unroll") for (int j = 0; j < 4; ++j) o[db] = MFMA32(vf[j], pb[j], o[db]); } \
        } \
        tc = tn; tn = tnn; bc = bn; \
    } while (0)
    for (;;) {
        AF_STEP(sA, sB); if (tc < 0) break;
        AF_STEP(sB, sA); if (tc < 0) break;
    }
    __syncthreads();
#undef AF_LOAD
#undef AF_STORE
#undef AF_STEP
}
__device__ __forceinline__ float hsum4(const f32x4& v) { return (v[0] + v[1]) + (v[2] + v[3]); }

struct DiffTF { int qlo, qpos, hi4; __device__ __forceinline__ int mode(int t) const { return 64 * t > qlo + 31 ? 0 : (64 * t + 63 > qlo ? 2 : 1); }
    __device__ __forceinline__ int lim_hi(int t) const { return qpos - 64 * t - hi4; } __device__ __forceinline__ int lim_lo(int t) const { return -(1 << 30); } };
template <bool FAST>
__device__ __forceinline__ void diff_unit(const Params& P, LAS unsigned char* lds, int b, int h, int qb, float lam, bool dry) {
    const int tid = threadIdx.x, lane = tid & 63, wave = tid >> 6, r32 = lane & 31, hi = lane >> 5;
    unsigned char* ws = P.ws;
    const int q0 = qb * 256, qpos = q0 + 32 * wave + r32;
    bf16_t* DQ = (bf16_t*)(ws + WS_DQ); const bf16_t* DK = (const bf16_t*)(ws + WS_DK); const bf16_t* DVT = (const bf16_t*)(ws + WS_DVT);
    bf16_t* qrow = DQ + (size_t)(b * SEQ + qpos) * 1024 + h * 128;
    const unsigned long long tmask = (qb == 15) ? ~0ull : ((1ull << (4 * qb + 4)) - 1ull);
    DiffTF tf; tf.qlo = q0 + 32 * wave; tf.qpos = qpos; tf.hi4 = 4 * hi;
    LAS unsigned* o0p = (LAS unsigned*)(lds + L_O0P) + wave * 32 * 64 + lane;
    f32x16 o0[4];
#pragma unroll
    for (int c = 0; c < 2; ++c) {
        bf16x8 qf[4]; load_q(qrow + 64 * c, hi, qf);
        f32x16 o[4];
#pragma unroll
        for (int db = 0; db < 4; ++db) o[db] = (f32x16){};
        float m = -1e30f, l = 0.f;
        if (FAST) { f32x4 ls = {}; attn_loop_fast<128, false, DiffTF>(lds, DK + (size_t)b * SEQ * 1024 + (h * 2 + c) * 64, 1024, DVT + (size_t)((b * 8 + h) * 128) * SEQ, SEQ, tmask, qf, o, ls, tf); l = hsum4(ls); }
        else attn_loop<128, DiffTF>(lds, DK + (size_t)b * SEQ * 1024 + (h * 2 + c) * 64, 1024, DVT + (size_t)((b * 8 + h) * 128) * SEQ, SEQ, tmask, qf, o, m, l, tf);
        l += __shfl_xor(l, 32);
        const float inv = 1.0f / fmaxf(l, 1e-30f);
        if (c == 0) {
#pragma unroll
            for (int db = 0; db < 4; ++db)
#pragma unroll
                for (int r = 0; r < 8; ++r) o0p[(db * 8 + r) * 64] = cvtpk(o[db][2 * r] * inv, o[db][2 * r + 1] * inv);
        } else {
            const float il = inv * lam;
#pragma unroll
            for (int db = 0; db < 4; ++db)
#pragma unroll
                for (int r = 0; r < 8; ++r) { const unsigned pw = o0p[(db * 8 + r) * 64]; o0[db][2 * r] = __uint_as_float(pw << 16) - o[db][2 * r] * il; o0[db][2 * r + 1] = __uint_as_float(pw & 0xffff0000u) - o[db][2 * r + 1] * il; }
        }
    }
    float ss = 0.f;
#pragma unroll
    for (int db = 0; db < 4; ++db)
#pragma unroll
        for (int r = 0; r < 16; ++r) ss += o0[db][r] * o0[db][r];
    ss += __shfl_xor(ss, 32);
    const float rstd = rsqrtf(ss * (1.f / 128.f) + EPS) * 0.8f;
    const float* sg = P.in[9];
#pragma unroll
    for (int db = 0; db < 4; ++db)
#pragma unroll
        for (int u = 0; u < 4; ++u) { const int d = 32 * db + 8 * u + 4 * hi; const f32x4 g4 = *(const f32x4*)(sg + d);
            u32x2 w; w.x = cvtpk(o0[db][4 * u] * rstd * g4.x, o0[db][4 * u + 1] * rstd * g4.y); w.y = cvtpk(o0[db][4 * u + 2] * rstd * g4.z, o0[db][4 * u + 3] * rstd * g4.w);
            if (!dry) *(u32x2*)(qrow + d) = w; }
}

__device__ __forceinline__ void compress_unit(const Params& P, LAS unsigned char* lds, int which, int pm) {
    unsigned char* ws = P.ws;
    bf16_t* HID = (bf16_t*)(ws + WS_HID) + (size_t)which * 4096 * 256;
    {
        pg8::Gemm g = pg8::make_gemm((const bf16_t*)(ws + (which ? WS_VC : WS_KC)), (const bf16_t*)(ws + WS_W1T) + (size_t)which * 256 * 2048, 4096, 256, 2048);
        g.lda = 4096; g.kstepA = 512; g.a_sh = 2; g.a_lo = (size_t)256 * 4096 * 2; g.a_hi = 128;
        LAS float* pbs = (LAS float*)(lds + 131072);
        if (threadIdx.x < 256) { const float* pp = (const float*)(ws + WS_PB) + which * 16 * 256 + threadIdx.x; float sacc = 0.f;
#pragma unroll
            for (int kc = 0; kc < 16; ++kc) sacc += pp[kc * 256];
            pbs[threadIdx.x] = sacc; }
        __syncthreads();
        OneUnit S{pm, 0}; EpiHid E{HID, pbs};
        pg8::gemm_phase<EpiHid, OneUnit, false, true>((PG8_LAS unsigned char*)lds, g, S, E);
    }
    __threadfence(); __syncthreads(); __threadfence();
    int tid = threadIdx.x; asm volatile("" : "+v"(tid));
    const int lane = tid & 63, wave = tid >> 6, r32 = lane & 31, hi = lane >> 5;
    const bf16_t* W2T = (const bf16_t*)(ws + WS_W2T) + which * 64 * 256;
    const int rowl = 32 * wave + r32; const bf16_t* hrow = HID + (size_t)(pm * 256 + rowl) * 256;
    f32x16 c0 = {}, c1 = {};
#pragma unroll 2
    for (int ks = 0; ks < 16; ++ks) {
        const bf16x8 a0 = *(const bf16x8*)(W2T + r32 * 256 + 16 * ks + 8 * hi), a1 = *(const bf16x8*)(W2T + (32 + r32) * 256 + 16 * ks + 8 * hi), bf = *(const bf16x8*)(hrow + 16 * ks + 8 * hi);
        c0 = MFMA32(a0, bf, c0); c1 = MFMA32(a1, bf, c1);
    }
    const int g = pm >> 2, b = pm & 3, n = rowl;
    if (which == 0) {
        float ss = 0.f;
#pragma unroll
        for (int r = 0; r < 16; ++r) ss += c0[r] * c0[r] + c1[r] * c1[r];
        ss += __shfl_xor(ss, 32);
        const float rstd = (n < 255) ? rsqrtf(ss * (1.f / 64.f) + EPS) : 0.f;
        const float* gk = P.in[11]; const float* CC = (const float*)(ws + WS_CCOS) + n * 32; const float* CS = (const float*)(ws + WS_CSIN) + n * 32;
        bf16_t* kr = (bf16_t*)(ws + WS_KCMP) + (size_t)((b * 4 + g) * 256 + n) * 64;
#pragma unroll
        for (int u = 0; u < 4; ++u) { const int i = 8 * u + 4 * hi; const f32x4 g1 = *(const f32x4*)(gk + i), g2 = *(const f32x4*)(gk + 32 + i), cc = *(const f32x4*)(CC + i), sn = *(const f32x4*)(CS + i);
            float o1[4], o2[4];
#pragma unroll
            for (int j = 0; j < 4; ++j) { const float x1 = c0[4 * u + j] * rstd * g1[j], x2 = c1[4 * u + j] * rstd * g2[j]; o1[j] = x1 * cc[j] - x2 * sn[j]; o2[j] = x2 * cc[j] + x1 * sn[j]; }
            u32x2 w; w.x = cvtpk(o1[0], o1[1]); w.y = cvtpk(o1[2], o1[3]); *(u32x2*)(kr + i) = w; w.x = cvtpk(o2[0], o2[1]); w.y = cvtpk(o2[2], o2[3]); *(u32x2*)(kr + 32 + i) = w; }
    } else {
        bf16_t* vt = (bf16_t*)(ws + WS_VCMPT) + (size_t)((b * 4 + g) * 64) * 256 + perm16(n);
        const float z = (n < 255) ? 1.f : 0.f;
#pragma unroll
        for (int r = 0; r < 16; ++r) { const int d = crow(r, hi); vt[(size_t)d * 256] = f2bf(c0[r] * z); vt[(size_t)(d + 32) * 256] = f2bf(c1[r] * z); }
    }
}

struct SlcTF { unsigned long long mymask, wu; int qpos, hi4; __device__ __forceinline__ int mode(int t) const { return ((wu >> t) & 1ull) ? 2 : 0; }
    __device__ __forceinline__ int lim_hi(int t) const { return ((mymask >> t) & 1ull) ? qpos - 64 * t - hi4 : -(1 << 30); } __device__ __forceinline__ int lim_lo(int t) const { return -(1 << 30); } };
struct SlcTFF { unsigned long long mymask, wu; int qpos, c, hi4; __device__ __forceinline__ int mode(int t) const { return ((wu >> t) & 1ull) ? (t == c ? 2 : 1) : 0; }
    __device__ __forceinline__ bool lanesel(int t) const { return (mymask >> t) & 1ull; }
    __device__ __forceinline__ int lim_hi(int t) const { return qpos - 64 * t - hi4; } __device__ __forceinline__ int lim_lo(int t) const { return -(1 << 30); } };
struct WinTF { int c, qpos, hi4; __device__ __forceinline__ int mode(int t) const { return (t == c || t == c - 8) ? 2 : 1; }
    __device__ __forceinline__ int lim_hi(int t) const { return qpos - 64 * t - hi4; } __device__ __forceinline__ int lim_lo(int t) const { return qpos - 511 - 64 * t - hi4; } };
template <bool FAST>
__device__ __forceinline__ void nsa_unit(const Params& P, LAS unsigned char* lds, int b, int g, int c, bool dry) {
    const int tid = threadIdx.x, lane = tid & 63, wave = tid >> 6, r32 = lane & 31, hi = lane >> 5;
    unsigned char* ws = P.ws;
    const int q0 = 64 * c, tk = r32 >> 2, hg = r32 & 3, tokl = 8 * wave + tk, qpos = q0 + tokl;
    bf16_t* qrow = (bf16_t*)(ws + WS_NQ) + (size_t)(b * SEQ + qpos) * 1024 + (g * 4 + hg) * 64;
    bf16x8 qf[4]; load_q(qrow, hi, qf);
    const float* ngp = (const float*)(ws + WS_NG) + (size_t)(b * SEQ + qpos) * 48 + (g * 4 + hg) * 3;
    const float gate0 = ngp[0], gate1 = ngp[1], gate2 = ngp[2];
    f32x16 yt[2]; yt[0] = (f32x16){}; yt[1] = (f32x16){};
    const int ntl = (4 * c + 2) / 64 + 1;
    LAS bf16_t* CK = (LAS bf16_t*)(lds + L_CK); LAS bf16_t* CV = (LAS bf16_t*)(lds + L_CV);
    LAS float* IMP = (LAS float*)(lds + L_IMP); LAS unsigned long long* SEL = (LAS unsigned long long*)(lds + L_SEL);
    {
        const bf16_t* kc = (const bf16_t*)(ws + WS_KCMP) + (size_t)((b * 4 + g) * 256) * 64; const bf16_t* vc = (const bf16_t*)(ws + WS_VCMPT) + (size_t)((b * 4 + g) * 64) * 256;
        u32x4 kr[4], vr[4]; const int srow = tid >> 3, sch = tid & 7;
#pragma unroll
        for (int it = 0; it < 4; ++it) if (it < ntl) { kr[it] = *(const u32x4*)(kc + (64 * it + srow) * 64 + sch * 8); vr[it] = *(const u32x4*)(vc + srow * 256 + (sch + 8 * it) * 8); }
#pragma unroll
        for (int it = 0; it < 4; ++it) if (it < ntl) { *(LAS u32x4*)(CK + (64 * it + srow) * CKROW + sch * 8) = kr[it]; *(LAS u32x4*)(CV + srow * CVROW + (sch + 8 * it) * 8) = vr[it]; }
    }
    __syncthreads();
    if constexpr (FAST) {
        const int nlim = ((qpos - 31) >> 4) - 4 * hi;
        f32x16 o[2]; o[0] = (f32x16){}; o[1] = (f32x16){};
        float lrow = 0.f, carry = 0.f; float ivq[4][8];
#pragma unroll
        for (int T = 0; T < 4; ++T) {
#pragma unroll
            for (int i = 0; i < 8; ++i) ivq[T][i] = 0.f;
            if (T < ntl) {
                f32x16 s[2]; qk_tile<CKROW>(CK + T * 64 * CKROW, qf, s, r32, hi);
#pragma unroll
                for (int kb = 0; kb < 2; ++kb)
#pragma unroll
                    for (int r = 0; r < 16; ++r) { const int kc_ = 32 * kb + (r & 3) + 8 * (r >> 2); const float e = EXP2(s[kb][r]); s[kb][r] = (kc_ > nlim - 64 * T) ? 0.f : e; }
#pragma unroll
                for (int kb = 0; kb < 2; ++kb)
#pragma unroll
                    for (int u = 0; u < 4; ++u) {
                        const float qs = (s[kb][4 * u] + s[kb][4 * u + 1]) + (s[kb][4 * u + 2] + s[kb][4 * u + 3]);
                        lrow += qs;
                        const float x = __shfl_xor(s[kb][4 * u + 3], 32);
                        ivq[T][kb * 4 + u] = qs + (hi ? x : carry); carry = x;
                    }
                pv_tile<64, CVROW>(CV + 64 * T, s, o, r32, hi);
            }
        }
        lrow += __shfl_xor(lrow, 32);
        const float invl = 1.0f / fmaxf(lrow, 1e-30f);
#pragma unroll
        for (int T = 0; T < 4; ++T)
            if (T < ntl) {
#pragma unroll
                for (int i = 0; i < 8; ++i) { float iv = ivq[T][i] * invl; iv += __shfl_xor(iv, 1); iv += __shfl_xor(iv, 2); if (hg == 0) IMP[tokl * 64 + 16 * T + 2 * i + hi] = iv; }
            }
        const float gs = gate0 * invl;
#pragma unroll
        for (int db = 0; db < 2; ++db) yt[db] = o[db] * gs;
    } else {
        const int nlim = ((qpos - 31) >> 4) - 4 * hi;
        float m = -1e30f, l = 0.f;
        for (int T = 0; T < ntl; ++T) {
            f32x16 s[2]; qk_tile<CKROW>(CK + T * 64 * CKROW, qf, s, r32, hi);
            float mx = -INFINITY;
#pragma unroll
            for (int kb = 0; kb < 2; ++kb)
#pragma unroll
                for (int r = 0; r < 16; ++r) { const int kc_ = 32 * kb + (r & 3) + 8 * (r >> 2); if (kc_ > nlim - 64 * T) s[kb][r] = -INFINITY; mx = fmaxf(mx, s[kb][r]); }
            mx = fmaxf(mx, __shfl_xor(mx, 32));
            const float mn = fmaxf(m, mx), alpha = EXP2(m - mn); m = mn; float rs = 0.f;
#pragma unroll
            for (int kb = 0; kb < 2; ++kb)
#pragma unroll
                for (int r = 0; r < 16; ++r) rs += EXP2(s[kb][r] - mn);
            l = l * alpha + rs;
        }
        l += __shfl_xor(l, 32);
        const float invl = 1.0f / fmaxf(l, 1e-30f);
        f32x16 o[2]; o[0] = (f32x16){}; o[1] = (f32x16){};
        float carry = 0.f;
        for (int T = 0; T < ntl; ++T) {
            f32x16 s[2]; qk_tile<CKROW>(CK + T * 64 * CKROW, qf, s, r32, hi);
#pragma unroll
            for (int kb = 0; kb < 2; ++kb)
#pragma unroll
                for (int r = 0; r < 16; ++r) { const int kc_ = 32 * kb + (r & 3) + 8 * (r >> 2); s[kb][r] = (kc_ > nlim - 64 * T) ? 0.f : EXP2(s[kb][r] - m) * invl; }
#pragma unroll
            for (int kb = 0; kb < 2; ++kb)
#pragma unroll
                for (int u = 0; u < 4; ++u) {
                    const float qs = (s[kb][4 * u] + s[kb][4 * u + 1]) + (s[kb][4 * u + 2] + s[kb][4 * u + 3]);
                    const float x = __shfl_xor(s[kb][4 * u + 3], 32);
                    float iv = qs + (hi ? x : carry); carry = x;
                    iv += __shfl_xor(iv, 1); iv += __shfl_xor(iv, 2);
                    if (hg == 0) IMP[tokl * 64 + 16 * T + 8 * kb + 2 * u + hi] = iv;
                }
            pv_tile<64, CVROW>(CV + 64 * T, s, o, r32, hi);
        }
#pragma unroll
        for (int db = 0; db < 2; ++db) yt[db] = o[db] * gate0;
    }
    __syncthreads();
    LAS float* yst = (LAS float*)(lds + L_CK) + tid;
#pragma unroll
    for (int db = 0; db < 2; ++db)
#pragma unroll
        for (int r = 0; r < 16; ++r) yst[(db * 16 + r) * NTHREADS] = yt[db][r];
    for (int i = 0; i < 8; ++i) {
        const int tl = 8 * wave + i; const int j = lane;
        const bool forced = (j == 0) || (j == c) || (j == c - 1);
        const float v = forced ? 1e4f : IMP[tl * 64 + j];
        const bool okj = (j <= c);
        const unsigned key = okj ? (__float_as_uint(v) + 1u) : 0u;
        unsigned thr = 0u;
        for (int bit = 31; bit >= 0; --bit) { const unsigned cand = thr | (1u << bit); if (__popcll(__ballot(key >= cand)) >= 16) thr = cand; }
        const unsigned long long gtm = __ballot(key > thr), eqm = __ballot(key == thr);
        const int need = 16 - __popcll(gtm);
        const bool selj = (key > thr) || (key == thr && __popcll(eqm & ((1ull << j) - 1ull)) < need);
        const unsigned long long msk = __ballot(selj && okj);
        if (lane == 0) SEL[tl] = msk;
    }
    __syncthreads();
    unsigned long long mymask = SEL[tokl], wu = 0ull;
#pragma unroll
    for (int i = 0; i < 8; ++i) wu |= SEL[8 * wave + i];
    {
        SlcTF tf; tf.mymask = mymask; tf.wu = wu; tf.qpos = qpos; tf.hi4 = 4 * hi;
        const unsigned long long tmask = (c == 63) ? ~0ull : ((1ull << (c + 1)) - 1ull);
        f32x16 o[2]; o[0] = (f32x16){}; o[1] = (f32x16){}; float m = -1e30f, l = 0.f;
        if (FAST) { SlcTFF tff; tff.mymask = mymask; tff.wu = wu; tff.qpos = qpos; tff.c = c; tff.hi4 = 4 * hi; f32x4 ls = {};
            attn_loop_fast<64, true, SlcTFF>(lds, (const bf16_t*)(ws + WS_KSL) + (size_t)b * SEQ * 256 + g * 64, 256, (const bf16_t*)(ws + WS_VSLT) + (size_t)((b * 4 + g) * 64) * SEQ, SEQ, tmask, qf, o, ls, tff); l = hsum4(ls); }
        else attn_loop<64, SlcTF>(lds, (const bf16_t*)(ws + WS_KSL) + (size_t)b * SEQ * 256 + g * 64, 256, (const bf16_t*)(ws + WS_VSLT) + (size_t)((b * 4 + g) * 64) * SEQ, SEQ, tmask, qf, o, m, l, tf);
        l += __shfl_xor(l, 32); const float sc = gate1 / fmaxf(l, 1e-30f);
#pragma unroll
        for (int db = 0; db < 2; ++db)
#pragma unroll
            for (int r = 0; r < 16; ++r) yst[(db * 16 + r) * NTHREADS] += o[db][r] * sc;
    }
    {
        WinTF tf; tf.c = c; tf.qpos = qpos; tf.hi4 = 4 * hi;
        const int tlo = c >= 8 ? c - 8 : 0;
        const unsigned long long hi_m = (c == 63) ? ~0ull : ((1ull << (c + 1)) - 1ull), tmask = hi_m & ~((1ull << tlo) - 1ull);
        f32x16 o[2]; o[0] = (f32x16){}; o[1] = (f32x16){}; float m = -1e30f, l = 0.f;
        if (FAST) { f32x4 ls = {}; attn_loop_fast<64, false, WinTF>(lds, (const bf16_t*)(ws + WS_KWN) + (size_t)b * SEQ * 256 + g * 64, 256, (const bf16_t*)(ws + WS_VWNT) + (size_t)((b * 4 + g) * 64) * SEQ, SEQ, tmask, qf, o, ls, tf); l = hsum4(ls); }
        else attn_loop<64, WinTF>(lds, (const bf16_t*)(ws + WS_KWN) + (size_t)b * SEQ * 256 + g * 64, 256, (const bf16_t*)(ws + WS_VWNT) + (size_t)((b * 4 + g) * 64) * SEQ, SEQ, tmask, qf, o, m, l, tf);
        l += __shfl_xor(l, 32); const float sc = gate2 / fmaxf(l, 1e-30f);
#pragma unroll
        for (int db = 0; db < 2; ++db)
#pragma unroll
            for (int r = 0; r < 16; ++r) yt[db][r] = yst[(db * 16 + r) * NTHREADS] + o[db][r] * sc;
    }
#pragma unroll
    for (int db = 0; db < 2; ++db)
#pragma unroll
        for (int u = 0; u < 4; ++u) { const int d = 32 * db + 8 * u + 4 * hi; u32x2 w; w.x = cvtpk(yt[db][4 * u], yt[db][4 * u + 1]); w.y = cvtpk(yt[db][4 * u + 2], yt[db][4 * u + 3]); if (!dry) *(u32x2*)(qrow + d) = w; }
}

#define XB_TMO      128
#define XB_XCNT(j)  (256  + 64 * (j))
#define XB_XSUB(j)  (1280 + 64 * (j))
#define XB_XGEN(j)  (2304 + 64 * (j))
#define XB_TOP      3328
#define XB_TOPGEN   3392
#define XCD_BAR_WORDS 3456
#define XB_SPIN_CAP (1u << 18)

__device__ __forceinline__ unsigned xb_ld(unsigned* p)              { return __hip_atomic_load(p, __ATOMIC_RELAXED, __HIP_MEMORY_SCOPE_AGENT); }
__device__ __forceinline__ unsigned xb_add(unsigned* p, unsigned v) { return __hip_atomic_fetch_add(p, v, __ATOMIC_RELAXED, __HIP_MEMORY_SCOPE_AGENT); }
__device__ __forceinline__ unsigned xb_xcc_id() { return (unsigned)__builtin_amdgcn_s_getreg((3 << 11) | 20) & 0xFu; }
#define XB_SPIN(cond, bar) do { unsigned _sp = 0; while (cond) { __builtin_amdgcn_s_sleep(1); \
    if ((++_sp & 255u) == 0u) { if (xb_ld(&(bar)[XB_TMO])) break; if (_sp > XB_SPIN_CAP) { atomicAdd(&(bar)[XB_TMO], 1u); break; } } } } while (0)

struct XcdBarrier {
    unsigned* bar; unsigned x;
    volatile LAS unsigned* st;
};

__device__ __forceinline__ XcdBarrier xcd_barrier_post(unsigned* bar, volatile LAS unsigned* st) {
    XcdBarrier b; b.bar = bar; b.x = xb_xcc_id(); b.st = st;
    if (threadIdx.x == 0) (void)xb_add(&bar[XB_XCNT(b.x)], 1u);
    return b;
}
__device__ __forceinline__ void xcd_barrier_complete(unsigned* bar, unsigned x, unsigned& nloc, unsigned& nx) {
    const unsigned G = gridDim.x * gridDim.y * gridDim.z;
    unsigned sum, cnt, mine, sp = 0u;
    for (;;) {
        sum = 0u; cnt = 0u; mine = 0u;
#pragma unroll
        for (unsigned j = 0; j < 16; ++j) { const unsigned c = xb_ld(&bar[XB_XCNT(j)]); sum += c; cnt += (c > 0u) ? 1u : 0u; mine = (j == x) ? c : mine; }
        if (sum == G) break;
        __builtin_amdgcn_s_sleep(1);
        if ((++sp & 255u) == 0u) { if (xb_ld(&bar[XB_TMO])) break; if (sp > XB_SPIN_CAP) { atomicAdd(&bar[XB_TMO], 1u); break; } }
    }
    nloc = mine > 0u ? mine : 1u; nx = cnt > 0u ? cnt : 1u;
}

__device__ __forceinline__ void xcd_barrier(const XcdBarrier& b) {
    asm volatile("s_waitcnt vmcnt(0)" ::: "memory");
    __syncthreads();
    if (threadIdx.x == 0) {
        unsigned* bar = b.bar;
        __builtin_amdgcn_s_waitcnt(0);
        unsigned nloc = b.st[0], nx = b.st[1];
        if (nloc == 0u) { xcd_barrier_complete(bar, b.x, nloc, nx); b.st[0] = nloc; b.st[1] = nx; }
        const unsigned old = xb_add(&bar[XB_XSUB(b.x)], 1u);
        const unsigned gen = old / nloc;
        if (old + 1u == (gen + 1u) * nloc) {
            __builtin_amdgcn_fence(__ATOMIC_RELEASE, "agent");
            asm volatile("s_waitcnt vmcnt(0)" ::: "memory");
            const unsigned og = xb_add(&bar[XB_TOP], 1u);
            const unsigned tg = og / nx;
            if (og + 1u == (tg + 1u) * nx) xb_add(&bar[XB_TOPGEN], 1u);
            else XB_SPIN(xb_ld(&bar[XB_TOPGEN]) == tg, bar);
            __builtin_amdgcn_fence(__ATOMIC_ACQUIRE, "agent");
            xb_add(&bar[XB_XGEN(b.x)], 1u);
            asm volatile("s_waitcnt vmcnt(0)" ::: "memory");
        } else {
            XB_SPIN(xb_ld(&bar[XB_XGEN(b.x)]) == gen, bar);
            __builtin_amdgcn_fence(__ATOMIC_ACQUIRE, "agent");
            asm volatile("s_waitcnt vmcnt(0)" ::: "memory");
        }
    }
    __syncthreads();
}

__device__ __forceinline__ int next_item(unsigned* counter, LAS int* slot) {
    __syncthreads();
    if (threadIdx.x == 0) *slot = (int)atomicAdd(counter, 1u);
    __syncthreads();
    return *slot;
}

__global__ void __launch_bounds__(NTHREADS) fwd_megakernel(Params P) {
    extern __shared__ __attribute__((aligned(16))) unsigned char lds_raw[];
    LAS unsigned char* lds = (LAS unsigned char*)lds_raw;
    cg::grid_group grid = cg::this_grid();
    const int G = gridDim.x, bx = blockIdx.x;
    const int vb = (G % 8 == 0) ? (bx % 8) * (G / 8) + bx / 8 : bx;
    unsigned char* ws = P.ws;
    unsigned* ctl = (unsigned*)(ws + WS_CTL);
    LAS int* slot = (LAS int*)(lds + L_SLOT);
    if (threadIdx.x < 8) ((LAS unsigned*)(lds + L_SLOT))[threadIdx.x] = 0u;
    __syncthreads();
    XcdBarrier xbar = xcd_barrier_post(ctl + CW_BAR, (volatile LAS unsigned*)(lds + L_SLOT + 16));
    const int lo = P.ph_lo, hi = P.ph_hi;
#ifdef PROBE_PHASE
    const unsigned long long t_start = __builtin_amdgcn_s_memrealtime(); unsigned long long t_probe = 0ull;
#define STAMP(k) do { if ((k) == PROBE_PHASE) t_probe = __builtin_amdgcn_s_memrealtime(); } while (0)
#else
#define STAMP(k) do { } while (0)
#endif
#ifndef PHMASK
#define PHMASK 0xff
#endif
#define IN(k) (((PHMASK >> (k)) & 1) && lo <= (k) && (k) < hi)
#define SEAM(k) do { if (IN(k) && IN((k) + 1)) { if (P.ph_lo < 0) grid.sync(); else xcd_barrier(xbar); } STAMP(k); } while (0)

    if (IN(0)) p0_prologue(P, lds, vb, G);
    SEAM(0);
    if (IN(1)) {
        pg8::Gemm g = pg8::make_gemm((const bf16_t*)(ws + WS_XN), (const bf16_t*)(ws + WS_WIN), MTOK, NPAD, 1024);
        pg8::StaticOrder S; S.init(MTOK, NPAD, G, bx);
        EpiProj E; E.ws = ws; E.gq = P.in[3]; E.gk = P.in[4]; E.gnq = P.in[10]; E.gnk = P.in[11]; E.mgp = (unsigned char*)P.out;
        pg8::gemm_phase<EpiProj, pg8::StaticOrder, true, true>((PG8_LAS unsigned char*)lds, g, S, E);
        for (;;) {
            const int it = next_item(ctl + 320, slot);
            if (it >= 704) break;
            late_weight_item(P, lds, it);
        }
    }
    SEAM(1);
    if (IN(2)) {
        float lam;
        bool fast;
        { const int lane = threadIdx.x & 63; const float a = wave_sum(P.in[5][lane] * P.in[6][lane]), b2 = wave_sum(P.in[7][lane] * P.in[8][lane]); lam = expf(a) - expf(b2) + 0.2f;
          float gq = fabsf(P.in[3][lane]), gk = fabsf(P.in[4][lane]);
#pragma unroll
          for (int o_ = 1; o_ < 64; o_ <<= 1) { gq = fmaxf(gq, __shfl_xor(gq, o_)); gk = fmaxf(gk, __shfl_xor(gk, o_)); }
          fast = (QSCALE * 64.f * gq * gk <= 40.f); }
        for (;;) {
            const int it = next_item(ctl + 128, slot);
            if (it >= 32) break;
            compress_unit(P, lds, it >> 4, it & 15);
        }
        for (;;) {
            const int it = next_item(ctl + 0, slot);
            if (it >= 512) break;
            const int qb = 15 - (it >> 5), bh = it & 31;
            if (fast) diff_unit<true>(P, lds, bh >> 3, bh & 7, qb, lam, P.dup != 0); else diff_unit<false>(P, lds, bh >> 3, bh & 7, qb, lam, P.dup != 0);
        }
    }
    SEAM(2);
    if (IN(3)) {
        bool fast;
        { const int lane = threadIdx.x & 63; float gq = fabsf(P.in[10][lane]), gk = fmaxf(fabsf(P.in[11][lane]), fmaxf(fabsf(P.in[11][64 + lane]), fabsf(P.in[11][128 + lane])));
#pragma unroll
          for (int o_ = 1; o_ < 64; o_ <<= 1) { gq = fmaxf(gq, __shfl_xor(gq, o_)); gk = fmaxf(gk, __shfl_xor(gk, o_)); }
          fast = (QSCALE * 64.f * gq * gk <= 40.f); }
        for (;;) {
            const int it = next_item(ctl + 64, slot);
            if (it >= 1024) break;
            const int c = 63 - (it >> 4), bg = it & 15;
            if (fast) nsa_unit<true>(P, lds, bg >> 2, bg & 3, c, P.dup != 0); else nsa_unit<false>(P, lds, bg >> 2, bg & 3, c, P.dup != 0);
        }
    }
    SEAM(3);
    if (IN(4)) {
        static_assert(WS_WPN == WS_WPD + (size_t)1024 * 1024 * 2 && WS_NQ > WS_DQ, "the two branch GEMMs are addressed as one virtual GEMM");
        TwoSched S; S.S.init(MTOK, 1024, G, bx);
        pg8::Gemm g = pg8::make_gemm((const bf16_t*)(ws + WS_DQ), (const bf16_t*)(ws + WS_WPD), MTOK, 2048, 1024);
        g.a_sh = 6; g.a_lo = (size_t)256 * 1024 * 2; g.a_hi = WS_NQ - WS_DQ;
        EpiMerge2 E{(const bf16_t*)P.out, (bf16_t*)(ws + WS_MIXED)};
        pg8::gemm_phase<EpiMerge2, TwoSched, true, true>((PG8_LAS unsigned char*)lds, g, S, E);
    }
    SEAM(4);
    if (IN(5)) {
        pg8::Gemm g = pg8::make_gemm((const bf16_t*)(ws + WS_MIXED), (const bf16_t*)(ws + WS_WOUT), MTOK, 1024, 1024);
        pg8::StaticOrder S; S.init(MTOK, 1024, G, bx);
        EpiRes1 E{P.in[0], P.out, (bf16_t*)(ws + WS_XB1), (float*)(ws + WS_PART)};
        pg8::gemm_phase<EpiRes1, pg8::StaticOrder, true, true>((PG8_LAS unsigned char*)lds, g, S, E);
    }
    SEAM(5);
    if (IN(6)) {
        pg8::Gemm g = pg8::make_gemm((const bf16_t*)(ws + WS_XB1), (const bf16_t*)(ws + WS_WUP), MTOK, DFF, 1024);
        pg8::StaticOrder S; S.init(MTOK, DFF, G, bx);
        EpiUp E{(const float*)(ws + WS_PART), (bf16_t*)(ws + WS_HB)};
        pg8::gemm_phase<EpiUp, pg8::StaticOrder, true, true>((PG8_LAS unsigned char*)lds, g, S, E);
    }
    SEAM(6);
    if (IN(7)) {
        pg8::Gemm g = pg8::make_gemm((const bf16_t*)(ws + WS_HB), (const bf16_t*)(ws + WS_WDN), MTOK, 1024, DFF);
        pg8::StaticOrder S; S.init(MTOK, 1024, G, bx);
        EpiRes2 E{P.out, 1.f, (const bf16_t*)(ws + WS_XB1)};
        pg8::gemm_phase<EpiRes2, pg8::StaticOrder, true, true>((PG8_LAS unsigned char*)lds, g, S, E);
    }
#ifdef PROBE_PHASE
    grid.sync();
    if (blockIdx.x == 0 && threadIdx.x == 0) P.out[0] = 1000.0f + (float)(t_probe - t_start) * 0.01f;
#endif
#undef IN
#undef SEAM
}

#ifndef PROBE_DUP
#define PROBE_DUP -1
#endif
extern "C" void kernel_launch(void* const* d_in, const int* in_sizes, int n_in, void* d_out, int out_size, void* d_ws, size_t ws_size, hipStream_t stream) {
    static int grid = 0;
    if (grid == 0) {
        if (n_in != 24 || out_size != MTOK * DM || ws_size < WS_END) { fprintf(stderr, "kernel_launch: unexpected shapes (n_in %d out %d ws %zu)\n", n_in, out_size, ws_size); grid = -1; return; }
        int dev = 0, cus = 0, per_cu = 0;
        hipGetDevice(&dev); hipDeviceGetAttribute(&cus, hipDeviceAttributeMultiprocessorCount, dev);
        if (hipFuncSetAttribute((const void*)fwd_megakernel, hipFuncAttributeMaxDynamicSharedMemorySize, LDS_BYTES) != hipSuccess) { fprintf(stderr, "kernel_launch: hipFuncSetAttribute failed\n"); grid = -1; return; }
        if (hipOccupancyMaxActiveBlocksPerMultiprocessor(&per_cu, (const void*)fwd_megakernel, NTHREADS, LDS_BYTES) != hipSuccess || per_cu < 1) { fprintf(stderr, "kernel_launch: occupancy query says %d\n", per_cu); per_cu = 1; }
        (void)hipGetLastError();
        grid = cus * 1;
        fprintf(stderr, "kernel_launch: grid %d (cus %d, per_cu %d)\n", grid, cus, per_cu);
    }
    if (grid < 0) return;
    hipMemsetAsync((char*)d_ws + WS_CTL, 0, CTL_BYTES, stream);
    Params p{};
    for (int i = 0; i < 24; ++i) p.in[i] = (const float*)d_in[i];
    p.out = (float*)d_out; p.ws = (unsigned char*)d_ws;
    for (int i = 0; i < 32; ++i) p.invfreq[i] = (double)powf(10000.0f, -(float)i / 32.0f);
    p.pad = 0;
    int plan[3][3] = {{0, 8, 0}, {0, 0, 0}, {0, 0, 0}}; int nl = 1;
    if (PROBE_DUP >= 0) { const int k = PROBE_DUP; const bool inplace = (k == 2 || k == 3 || k == 7); plan[0][0] = 0; plan[0][1] = k + (inplace ? 0 : 1); plan[0][2] = 0; plan[1][0] = k; plan[1][1] = k + 1; plan[1][2] = inplace ? 1 : 0; plan[2][0] = k + (inplace ? 0 : 1); plan[2][1] = 8; plan[2][2] = 0; nl = 3; }
    for (int li = 0; li < nl; ++li) {
        if (plan[li][0] >= plan[li][1]) continue;
        if (li > 0) hipMemsetAsync((char*)d_ws + WS_CTL, 0, CTL_BYTES, stream);
        p.ph_lo = plan[li][0]; p.ph_hi = plan[li][1]; p.dup = plan[li][2];
        void* args[] = {&p};
        hipError_t e = hipLaunchCooperativeKernel((const void*)fwd_megakernel, dim3(grid), dim3(NTHREADS), args, LDS_BYTES, stream);
        if (e != hipSuccess) fprintf(stderr, "kernel_launch: cooperative launch failed: %s (grid %d)\n", hipGetErrorString(e), grid);
    }
}
```

```cpp
#include <hip/hip_runtime.h>
#include <hip/hip_cooperative_groups.h>
#include <cstdio>
#include <cstdint>
#include <cmath>
namespace cg = cooperative_groups;

namespace pg8 {
#define PG8_LAS __attribute__((address_space(3)))
typedef unsigned short bf16_t;
typedef short bf16x8 __attribute__((ext_vector_type(8)));
typedef float f32x4 __attribute__((ext_vector_type(4)));
typedef unsigned u32x4 __attribute__((ext_vector_type(4)));
constexpr int BM = 256, BK = 64, HALF = 128, HTB = HALF * BK * 2  , STAGE_BYTES = 8 * HTB, NXCD = 8, WGM = 8;

__host__ __device__ __forceinline__ int lds_byte(int r, int c) { const int st = (r >> 4) * 2 + (c >> 5), rr = r & 15, cc = c & 31, ob = rr * 64 + cc * 2; return st * 1024 + (ob ^ (((ob >> 9) & 1) << 5)); }
__host__ __device__ __forceinline__ void stage_rc(int b, int& R, int& C) { const int st = b / 1024, sb = b % 1024, swz = sb ^ (((sb >> 9) & 1) << 5); R = (st >> 1) * 16 + swz / 64; C = (st & 1) * 32 + (swz % 64) / 2; }
__host__ __device__ __forceinline__ int perm32(int rho) { const int n = rho >> 4, i = rho & 15; return 8 * (i >> 2) + 4 * n + (i & 3); }

struct Unit { int pm, pn; };
struct Gemm { const bf16_t* A; const bf16_t* Bt; int M, N, K; int lda; int kstepA; int a_sh; size_t a_lo, a_hi; };
__host__ __device__ __forceinline__ Gemm make_gemm(const bf16_t* A, const bf16_t* Bt, int M, int N, int K) { Gemm g; g.A = A; g.Bt = Bt; g.M = M; g.N = N; g.K = K; g.lda = K; g.kstepA = BK * 2; g.a_sh = 24; g.a_lo = (size_t)BM * K * 2; g.a_hi = 0; return g; }
__device__ __forceinline__ const char* a_tile(const Gemm& g, int pm) { return (const char*)g.A + (size_t)(pm >> g.a_sh) * g.a_hi + (size_t)(pm & ((1 << g.a_sh) - 1)) * g.a_lo; }

struct StaticOrder {
    int nM, nN, nwg, G, c;
    __host__ __device__ void init(int M, int N, int G_, int c_) { nM = M / BM; nN = N / BM; nwg = nM * nN; G = G_; c = c_; }
    __host__ __device__ bool next(int i, Unit& u) const {
        const long L = (long)i * G + c; if (L >= nwg) return false;
        int wgid = (int)L; { const int q = nwg / NXCD, r = nwg % NXCD, xcd = wgid % NXCD, off = wgid / NXCD; wgid = (xcd < r ? xcd * (q + 1) : r * (q + 1) + (xcd - r) * q) + off; }
        const int nig = WGM * nN, gid = wgid / nig, fm = gid * WGM, gsz = (nM - fm) < WGM ? (nM - fm) : WGM;
        u.pm = fm + ((wgid % nig) % gsz); u.pn = (wgid % nig) / gsz; return true;
    }
    __device__ __forceinline__ void a_ready(const Unit&) const {}
    __device__ __forceinline__ void done(const Unit&) const {}
};


template <class Epi, class Sched, bool ALIGN_EPI = false, bool SP2 = false>
__device__ __forceinline__ void gemm_phase(PG8_LAS unsigned char* lds, const Gemm g, const Sched& S, const Epi& E) {
    const int tid = threadIdx.x, wid = __builtin_amdgcn_readfirstlane(tid >> 6), lane = tid & 63, wr = wid >> 2, wc = wid & 3, fr = lane & 15, fq = lane >> 4;
    const int K = g.K, nt = K / BK;
    unsigned voffA[2], voffB[2];
#pragma unroll
    for (int i = 0; i < 2; ++i) { int R, C; stage_rc(tid * 16 + i * 8192, R, C); const int Rb = Epi::PERM ? ((R & ~31) + perm32(R & 31)) : R;
        voffA[i] = (unsigned)(R * g.lda + C) * 2u; voffB[i] = (unsigned)(Rb * K + C) * 2u; }
    const size_t kstep = (size_t)(BK * 2); const size_t kstepA = (size_t)g.kstepA; const size_t hstepA = (size_t)HALF * g.lda * 2;
    const size_t hstep = (size_t)HALF * K * 2;
    const size_t tstep = 2 * hstep;
    const unsigned ldsw = (unsigned)wid * 1024u;
    const int aoff = lds_byte(wr * 64 + fr, fq * 8), boff = lds_byte(wc * 32 + fr, fq * 8);
#define PG8_SA(b, h) (((b) * 2 + (h)) * HTB)
#define PG8_SB(b, h) ((4 + (b) * 2 + (h)) * HTB)
#define PG8_STAGE(bufoff, gbase, voff) do { _Pragma("unroll") for (int _i = 0; _i < 2; ++_i) \
        __builtin_amdgcn_global_load_lds((const unsigned*)((const char*)(gbase) + (voff)[_i]), (PG8_LAS unsigned*)(lds + (bufoff) + ldsw + _i * 8192), 16, 0, 0); } while (0)
#define PG8_LDA(dst, b, h) do { _Pragma("unroll") for (int m = 0; m < 4; ++m) _Pragma("unroll") for (int k = 0; k < 2; ++k) dst[m][k] = *(const PG8_LAS bf16x8*)(lds + PG8_SA(b, h) + aoff + m * 2048 + k * 1024); } while (0)
#define PG8_LDB(dst, b, h) do { _Pragma("unroll") for (int n = 0; n < 2; ++n) _Pragma("unroll") for (int k = 0; k < 2; ++k) dst[n][k] = *(const PG8_LAS bf16x8*)(lds + PG8_SB(b, h) + boff + n * 2048 + k * 1024); } while (0)
#define PG8_MMA(ai, bj, At, Bt) do { __builtin_amdgcn_s_setprio(1); _Pragma("unroll") for (int m = 0; m < 4; ++m) _Pragma("unroll") for (int n = 0; n < 2; ++n) _Pragma("unroll") for (int k = 0; k < 2; ++k) \
        acc[ai][bj][m][n] = __builtin_amdgcn_mfma_f32_16x16x32_bf16(Bt[n][k], At[m][k], acc[ai][bj][m][n], 0, 0, 0); __builtin_amdgcn_s_setprio(0); } while (0)
#define PG8_WAIT_V(n) asm volatile("s_waitcnt vmcnt(" #n ")" ::: "memory")
#define PG8_WAIT_L(n) asm volatile("s_waitcnt lgkmcnt(" #n ")" ::: "memory")
#define PG8_BAR __builtin_amdgcn_s_barrier()
#define PG8_SCHED __builtin_amdgcn_sched_barrier(0)
    Unit cur, nxt; int ui = 0;
    if (!S.next(0, cur)) return;
    f32x4 acc[2][2][4][2];
#pragma unroll
    for (int a = 0; a < 2; ++a)
#pragma unroll
        for (int b = 0; b < 2; ++b)
#pragma unroll
            for (int m = 0; m < 4; ++m)
#pragma unroll
                for (int n = 0; n < 2; ++n) acc[a][b][m][n] = (f32x4){0.f, 0.f, 0.f, 0.f};
    bf16x8 At[4][2], B0[2][2], B1[2][2];
    const char* cA = a_tile(g, cur.pm); const char* cB = (const char*)g.Bt + (size_t)cur.pn * tstep;
    S.a_ready(cur);
    if constexpr (SP2) {
        PG8_STAGE(PG8_SB(0, 0), cB, voffB); PG8_STAGE(PG8_SB(0, 1), cB + hstep, voffB); PG8_STAGE(PG8_SA(0, 0), cA, voffA); PG8_STAGE(PG8_SA(0, 1), cA + hstepA, voffA);
        if (wr == 1) PG8_BAR;
        PG8_WAIT_V(2); PG8_BAR;
        PG8_STAGE(PG8_SB(1, 0), cB + kstep, voffB); PG8_STAGE(PG8_SA(1, 0), cA + kstepA, voffA); PG8_STAGE(PG8_SB(1, 1), cB + hstep + kstep, voffB);
        PG8_WAIT_V(6); PG8_BAR;
    } else {
        PG8_STAGE(PG8_SB(0, 0), cB, voffB); PG8_STAGE(PG8_SA(0, 0), cA, voffA); PG8_STAGE(PG8_SB(0, 1), cB + hstep, voffB); PG8_STAGE(PG8_SA(0, 1), cA + hstepA, voffA);
        if (wr == 1) PG8_BAR;
        PG8_WAIT_V(4); PG8_BAR;
        PG8_STAGE(PG8_SB(1, 0), cB + kstep, voffB); PG8_STAGE(PG8_SA(1, 0), cA + kstepA, voffA); PG8_STAGE(PG8_SB(1, 1), cB + hstep + kstep, voffB);
        PG8_WAIT_V(6); PG8_BAR;
    }
    for (;;) {
        const bool has_next = S.next(ui + 1, nxt);
        const char* nA = has_next ? a_tile(g, nxt.pm) : cA; const char* nB = has_next ? (const char*)g.Bt + (size_t)nxt.pn * tstep : cB;
        for (int t = 0; t < nt; t += 2) {
            const bool last = (t == nt - 2);
            const char* a1 = cA + (size_t)(t + 1) * kstepA;
            const char* a2 = last ? nA : cA + (size_t)(t + 2) * kstepA; const char* b2 = last ? nB : cB + (size_t)(t + 2) * kstep;
            const char* a3 = a2 + kstepA; const char* b3 = b2 + kstep;
            if (last && has_next) S.a_ready(nxt);
            if constexpr (SP2) {
            PG8_LDB(B0, 0, 0); PG8_LDB(B1, 0, 1); PG8_SCHED; PG8_LDA(At, 0, 0); PG8_STAGE(PG8_SA(1, 1), a1 + hstepA, voffA);
            PG8_WAIT_V(8); PG8_WAIT_L(0); PG8_BAR; PG8_MMA(0, 0, At, B0); PG8_MMA(0, 1, At, B1); PG8_BAR; PG8_SCHED;
            PG8_LDA(At, 0, 1); PG8_STAGE(PG8_SB(0, 0), b2, voffB); PG8_STAGE(PG8_SB(0, 1), b2 + hstep, voffB); PG8_STAGE(PG8_SA(0, 0), a2, voffA);
            PG8_WAIT_V(8); PG8_WAIT_L(0); PG8_BAR; PG8_MMA(1, 0, At, B0); PG8_MMA(1, 1, At, B1); PG8_BAR; PG8_SCHED;
            PG8_LDB(B0, 1, 0); PG8_LDB(B1, 1, 1); PG8_SCHED; PG8_LDA(At, 1, 0); PG8_STAGE(PG8_SA(0, 1), a2 + hstepA, voffA);
            PG8_WAIT_V(8); PG8_WAIT_L(0); PG8_BAR; PG8_MMA(0, 0, At, B0); PG8_MMA(0, 1, At, B1); PG8_BAR; PG8_SCHED;
            PG8_LDA(At, 1, 1); PG8_STAGE(PG8_SB(1, 0), b3, voffB); PG8_STAGE(PG8_SB(1, 1), b3 + hstep, voffB); PG8_STAGE(PG8_SA(1, 0), a3, voffA);
            PG8_WAIT_V(8); PG8_WAIT_L(0); PG8_BAR; PG8_MMA(1, 0, At, B0); PG8_MMA(1, 1, At, B1); PG8_BAR; PG8_SCHED;
            } else {
            PG8_LDB(B0, 0, 0); PG8_SCHED; PG8_LDA(At, 0, 0); PG8_STAGE(PG8_SA(1, 1), a1 + hstepA, voffA);
            PG8_WAIT_L(8); PG8_BAR; PG8_WAIT_L(0); PG8_MMA(0, 0, At, B0); PG8_BAR; PG8_SCHED;
            PG8_LDB(B1, 0, 1); PG8_STAGE(PG8_SB(0, 0), b2, voffB);
            PG8_BAR; PG8_WAIT_L(0); PG8_MMA(0, 1, At, B1); PG8_BAR;
            PG8_LDA(At, 0, 1); PG8_STAGE(PG8_SA(0, 0), a2, voffA);
            PG8_BAR; PG8_WAIT_L(0); PG8_MMA(1, 0, At, B0); PG8_BAR; PG8_SCHED;
            PG8_STAGE(PG8_SB(0, 1), b2 + hstep, voffB);
            PG8_WAIT_V(6); PG8_BAR; PG8_MMA(1, 1, At, B1); PG8_BAR;
            PG8_LDB(B0, 1, 0); PG8_SCHED; PG8_LDA(At, 1, 0); PG8_STAGE(PG8_SA(0, 1), a2 + hstepA, voffA);
            PG8_WAIT_L(8); PG8_BAR; PG8_WAIT_L(0); PG8_MMA(0, 0, At, B0); PG8_BAR; PG8_SCHED;
            PG8_LDB(B1, 1, 1); PG8_STAGE(PG8_SB(1, 0), b3, voffB);
            PG8_BAR; PG8_WAIT_L(0); PG8_MMA(0, 1, At, B1); PG8_BAR;
            PG8_LDA(At, 1, 1); PG8_STAGE(PG8_SA(1, 0), a3, voffA);
            PG8_BAR; PG8_WAIT_L(0); PG8_MMA(1, 0, At, B0); PG8_BAR; PG8_SCHED;
            PG8_STAGE(PG8_SB(1, 1), b3 + hstep, voffB);
            PG8_WAIT_V(6); PG8_BAR; PG8_MMA(1, 1, At, B1); PG8_BAR;
            }
        }
        if constexpr (ALIGN_EPI) { if (wr == 0) PG8_BAR; }
        if constexpr (!Epi::AFTER_DRAIN) { E(acc, cur, wr, wc, fr, fq); S.done(cur); }
        if (!has_next) break;
#pragma unroll
        for (int a = 0; a < 2; ++a)
#pragma unroll
            for (int b = 0; b < 2; ++b)
#pragma unroll
                for (int m = 0; m < 4; ++m)
#pragma unroll
                    for (int n = 0; n < 2; ++n) acc[a][b][m][n] = (f32x4){0.f, 0.f, 0.f, 0.f};
        cur = nxt; cA = nA; cB = nB; ++ui;
        if constexpr (ALIGN_EPI) { if (wr == 1) PG8_BAR; }
    }
    PG8_WAIT_V(0);
    if constexpr (!ALIGN_EPI) { if (wr == 0) PG8_BAR; }
    PG8_BAR;
    if constexpr (Epi::AFTER_DRAIN) { E.fused(acc, cur, wr, wc, fr, fq, lds, wid, lane); S.done(cur); }
#undef PG8_SA
#undef PG8_SB
#undef PG8_STAGE
#undef PG8_LDA
#undef PG8_LDB
#undef PG8_MMA
#undef PG8_WAIT_V
#undef PG8_WAIT_L
#undef PG8_BAR
#undef PG8_SCHED
}
}

#define LAS __attribute__((address_space(3)))
typedef unsigned short bf16_t;
typedef short bf16x8 __attribute__((ext_vector_type(8)));
typedef float f32x4 __attribute__((ext_vector_type(4)));
typedef float f32x16 __attribute__((ext_vector_type(16)));
typedef float f32x8 __attribute__((ext_vector_type(8)));
typedef unsigned u32x4 __attribute__((ext_vector_type(4)));
typedef unsigned u32x2 __attribute__((ext_vector_type(2)));
typedef float f32x2_t __attribute__((ext_vector_type(2)));
typedef __bf16 bf16x2_t __attribute__((ext_vector_type(2)));

constexpr int NB = 4, SEQ = 4096, DM = 1024, MTOK = NB * SEQ, DIN = 7728, NPAD = 7936, DFF = 4096;
constexpr float QSCALE = 0.125f * 1.4426950408889634f;
constexpr float EPS = 1e-6f;
constexpr int NTHREADS = 512, NWAVES = 8;

constexpr size_t MiB = 1u << 20;
constexpr size_t WS_CTL = 0, CTL_BYTES = 65536;
constexpr int CW_BAR = 4096;
constexpr size_t WS_COS = 1 * MiB, WS_SIN = WS_COS + 4096 * 32 * 4, WS_CCOS = WS_SIN + 4096 * 32 * 4, WS_CSIN = WS_CCOS + 256 * 32 * 4;
constexpr size_t WS_PB = 3 * MiB;
constexpr size_t WS_W2T = 3 * MiB + 65536;
constexpr size_t WS_W1T = 4 * MiB;
constexpr size_t WS_WPD = 6 * MiB, WS_WPN = 8 * MiB, WS_WOUT = 10 * MiB, WS_WUP = 12 * MiB, WS_WDN = 20 * MiB, WS_WIN = 28 * MiB;
constexpr size_t WS_XN = 45 * MiB;
constexpr size_t WS_HID = WS_XN, WS_KCMP = WS_XN + 4 * MiB, WS_VCMPT = WS_XN + 5 * MiB, WS_MIXED = WS_XN;
constexpr size_t WS_DQ = 77 * MiB, WS_DK = 109 * MiB, WS_DVT = 141 * MiB, WS_NQ = 173 * MiB;
constexpr size_t WS_KC = 205 * MiB, WS_VC = 213 * MiB, WS_KSL = 221 * MiB, WS_KWN = 229 * MiB, WS_VSLT = 237 * MiB, WS_VWNT = 245 * MiB, WS_NG = 253 * MiB;
constexpr size_t WS_T1 = WS_DK;
constexpr size_t WS_XB1 = WS_KC;
constexpr size_t WS_PART = WS_NG;
constexpr size_t WS_HB = WS_DQ;
constexpr size_t WS_END = 256 * MiB;

constexpr int LDS_BYTES = 151552;
constexpr int TROW = 72;
constexpr int ABUF = 64 * TROW * 2 + 128 * TROW * 2;
constexpr int L_O0P = 83968;
constexpr int L_CK = 57344, CKROW = 72;
constexpr int L_CV = L_CK + 256 * CKROW * 2, CVROW = 264;
constexpr int L_IMP = L_CV + 64 * CVROW * 2;
constexpr int L_SEL = L_IMP + 16384;
constexpr int L_SLOT = 149504;
static_assert(L_SEL + 512 <= L_SLOT && L_O0P + 65536 <= L_SLOT && 3 * ABUF <= L_O0P && 3 * (128 * TROW * 2) <= L_CK, "lds map 2");
static_assert(L_SLOT + 64 <= LDS_BYTES, "lds map");

struct Params { const float* in[24]; float* out; unsigned char* ws; double invfreq[32]; int ph_lo, ph_hi, dup, pad; };

__device__ __forceinline__ unsigned cvtpk(float lo, float hi) { f32x2_t v = {lo, hi}; bf16x2_t b = __builtin_convertvector(v, bf16x2_t); return __builtin_bit_cast(unsigned, b); }
__device__ __forceinline__ bf16_t f2bf(float f) { return (bf16_t)(cvtpk(f, 0.f) & 0xffffu); }
__device__ __forceinline__ int crow(int r, int hi) { return (r & 3) + 8 * (r >> 2) + 4 * hi; }
__device__ __forceinline__ int perm16(int t) { return (t & ~12) | ((t & 4) << 1) | ((t & 8) >> 1); }
__device__ __forceinline__ float wave_sum(float v) {
#pragma unroll
    for (int o = 1; o < 64; o <<= 1) v += __shfl_xor(v, o);
    return v;
}
__device__ __forceinline__ float sigmoidf_(float v) { return __builtin_amdgcn_rcpf(1.0f + __expf(-v)); }
__device__ __forceinline__ float gelu_tanh(float x) { const float u = 0.7978845608028654f * (x + 0.044715f * x * x * x); return x * __builtin_amdgcn_rcpf(1.0f + __expf(-2.0f * u)); }

__device__ __forceinline__ void tr_item(const float* W, int ldw, int col0, int nvalid, const float* kscale, bf16_t* WT, int ldt, int row0, int k0, LAS float* scr, int lane) {
    const int cl = lane & 31;
#pragma unroll
    for (int i = 0; i < 32; ++i) { const int kk = 2 * i + (lane >> 5); float v = 0.f; if (cl < nvalid) { v = __builtin_nontemporal_load(W + (size_t)(k0 + kk) * ldw + col0 + cl); if (kscale) v *= kscale[k0 + kk]; } scr[kk * 33 + cl] = v; }
    asm volatile("s_waitcnt lgkmcnt(0)" ::: "memory");
    const int c = lane & 7;
#pragma unroll
    for (int j = 0; j < 4; ++j) { const int n = (lane >> 3) + 8 * j; const LAS float* s = scr + (8 * c) * 33 + n;
        u32x4 o; o.x = cvtpk(s[0 * 33], s[1 * 33]); o.y = cvtpk(s[2 * 33], s[3 * 33]); o.z = cvtpk(s[4 * 33], s[5 * 33]); o.w = cvtpk(s[6 * 33], s[7 * 33]);
        *(u32x4*)(WT + (size_t)(row0 + n) * ldt + k0 + 8 * c) = o; }
    asm volatile("s_waitcnt lgkmcnt(0)" ::: "memory");
}
__device__ __forceinline__ void tr_plain(const float* W, int K, int N, const float* kscale, bf16_t* WT, LAS float* scr, int item, int lane) {
    const int nblk = N / 32, kb = item / nblk, nb = item % nblk;
    tr_item(W, N, 32 * nb, 32, kscale, WT, K, 32 * nb, 64 * kb, scr, lane);
}
__device__ __forceinline__ void sincos_d(double ang, float& s, float& c) {
    const double k = rint(ang * 0.15915494309189535);
    double r = fma(-k, 6.283185307179586, ang); r = fma(-k, 2.4492935982947064e-16, r);
    const double r2 = r * r; double ts = r, tc = 1.0, ss = r, cs = 1.0;
#pragma unroll
    for (int n = 1; n <= 14; ++n) { tc *= -r2 * (1.0 / ((2.0 * n - 1.0) * (2.0 * n))); cs += tc; ts *= -r2 * (1.0 / ((2.0 * n) * (2.0 * n + 1.0))); ss += ts; }
    s = (float)ss; c = (float)cs;
}

__device__ __forceinline__ void late_weight_item(const Params& P, LAS unsigned char* lds, int item) {
    const int tid = threadIdx.x, lane = tid & 63, wave = tid >> 6;
    LAS float* scr = (LAS float*)(lds + wave * 16384);
    unsigned char* ws = P.ws;
    int it = item * NWAVES + wave;
    if (it < 512) { tr_plain(P.in[18], 1024, 1024, nullptr, (bf16_t*)(ws + WS_WPD), scr, it, lane); return; } it -= 512;
    if (it < 512) { tr_plain(P.in[19], 1024, 1024, nullptr, (bf16_t*)(ws + WS_WPN), scr, it, lane); return; } it -= 512;
    if (it < 512) { tr_plain(P.in[20], 1024, 1024, nullptr, (bf16_t*)(ws + WS_WOUT), scr, it, lane); return; } it -= 512;
    if (it < 2048) { tr_plain(P.in[22], 1024, 4096, P.in[21], (bf16_t*)(ws + WS_WUP), scr, it, lane); return; } it -= 2048;
    tr_plain(P.in[23], 4096, 1024, nullptr, (bf16_t*)(ws + WS_WDN), scr, it, lane);
}
__device__ __forceinline__ void p0_prologue(const Params& P, LAS unsigned char* lds, int vb, int G) {
    const int tid = threadIdx.x, lane = tid & 63, wave = tid >> 6;
    LAS float* scr = (LAS float*)(lds + wave * 16384);
    const int gw = vb * NWAVES + wave, NGW = G * NWAVES;
    unsigned char* ws = P.ws;
    for (int it = gw; it < 16 * 248; it += NGW) {
        const int kb = it / 248, nb = it % 248, n0 = 32 * nb, pn = n0 >> 8, p = n0 & 255, bj = p >> 7, wc = (p >> 5) & 3, L0 = 64 * wc + 32 * bj;
        const int srcbase = pn < 22 ? 256 * pn : (pn < 30 ? 5680 + 256 * (pn - 22) : 5632), tv = pn < 30 ? 256 : 48;
        int nv = tv - L0; nv = nv < 0 ? 0 : (nv > 32 ? 32 : nv);
        tr_item(P.in[2], DIN, srcbase + L0, nv, nullptr, (bf16_t*)(ws + WS_WIN), 1024, n0, 64 * kb, scr, lane);
    }
    for (int it = gw; it < 32 * 8; it += NGW) tr_plain(P.in[14], 2048, 256, nullptr, (bf16_t*)(ws + WS_W1T), scr, it, lane);
    for (int it = gw; it < 32 * 8; it += NGW) tr_plain(P.in[16], 2048, 256, nullptr, (bf16_t*)(ws + WS_W1T) + 256 * 2048, scr, it, lane);
    for (int it = gw; it < 4 * 2; it += NGW) tr_plain(P.in[15], 256, 64, nullptr, (bf16_t*)(ws + WS_W2T), scr, it, lane);
    for (int it = gw; it < 4 * 2; it += NGW) tr_plain(P.in[17], 256, 64, nullptr, (bf16_t*)(ws + WS_W2T) + 64 * 256, scr, it, lane);
    for (int it = NGW - 1 - gw; it < 128; it += NGW) {
        const int which = it >> 6, kc = (it >> 2) & 15, j = 64 * (it & 3) + lane; const float* pos = P.in[which ? 13 : 12] + 128 * kc; const float* W1 = P.in[which ? 16 : 14] + (size_t)128 * kc * 256;
        float a0 = 0.f, a1 = 0.f, a2 = 0.f, a3 = 0.f;
#pragma unroll 4
        for (int k = 0; k < 128; k += 4) { a0 += pos[k] * W1[(size_t)k * 256 + j]; a1 += pos[k + 1] * W1[(size_t)(k + 1) * 256 + j]; a2 += pos[k + 2] * W1[(size_t)(k + 2) * 256 + j]; a3 += pos[k + 3] * W1[(size_t)(k + 3) * 256 + j]; }
        ((float*)(ws + WS_PB))[(which * 16 + kc) * 256 + j] = (a0 + a1) + (a2 + a3);
    }
    for (int idx = vb * NTHREADS + tid; idx < (4096 + 256) * 32; idx += G * NTHREADS) {
        const int i = idx & 31, p = idx >> 5; float s, c;
        if (p < 4096) { sincos_d((double)p * P.invfreq[i], s, c); ((float*)(ws + WS_COS))[p * 32 + i] = c; ((float*)(ws + WS_SIN))[p * 32 + i] = s; }
        else { const int n = p - 4096; sincos_d(((double)n * 16.0 + 15.5) * P.invfreq[i], s, c); ((float*)(ws + WS_CCOS))[n * 32 + i] = c; ((float*)(ws + WS_CSIN))[n * 32 + i] = s; }
    }
    const float* x = P.in[0]; const float* g = P.in[1]; bf16_t* XN = (bf16_t*)(ws + WS_XN);
    f32x4 gv[4];
#pragma unroll
    for (int j = 0; j < 4; ++j) gv[j] = ((const f32x4*)g)[lane + 64 * j];
    for (int m0 = gw; m0 < MTOK; m0 += 8 * NGW) {
        f32x4 v[8][4];
#pragma unroll
        for (int r = 0; r < 8; ++r) { const int m = m0 + r * NGW; if (m < MTOK) { const f32x4* xr = (const f32x4*)(x + (size_t)m * DM) + lane;
#pragma unroll
            for (int j = 0; j < 4; ++j) v[r][j] = __builtin_nontemporal_load(xr + 64 * j); } }
#pragma unroll
        for (int r = 0; r < 8; ++r) { const int m = m0 + r * NGW; if (m < MTOK) { float s = 0.f;
#pragma unroll
            for (int j = 0; j < 4; ++j) s += (v[r][j].x * v[r][j].x + v[r][j].y * v[r][j].y) + (v[r][j].z * v[r][j].z + v[r][j].w * v[r][j].w);
            const float rstd = rsqrtf(wave_sum(s) * (1.f / DM) + EPS);
            u32x2* o8 = (u32x2*)(XN + (size_t)m * DM) + lane;
#pragma unroll
            for (int j = 0; j < 4; ++j) { const f32x4 y = v[r][j] * rstd * gv[j]; u32x2 w; w.x = cvtpk(y.x, y.y); w.y = cvtpk(y.z, y.w); o8[64 * j] = w; } } }
    }
}

struct EpiProj {
    static constexpr bool PERM = true, AFTER_DRAIN = false;
    unsigned char* ws; const float *gq, *gk, *gnq, *gnk;
    __device__ __forceinline__ void operator()(const f32x4 (&acc)[2][2][4][2], const pg8::Unit& u, int wr, int wc, int fr, int fq) const {
        const int pn = u.pn; const int row0 = u.pm * 256 + wr * 64 + fr;
        int type, ld = 1024, cb = 0; bf16_t* dst = nullptr; const float* gain = nullptr; float qs = 1.f;
        if (pn < 4) { type = 0; dst = (bf16_t*)(ws + WS_DQ); cb = 256 * pn; gain = gq; qs = QSCALE; }
        else if (pn < 8) { type = 0; dst = (bf16_t*)(ws + WS_DK); cb = 256 * (pn - 4); gain = gk; }
        else if (pn < 12) { type = 2; dst = (bf16_t*)(ws + WS_DVT); }
        else if (pn < 16) { type = 0; dst = (bf16_t*)(ws + WS_NQ); cb = 256 * (pn - 12); gain = gnq; qs = QSCALE; }
        else if (pn == 16) { type = 1; dst = (bf16_t*)(ws + WS_KC); ld = 256; }
        else if (pn == 17) { type = 1; dst = (bf16_t*)(ws + WS_VC); ld = 256; }
        else if (pn == 18) { type = 0; dst = (bf16_t*)(ws + WS_KSL); ld = 256; gain = gnk + 64; }
        else if (pn == 19) { type = 2; dst = (bf16_t*)(ws + WS_VSLT); }
        else if (pn == 20) { type = 0; dst = (bf16_t*)(ws + WS_KWN); ld = 256; gain = gnk + 128; }
        else if (pn == 21) { type = 2; dst = (bf16_t*)(ws + WS_VWNT); }
        else if (pn < 30) { type = 3; dst = (bf16_t*)P_MG(); ld = 2048; cb = 256 * (pn - 22); }
        else { type = 4; }
        const int lc = 64 * wc + 8 * fq;
        if (type == 0) {
            const float* COS = (const float*)(ws + WS_COS); const float* SIN = (const float*)(ws + WS_SIN);
            f32x4 g1[2], g2[2];
#pragma unroll
            for (int n = 0; n < 2; ++n) { g1[n] = *(const f32x4*)(gain + 8 * fq + 4 * n); g2[n] = *(const f32x4*)(gain + 32 + 8 * fq + 4 * n); }
#pragma unroll
            for (int ai = 0; ai < 2; ++ai)
#pragma unroll
                for (int m = 0; m < 4; ++m) {
                    const int row = row0 + ai * 128 + m * 16, pos = row & (SEQ - 1);
                    float ss = 0.f;
#pragma unroll
                    for (int bj = 0; bj < 2; ++bj)
#pragma unroll
                        for (int n = 0; n < 2; ++n) { const f32x4 v = acc[ai][bj][m][n]; ss += (v.x * v.x + v.y * v.y) + (v.z * v.z + v.w * v.w); }
                    ss += __shfl_xor(ss, 16); ss += __shfl_xor(ss, 32);
                    const float rstd = rsqrtf(ss * (1.f / 64.f) + EPS);
                    f32x4 o1[2], o2[2];
#pragma unroll
                    for (int n = 0; n < 2; ++n) {
                        const f32x4 c4 = *(const f32x4*)(COS + pos * 32 + 8 * fq + 4 * n), s4 = *(const f32x4*)(SIN + pos * 32 + 8 * fq + 4 * n);
                        const f32x4 x1 = acc[ai][0][m][n] * rstd * g1[n], x2 = acc[ai][1][m][n] * rstd * g2[n];
                        o1[n] = (x1 * c4 - x2 * s4) * qs; o2[n] = (x2 * c4 + x1 * s4) * qs;
                    }
                    bf16_t* rp = dst + (size_t)row * ld + cb + lc;
                    u32x4 w; w.x = cvtpk(o1[0].x, o1[0].y); w.y = cvtpk(o1[0].z, o1[0].w); w.z = cvtpk(o1[1].x, o1[1].y); w.w = cvtpk(o1[1].z, o1[1].w); *(u32x4*)rp = w;
                    w.x = cvtpk(o2[0].x, o2[0].y); w.y = cvtpk(o2[0].z, o2[0].w); w.z = cvtpk(o2[1].x, o2[1].y); w.w = cvtpk(o2[1].z, o2[1].w); *(u32x4*)(rp + 32) = w;
                }
        } else if (type == 1 || type == 3) {
#pragma unroll
            for (int ai = 0; ai < 2; ++ai)
#pragma unroll
                for (int m = 0; m < 4; ++m) {
                    const int row = row0 + ai * 128 + m * 16; bf16_t* rp = dst + (size_t)row * ld + cb + lc;
#pragma unroll
                    for (int bj = 0; bj < 2; ++bj) {
                        f32x4 a = acc[ai][bj][m][0], b = acc[ai][bj][m][1];
                        if (type == 3) { a.x = sigmoidf_(a.x); a.y = sigmoidf_(a.y); a.z = sigmoidf_(a.z); a.w = sigmoidf_(a.w); b.x = sigmoidf_(b.x); b.y = sigmoidf_(b.y); b.z = sigmoidf_(b.z); b.w = sigmoidf_(b.w); }
                        u32x4 w; w.x = cvtpk(a.x, a.y); w.y = cvtpk(a.z, a.w); w.z = cvtpk(b.x, b.y); w.w = cvtpk(b.z, b.w); *(u32x4*)(rp + 32 * bj) = w;
                    }
                }
        } else if (type == 2) {
            int nh, dv, vh, dbase;
            if (pn < 12) { nh = 8; dv = 128; vh = 2 * (pn - 8) + (wc >> 1); dbase = 64 * (wc & 1); } else { nh = 4; dv = 64; vh = wc; dbase = 0; }
#pragma unroll
            for (int ai = 0; ai < 2; ++ai)
#pragma unroll
                for (int m = 0; m < 4; ++m) {
                    const int row = row0 + ai * 128 + m * 16, b = row >> 12, t = row & (SEQ - 1);
                    bf16_t* bp = dst + ((size_t)(b * nh + vh) * dv + dbase + 8 * fq) * SEQ + perm16(t);
#pragma unroll
                    for (int bj = 0; bj < 2; ++bj)
#pragma unroll
                        for (int n = 0; n < 2; ++n) { const f32x4 v = acc[ai][bj][m][n]; bf16_t* q = bp + (size_t)(32 * bj + 4 * n) * SEQ;
                            q[0] = f2bf(v.x); q[SEQ] = f2bf(v.y); q[2 * SEQ] = f2bf(v.z); q[3 * SEQ] = f2bf(v.w); }
                }
        } else {
            float* NG = (float*)(ws + WS_NG);
            if (wc == 0) {
#pragma unroll
                for (int ai = 0; ai < 2; ++ai)
#pragma unroll
                    for (int m = 0; m < 4; ++m) {
                        const int row = row0 + ai * 128 + m * 16;
#pragma unroll
                        for (int bj = 0; bj < 2; ++bj)
#pragma unroll
                            for (int n = 0; n < 2; ++n) { const int L = 32 * bj + 8 * fq + 4 * n; if (L < 48) { const f32x4 v = acc[ai][bj][m][n];
                                f32x4 o; o.x = sigmoidf_(v.x); o.y = sigmoidf_(v.y); o.z = sigmoidf_(v.z); o.w = sigmoidf_(v.w); *(f32x4*)(NG + (size_t)row * 48 + L) = o; } }
                    }
            }
        }
    }
    unsigned char* mgp;
    __device__ __forceinline__ unsigned char* P_MG() const { return mgp; }
};
struct EpiHid {
    static constexpr bool PERM = true, AFTER_DRAIN = false;
    bf16_t* HID; const LAS float* pb;
    __device__ __forceinline__ void operator()(const f32x4 (&acc)[2][2][4][2], const pg8::Unit& u, int wr, int wc, int fr, int fq) const {
        const int row0 = u.pm * 256 + wr * 64 + fr, col0 = wc * 32 + 8 * fq;
#pragma unroll
        for (int ai = 0; ai < 2; ++ai)
#pragma unroll
            for (int m = 0; m < 4; ++m) { bf16_t* rp = HID + (size_t)(row0 + ai * 128 + m * 16) * 256 + col0;
#pragma unroll
                for (int bj = 0; bj < 2; ++bj) { const f32x4 b0 = *(const LAS f32x4*)(pb + col0 + 128 * bj), b1 = *(const LAS f32x4*)(pb + col0 + 128 * bj + 4);
                    const f32x4 a = acc[ai][bj][m][0] + b0, b = acc[ai][bj][m][1] + b1;
                    u32x4 w; w.x = cvtpk(gelu_tanh(a.x), gelu_tanh(a.y)); w.y = cvtpk(gelu_tanh(a.z), gelu_tanh(a.w)); w.z = cvtpk(gelu_tanh(b.x), gelu_tanh(b.y)); w.w = cvtpk(gelu_tanh(b.z), gelu_tanh(b.w));
                    *(u32x4*)(rp + 128 * bj) = w; asm volatile("" ::: "memory"); } }
    }
};
template <int MODE> struct EpiMerge {
    static constexpr bool PERM = false, AFTER_DRAIN = false;
    const bf16_t* MG; float* T1; bf16_t* MIXED;
    __device__ __forceinline__ void operator()(const f32x4 (&acc)[2][2][4][2], const pg8::Unit& u, int wr, int wc, int fr, int fq) const {
        const int row0 = u.pm * 256 + wr * 64 + fr, col0 = u.pn * 256 + wc * 32 + 4 * fq;
#pragma unroll
        for (int ai = 0; ai < 2; ++ai)
#pragma unroll
            for (int m = 0; m < 4; ++m) { const size_t row = row0 + ai * 128 + m * 16;
#pragma unroll
                for (int bj = 0; bj < 2; ++bj)
#pragma unroll
                    for (int n = 0; n < 2; ++n) { const int col = col0 + 128 * bj + 16 * n;
                        const u32x2 gw = *(const u32x2*)(MG + row * 2048 + MODE * 1024 + col);
                        f32x4 gt; gt.x = __uint_as_float(gw.x << 16); gt.y = __uint_as_float(gw.x & 0xffff0000u); gt.z = __uint_as_float(gw.y << 16); gt.w = __uint_as_float(gw.y & 0xffff0000u);
                        if (MODE == 0) { const f32x4 v = gt * acc[ai][bj][m][n]; u32x2 w; w.x = cvtpk(v.x, v.y); w.y = cvtpk(v.z, v.w); *(u32x2*)(MIXED + row * 1024 + col) = w; }
                        else { const u32x2 tw = *(const u32x2*)(MIXED + row * 1024 + col); f32x4 t1; t1.x = __uint_as_float(tw.x << 16); t1.y = __uint_as_float(tw.x & 0xffff0000u); t1.z = __uint_as_float(tw.y << 16); t1.w = __uint_as_float(tw.y & 0xffff0000u); const f32x4 v = t1 + gt * acc[ai][bj][m][n]; u32x2 w; w.x = cvtpk(v.x, v.y); w.y = cvtpk(v.z, v.w); *(u32x2*)(MIXED + row * 1024 + col) = w; }
                    } }
    }
};
struct EpiMerge2 {
    static constexpr bool PERM = false, AFTER_DRAIN = false;
    const bf16_t* MG; bf16_t* MIXED;
    template <int W> __device__ __forceinline__ void run(const f32x4 (&acc)[2][2][4][2], const pg8::Unit& u, int wr, int wc, int fr, int fq) const {
        const int row0 = (u.pm & 63) * 256 + wr * 64 + fr, col0 = (u.pn & 3) * 256 + wc * 32 + 4 * fq;
#pragma unroll
        for (int ai = 0; ai < 2; ++ai) {
            u32x2 gwv[4][2][2], twv[4][2][2];
#pragma unroll
            for (int m = 0; m < 4; ++m)
#pragma unroll
                for (int bj = 0; bj < 2; ++bj)
#pragma unroll
                    for (int n = 0; n < 2; ++n) { const size_t row = row0 + ai * 128 + m * 16; const int col = col0 + 128 * bj + 16 * n;
                        gwv[m][bj][n] = *(const u32x2*)(MG + row * 2048 + W * 1024 + col);
                        if (W) twv[m][bj][n] = *(const u32x2*)(MIXED + row * 1024 + col); }
            asm volatile("" ::: "memory");
#pragma unroll
            for (int m = 0; m < 4; ++m)
#pragma unroll
                for (int bj = 0; bj < 2; ++bj)
#pragma unroll
                    for (int n = 0; n < 2; ++n) { const size_t row = row0 + ai * 128 + m * 16; const int col = col0 + 128 * bj + 16 * n; const u32x2 gw = gwv[m][bj][n];
                        f32x4 gt; gt.x = __uint_as_float(gw.x << 16); gt.y = __uint_as_float(gw.x & 0xffff0000u); gt.z = __uint_as_float(gw.y << 16); gt.w = __uint_as_float(gw.y & 0xffff0000u);
                        f32x4 v = gt * acc[ai][bj][m][n];
                        if (W) { const u32x2 tw = twv[m][bj][n]; f32x4 t1; t1.x = __uint_as_float(tw.x << 16); t1.y = __uint_as_float(tw.x & 0xffff0000u); t1.z = __uint_as_float(tw.y << 16); t1.w = __uint_as_float(tw.y & 0xffff0000u); v = v + t1; }
                        u32x2 wv; wv.x = cvtpk(v.x, v.y); wv.y = cvtpk(v.z, v.w); *(u32x2*)(MIXED + row * 1024 + col) = wv; }
            asm volatile("" ::: "memory");
        }
    }
    __device__ __forceinline__ void operator()(const f32x4 (&acc)[2][2][4][2], const pg8::Unit& u, int wr, int wc, int fr, int fq) const {
        if ((u.pm >> 6) == 0) run<0>(acc, u, wr, wc, fr, fq); else run<1>(acc, u, wr, wc, fr, fq);
    }
};
struct TwoSched {
    pg8::StaticOrder S;
    __device__ __forceinline__ bool next(int i, pg8::Unit& u) const { pg8::Unit b; if (!S.next(i >> 1, b)) return false; const int w = i & 1; u.pm = b.pm + 64 * w; u.pn = b.pn + 4 * w; return true; }
    __device__ __forceinline__ void a_ready(const pg8::Unit&) const {}
    __device__ __forceinline__ void done(const pg8::Unit&) const {}
};
struct EpiRes1 {
    static constexpr bool PERM = false, AFTER_DRAIN = false;
    const float* x; float* out; bf16_t* XB1; float* PART;
    __device__ __forceinline__ void operator()(const f32x4 (&acc)[2][2][4][2], const pg8::Unit& u, int wr, int wc, int fr, int fq) const {
        const int row0 = u.pm * 256 + wr * 64 + fr, col0 = u.pn * 256 + wc * 32 + 4 * fq;
#pragma unroll
        for (int ai = 0; ai < 2; ++ai) {
            f32x4 xv[4][2][2];
#pragma unroll
            for (int m = 0; m < 4; ++m)
#pragma unroll
                for (int bj = 0; bj < 2; ++bj)
#pragma unroll
                    for (int n = 0; n < 2; ++n) xv[m][bj][n] = *(const f32x4*)(x + (size_t)(row0 + ai * 128 + m * 16) * 1024 + col0 + 128 * bj + 16 * n);
            asm volatile("" ::: "memory");
#pragma unroll
            for (int m = 0; m < 4; ++m) { const size_t row = row0 + ai * 128 + m * 16; float ss = 0.f;
#pragma unroll
                for (int bj = 0; bj < 2; ++bj)
#pragma unroll
                    for (int n = 0; n < 2; ++n) { const int col = col0 + 128 * bj + 16 * n;
                        const f32x4 v = xv[m][bj][n] + acc[ai][bj][m][n];
                        u32x2 w; w.x = cvtpk(v.x, v.y); w.y = cvtpk(v.z, v.w); *(u32x2*)(XB1 + row * 1024 + col) = w;
                        ss += (v.x * v.x + v.y * v.y) + (v.z * v.z + v.w * v.w); }
                ss += __shfl_xor(ss, 16); ss += __shfl_xor(ss, 32);
                if (fq == 0) PART[row * 16 + u.pn * 4 + wc] = ss; }
            asm volatile("" ::: "memory");
        }
    }
};
struct EpiUp {
    static constexpr bool PERM = true, AFTER_DRAIN = false;
    const float* PART; bf16_t* HB;
    __device__ __forceinline__ void operator()(const f32x4 (&acc)[2][2][4][2], const pg8::Unit& u, int wr, int wc, int fr, int fq) const {
        const int row0 = u.pm * 256 + wr * 64 + fr, col0 = u.pn * 256 + wc * 32 + 8 * fq;
#pragma unroll
        for (int ai = 0; ai < 2; ++ai)
#pragma unroll
            for (int m = 0; m < 4; ++m) { const size_t row = row0 + ai * 128 + m * 16;
                const f32x4* pp = (const f32x4*)(PART + row * 16); const f32x4 p0 = pp[0], p1 = pp[1], p2 = pp[2], p3 = pp[3];
                const float ss = ((p0.x + p0.y) + (p0.z + p0.w)) + ((p1.x + p1.y) + (p1.z + p1.w)) + ((p2.x + p2.y) + (p2.z + p2.w)) + ((p3.x + p3.y) + (p3.z + p3.w));
                const float rstd = rsqrtf(ss * (1.f / 1024.f) + EPS);
#pragma unroll
                for (int bj = 0; bj < 2; ++bj) { f32x4 a = acc[ai][bj][m][0] * rstd, b = acc[ai][bj][m][1] * rstd;
                    a.x = fmaxf(a.x, 0.f); a.y = fmaxf(a.y, 0.f); a.z = fmaxf(a.z, 0.f); a.w = fmaxf(a.w, 0.f); b.x = fmaxf(b.x, 0.f); b.y = fmaxf(b.y, 0.f); b.z = fmaxf(b.z, 0.f); b.w = fmaxf(b.w, 0.f);
                    a = a * a; b = b * b;
                    u32x4 w; w.x = cvtpk(a.x, a.y); w.y = cvtpk(a.z, a.w); w.z = cvtpk(b.x, b.y); w.w = cvtpk(b.z, b.w); *(u32x4*)(HB + row * 4096 + col0 + 128 * bj) = w; } }
    }
};
struct EpiRes2 {
    static constexpr bool PERM = false, AFTER_DRAIN = false;
    float* out; float scale; const bf16_t* XB1;
    __device__ __forceinline__ void operator()(const f32x4 (&acc)[2][2][4][2], const pg8::Unit& u, int wr, int wc, int fr, int fq) const {
        const int row0 = u.pm * 256 + wr * 64 + fr, col0 = u.pn * 256 + wc * 32 + 4 * fq;
#pragma unroll
        for (int ai = 0; ai < 2; ++ai) {
            u32x2 xw[4][2][2];
#pragma unroll
            for (int m = 0; m < 4; ++m)
#pragma unroll
                for (int bj = 0; bj < 2; ++bj)
#pragma unroll
                    for (int n = 0; n < 2; ++n) xw[m][bj][n] = *(const u32x2*)(XB1 + (size_t)(row0 + ai * 128 + m * 16) * 1024 + col0 + 128 * bj + 16 * n);
            asm volatile("" ::: "memory");
#pragma unroll
            for (int m = 0; m < 4; ++m)
#pragma unroll
                for (int bj = 0; bj < 2; ++bj)
#pragma unroll
                    for (int n = 0; n < 2; ++n) { const size_t off = (size_t)(row0 + ai * 128 + m * 16) * 1024 + col0 + 128 * bj + 16 * n; const u32x2 w = xw[m][bj][n];
                        f32x4 x1; x1.x = __uint_as_float(w.x << 16); x1.y = __uint_as_float(w.x & 0xffff0000u); x1.z = __uint_as_float(w.y << 16); x1.w = __uint_as_float(w.y & 0xffff0000u);
                        *(f32x4*)(out + off) = x1 + acc[ai][bj][m][n] * scale; }
            asm volatile("" ::: "memory");
        }
    }
};
struct OneUnit {
    int pm, pn;
    __device__ bool next(int i, pg8::Unit& u) const { if (i > 0) return false; u.pm = pm; u.pn = pn; return true; }
    __device__ __forceinline__ void a_ready(const pg8::Unit&) const {}
    __device__ __forceinline__ void done(const pg8::Unit&) const {}
};

#define MFMA32(a, b, c) __builtin_amdgcn_mfma_f32_32x32x16_bf16((a), (b), (c), 0, 0, 0)
#define EXP2(x) __builtin_amdgcn_exp2f(x)

__device__ __forceinline__ void load_q(const bf16_t* qrow, int hi, bf16x8 (&qf)[4]) {
#pragma unroll
    for (int ds = 0; ds < 4; ++ds) qf[ds] = *(const bf16x8*)(qrow + 16 * ds + 8 * hi);
    asm volatile("" : "+v"(qf[0]), "+v"(qf[1]), "+v"(qf[2]), "+v"(qf[3]));
}
template <int KROW>
__device__ __forceinline__ void qk_tile(const LAS bf16_t* Kt, const bf16x8 (&qf)[4], f32x16 (&s)[2], int r32, int hi) {
#pragma unroll
    for (int kb = 0; kb < 2; ++kb) {
        f32x16 a = {};
#pragma unroll
        for (int ds = 0; ds < 4; ++ds) { const bf16x8 kf = *(const LAS bf16x8*)(Kt + (32 * kb + r32) * KROW + 16 * ds + 8 * hi); a = MFMA32(kf, qf[ds], a); }
        s[kb] = a;
    }
}
template <int DV, int VROW>
__device__ __forceinline__ void pv_tile(const LAS bf16_t* Vt, const f32x16 (&p)[2], f32x16 (&o)[DV / 32], int r32, int hi) {
    bf16x8 pb[4];
#pragma unroll
    for (int j = 0; j < 4; ++j) { const int kb = j >> 1, r0 = 8 * (j & 1); u32x4 w; w.x = cvtpk(p[kb][r0], p[kb][r0 + 1]); w.y = cvtpk(p[kb][r0 + 2], p[kb][r0 + 3]); w.z = cvtpk(p[kb][r0 + 4], p[kb][r0 + 5]); w.w = cvtpk(p[kb][r0 + 6], p[kb][r0 + 7]); pb[j] = __builtin_bit_cast(bf16x8, w); }
#pragma unroll
    for (int db = 0; db < DV / 32; ++db) {
        bf16x8 vf[4];
#pragma unroll
        for (int j = 0; j < 4; ++j) vf[j] = *(const LAS bf16x8*)(Vt + (32 * db + r32) * VROW + 16 * j + 8 * hi);
#pragma unroll
        for (int j = 0; j < 4; ++j) o[db] = MFMA32(vf[j], pb[j], o[db]);
        __builtin_amdgcn_sched_barrier(0);
    }
}
template <int DV, class TF>
__device__ __forceinline__ void attn_loop(LAS unsigned char* lds, const bf16_t* Kg, int ldk, const bf16_t* VTg, int ldv, unsigned long long tmask,
                                          const bf16x8 (&qf)[4], f32x16 (&o)[DV / 32], float& m, float& l, const TF& tf) {
    const int tid = threadIdx.x, lane = tid & 63, r32 = lane & 31, hi = lane >> 5, srow = tid >> 3, sch = tid & 7;
    u32x4 kreg, vreg[DV / 64];
    int buf = 0;
    if (tmask) { const int t = __builtin_ctzll(tmask); kreg = *(const u32x4*)(Kg + (size_t)(64 * t + srow) * ldk + sch * 8);
#pragma unroll
        for (int i = 0; i < DV / 64; ++i) vreg[i] = *(const u32x4*)(VTg + (size_t)(srow + 64 * i) * ldv + 64 * t + sch * 8); }
    while (tmask) {
        const int t = __builtin_ctzll(tmask); tmask &= tmask - 1;
        LAS bf16_t* Kt = (LAS bf16_t*)(lds + buf * ABUF); LAS bf16_t* Vt = Kt + 64 * TROW;
        *(LAS u32x4*)(Kt + srow * TROW + sch * 8) = kreg;
#pragma unroll
        for (int i = 0; i < DV / 64; ++i) *(LAS u32x4*)(Vt + (srow + 64 * i) * TROW + sch * 8) = vreg[i];
        __syncthreads();
        if (tmask) { const int tn = __builtin_ctzll(tmask); kreg = *(const u32x4*)(Kg + (size_t)(64 * tn + srow) * ldk + sch * 8);
#pragma unroll
            for (int i = 0; i < DV / 64; ++i) vreg[i] = *(const u32x4*)(VTg + (size_t)(srow + 64 * i) * ldv + 64 * tn + sch * 8); }
        const int md = tf.mode(t);
        if (md) {
            f32x16 s[2];
            qk_tile<TROW>(Kt, qf, s, r32, hi);
            if (md == 2) {
                const int lim_hi = tf.lim_hi(t), lim_lo = tf.lim_lo(t);
#pragma unroll
                for (int kb = 0; kb < 2; ++kb)
#pragma unroll
                    for (int r = 0; r < 16; ++r) { const int kc_ = 32 * kb + (r & 3) + 8 * (r >> 2); if (kc_ > lim_hi || kc_ < lim_lo) s[kb][r] = -INFINITY; }
            }
            float mx = fmaxf(s[0][0], s[1][0]);
#pragma unroll
            for (int r = 1; r < 16; ++r) mx = fmaxf(mx, fmaxf(s[0][r], s[1][r]));
            mx = fmaxf(mx, __shfl_xor(mx, 32));
            const float mn = fmaxf(m, mx), alpha = EXP2(m - mn); m = mn;
            float rs = 0.f;
#pragma unroll
            for (int kb = 0; kb < 2; ++kb)
#pragma unroll
                for (int r = 0; r < 16; ++r) { const float e = EXP2(s[kb][r] - mn); s[kb][r] = e; rs += e; }
            l = l * alpha + rs;
            if (!__all(alpha == 1.0f)) {
#pragma unroll
                for (int db = 0; db < DV / 32; ++db) o[db] = o[db] * alpha;
            }
            pv_tile<DV, TROW>(Vt, s, o, r32, hi);
        }
        buf ^= 1;
    }
    __syncthreads();
}


template <int DV, bool LSEL, class TF>
__device__ __forceinline__ void attn_loop_fast(LAS unsigned char* lds, const bf16_t* Kg, int ldk, const bf16_t* VTg, int ldv, unsigned long long tmask,
                                               const bf16x8 (&qf)[4], f32x16 (&o)[DV / 32], f32x4& lsum, const TF& tf) {
    constexpr int ABF = (64 + DV) * TROW * 2;
    const int tid = threadIdx.x, lane = tid & 63, r32 = lane & 31, hi = lane >> 5, srow = tid >> 3, sch = tid & 7;
    if (!tmask) return;
    u32x4 kreg, vreg[DV / 64];
#define AF_LOAD(t) do { kreg = *(const u32x4*)(Kg + (size_t)(64 * (t) + srow) * ldk + sch * 8); _Pragma("unroll") for (int i_ = 0; i_ < DV / 64; ++i_) vreg[i_] = *(const u32x4*)(VTg + (size_t)(srow + 64 * i_) * ldv + 64 * (t) + sch * 8); } while (0)
#define AF_STORE(b) do { LAS bf16_t* Kt_ = (LAS bf16_t*)(lds + (b) * ABF); *(LAS u32x4*)(Kt_ + srow * TROW + sch * 8) = kreg; _Pragma("unroll") for (int i_ = 0; i_ < DV / 64; ++i_) *(LAS u32x4*)(Kt_ + 64 * TROW + (srow + 64 * i_) * TROW + sch * 8) = vreg[i_]; } while (0)
    int tc = __builtin_ctzll(tmask); tmask &= tmask - 1;
    AF_LOAD(tc); AF_STORE(0);
    int tn = -1; if (tmask) { tn = __builtin_ctzll(tmask); tmask &= tmask - 1; AF_LOAD(tn); }
    __syncthreads();
    f32x16 sA[2], sB[2];
    int bc = 0;
    if (tf.mode(tc)) qk_tile<TROW>((const LAS bf16_t*)(lds), qf, sA, r32, hi);
#define AF_STEP(scur, snxt) do { \
        const int bn = (bc == 2) ? 0 : bc + 1; \
        if (tn >= 0) AF_STORE(bn); \
        __syncthreads(); \
        int tnn = -1; if (tmask) { tnn = __builtin_ctzll(tmask); tmask &= tmask - 1; AF_LOAD(tnn); } \
        if (tn >= 0 && tf.mode(tn)) qk_tile<TROW>((const LAS bf16_t*)(lds + bn * ABF), qf, snxt, r32, hi); \
        const int md = tf.mode(tc); \
        if (md) { \
            _Pragma("unroll") for (int kb = 0; kb < 2; ++kb) _Pragma("unroll") for (int r = 0; r < 16; ++r) scur[kb][r] = EXP2(scur[kb][r]); \
            if (md == 2) { const int lim_hi = tf.lim_hi(tc), lim_lo = tf.lim_lo(tc); _Pragma("unroll") for (int kb = 0; kb < 2; ++kb) _Pragma("unroll") for (int r = 0; r < 16; ++r) { const int kc_ = 32 * kb + (r & 3) + 8 * (r >> 2); if (kc_ > lim_hi || kc_ < lim_lo) scur[kb][r] = 0.f; } } \
            bf16x8 pb[4]; \
            if constexpr (LSEL) { const bool sel = tf.lanesel(tc); const float sm = sel ? 1.f : 0.f; const unsigned am = sel ? 0xffffffffu : 0u; { const f32x16 t16_ = scur[0] + scur[1]; const f32x8 t8_ = t16_.lo + t16_.hi; lsum = lsum + (t8_.lo + t8_.hi) * sm; } \
                _Pragma("unroll") for (int j = 0; j < 4; ++j) { const int kb = j >> 1, r0 = 8 * (j & 1); u32x4 w; w.x = cvtpk(scur[kb][r0], scur[kb][r0 + 1]) & am; w.y = cvtpk(scur[kb][r0 + 2], scur[kb][r0 + 3]) & am; w.z = cvtpk(scur[kb][r0 + 4], scur[kb][r0 + 5]) & am; w.w = cvtpk(scur[kb][r0 + 6], scur[kb][r0 + 7]) & am; pb[j] = __builtin_bit_cast(bf16x8, w); } \
            } else { { const f32x16 t16_ = scur[0] + scur[1]; const f32x8 t8_ = t16_.lo + t16_.hi; lsum = lsum + (t8_.lo + t8_.hi); } \
                _Pragma("unroll") for (int j = 0; j < 4; ++j) { const int kb = j >> 1, r0 = 8 * (j & 1); u32x4 w; w.x = cvtpk(scur[kb][r0], scur[kb][r0 + 1]); w.y = cvtpk(scur[kb][r0 + 2], scur[kb][r0 + 3]); w.z = cvtpk(scur[kb][r0 + 4], scur[kb][r0 + 5]); w.w = cvtpk(scur[kb][r0 + 6], scur[kb][r0 + 7]); pb[j] = __builtin_bit_cast(bf16x8, w); } } \
            const LAS bf16_t* Vt_ = (const LAS bf16_t*)(lds + bc * ABF) + 64 * TROW; \
            _Pragma("unroll") for (int db = 0; db < DV / 32; ++db) { bf16x8 vf[4]; \
                _Pragma("unroll") for (int j = 0; j < 4; ++j) vf[j] = *(const LAS bf16x8*)(Vt_ + (32 * db + r32) * TROW + 16 * j + 8 * hi); \
                _Pragma("unroll") for (int j = 0; j < 4; ++j) o[db] = MFMA32(vf[j], pb[j], o[db]); } \
        } \
        tc = tn; tn = tnn; bc = bn; \
    } while (0)
    for (;;) {
        AF_STEP(sA, sB); if (tc < 0) break;
        AF_STEP(sB, sA); if (tc < 0) break;
    }
    __syncthreads();
#undef AF_LOAD
#undef AF_STORE
#undef AF_STEP
}
__device__ __forceinline__ float hsum4(const f32x4& v) { return (v[0] + v[1]) + (v[2] + v[3]); }

struct DiffTF { int qlo, qpos, hi4; __device__ __forceinline__ int mode(int t) const { return 64 * t > qlo + 31 ? 0 : (64 * t + 63 > qlo ? 2 : 1); }
    __device__ __forceinline__ int lim_hi(int t) const { return qpos - 64 * t - hi4; } __device__ __forceinline__ int lim_lo(int t) const { return -(1 << 30); } };
template <bool FAST>
__device__ __forceinline__ void diff_unit(const Params& P, LAS unsigned char* lds, int b, int h, int qb, float lam, bool dry) {
    const int tid = threadIdx.x, lane = tid & 63, wave = tid >> 6, r32 = lane & 31, hi = lane >> 5;
    unsigned char* ws = P.ws;
    const int q0 = qb * 256, qpos = q0 + 32 * wave + r32;
    bf16_t* DQ = (bf16_t*)(ws + WS_DQ); const bf16_t* DK = (const bf16_t*)(ws + WS_DK); const bf16_t* DVT = (const bf16_t*)(ws + WS_DVT);
    bf16_t* qrow = DQ + (size_t)(b * SEQ + qpos) * 1024 + h * 128;
    const unsigned long long tmask = (qb == 15) ? ~0ull : ((1ull << (4 * qb + 4)) - 1ull);
    DiffTF tf; tf.qlo = q0 + 32 * wave; tf.qpos = qpos; tf.hi4 = 4 * hi;
    LAS unsigned* o0p = (LAS unsigned*)(lds + L_O0P) + wave * 32 * 64 + lane;
    f32x16 o0[4];
#pragma unroll
    for (int c = 0; c < 2; ++c) {
        bf16x8 qf[4]; load_q(qrow + 64 * c, hi, qf);
        f32x16 o[4];
#pragma unroll
        for (int db = 0; db < 4; ++db) o[db] = (f32x16){};
        float m = -1e30f, l = 0.f;
        if (FAST) { f32x4 ls = {}; attn_loop_fast<128, false, DiffTF>(lds, DK + (size_t)b * SEQ * 1024 + (h * 2 + c) * 64, 1024, DVT + (size_t)((b * 8 + h) * 128) * SEQ, SEQ, tmask, qf, o, ls, tf); l = hsum4(ls); }
        else attn_loop<128, DiffTF>(lds, DK + (size_t)b * SEQ * 1024 + (h * 2 + c) * 64, 1024, DVT + (size_t)((b * 8 + h) * 128) * SEQ, SEQ, tmask, qf, o, m, l, tf);
        l += __shfl_xor(l, 32);
        const float inv = 1.0f / fmaxf(l, 1e-30f);
        if (c == 0) {
#pragma unroll
            for (int db = 0; db < 4; ++db)
#pragma unroll
                for (int r = 0; r < 8; ++r) o0p[(db * 8 + r) * 64] = cvtpk(o[db][2 * r] * inv, o[db][2 * r + 1] * inv);
        } else {
            const float il = inv * lam;
#pragma unroll
            for (int db = 0; db < 4; ++db)
#pragma unroll
                for (int r = 0; r < 8; ++r) { const unsigned pw = o0p[(db * 8 + r) * 64]; o0[db][2 * r] = __uint_as_float(pw << 16) - o[db][2 * r] * il; o0[db][2 * r + 1] = __uint_as_float(pw & 0xffff0000u) - o[db][2 * r + 1] * il; }
        }
    }
    float ss = 0.f;
#pragma unroll
    for (int db = 0; db < 4; ++db)
#pragma unroll
        for (int r = 0; r < 16; ++r) ss += o0[db][r] * o0[db][r];
    ss += __shfl_xor(ss, 32);
    const float rstd = rsqrtf(ss * (1.f / 128.f) + EPS) * 0.8f;
    const float* sg = P.in[9];
#pragma unroll
    for (int db = 0; db < 4; ++db)
#pragma unroll
        for (int u = 0; u < 4; ++u) { const int d = 32 * db + 8 * u + 4 * hi; const f32x4 g4 = *(const f32x4*)(sg + d);
            u32x2 w; w.x = cvtpk(o0[db][4 * u] * rstd * g4.x, o0[db][4 * u + 1] * rstd * g4.y); w.y = cvtpk(o0[db][4 * u + 2] * rstd * g4.z, o0[db][4 * u + 3] * rstd * g4.w);
            if (!dry) *(u32x2*)(qrow + d) = w; }
}

__device__ __forceinline__ void compress_unit(const Params& P, LAS unsigned char* lds, int which, int pm) {
    unsigned char* ws = P.ws;
    bf16_t* HID = (bf16_t*)(ws + WS_HID) + (size_t)which * 4096 * 256;
    {
        pg8::Gemm g = pg8::make_gemm((const bf16_t*)(ws + (which ? WS_VC : WS_KC)), (const bf16_t*)(ws + WS_W1T) + (size_t)which * 256 * 2048, 4096, 256, 2048);
        g.lda = 4096; g.kstepA = 512; g.a_sh = 2; g.a_lo = (size_t)256 * 4096 * 2; g.a_hi = 128;
        LAS float* pbs = (LAS float*)(lds + 131072);
        if (threadIdx.x < 256) { const float* pp = (const float*)(ws + WS_PB) + which * 16 * 256 + threadIdx.x; float sacc = 0.f;
#pragma unroll
            for (int kc = 0; kc < 16; ++kc) sacc += pp[kc * 256];
            pbs[threadIdx.x] = sacc; }
        __syncthreads();
        OneUnit S{pm, 0}; EpiHid E{HID, pbs};
        pg8::gemm_phase<EpiHid, OneUnit, false, true>((PG8_LAS unsigned char*)lds, g, S, E);
    }
    __threadfence(); __syncthreads(); __threadfence();
    int tid = threadIdx.x; asm volatile("" : "+v"(tid));
    const int lane = tid & 63, wave = tid >> 6, r32 = lane & 31, hi = lane >> 5;
    const bf16_t* W2T = (const bf16_t*)(ws + WS_W2T) + which * 64 * 256;
    const int rowl = 32 * wave + r32; const bf16_t* hrow = HID + (size_t)(pm * 256 + rowl) * 256;
    f32x16 c0 = {}, c1 = {};
#pragma unroll 2
    for (int ks = 0; ks < 16; ++ks) {
        const bf16x8 a0 = *(const bf16x8*)(W2T + r32 * 256 + 16 * ks + 8 * hi), a1 = *(const bf16x8*)(W2T + (32 + r32) * 256 + 16 * ks + 8 * hi), bf = *(const bf16x8*)(hrow + 16 * ks + 8 * hi);
        c0 = MFMA32(a0, bf, c0); c1 = MFMA32(a1, bf, c1);
    }
    const int g = pm >> 2, b = pm & 3, n = rowl;
    if (which == 0) {
        float ss = 0.f;
#pragma unroll
        for (int r = 0; r < 16; ++r) ss += c0[r] * c0[r] + c1[r] * c1[r];
        ss += __shfl_xor(ss, 32);
        const float rstd = (n < 255) ? rsqrtf(ss * (1.f / 64.f) + EPS) : 0.f;
        const float* gk = P.in[11]; const float* CC = (const float*)(ws + WS_CCOS) + n * 32; const float* CS = (const float*)(ws + WS_CSIN) + n * 32;
        bf16_t* kr = (bf16_t*)(ws + WS_KCMP) + (size_t)((b * 4 + g) * 256 + n) * 64;
#pragma unroll
        for (int u = 0; u < 4; ++u) { const int i = 8 * u + 4 * hi; const f32x4 g1 = *(const f32x4*)(gk + i), g2 = *(const f32x4*)(gk + 32 + i), cc = *(const f32x4*)(CC + i), sn = *(const f32x4*)(CS + i);
            float o1[4], o2[4];
#pragma unroll
            for (int j = 0; j < 4; ++j) { const float x1 = c0[4 * u + j] * rstd * g1[j], x2 = c1[4 * u + j] * rstd * g2[j]; o1[j] = x1 * cc[j] - x2 * sn[j]; o2[j] = x2 * cc[j] + x1 * sn[j]; }
            u32x2 w; w.x = cvtpk(o1[0], o1[1]); w.y = cvtpk(o1[2], o1[3]); *(u32x2*)(kr + i) = w; w.x = cvtpk(o2[0], o2[1]); w.y = cvtpk(o2[2], o2[3]); *(u32x2*)(kr + 32 + i) = w; }
    } else {
        bf16_t* vt = (bf16_t*)(ws + WS_VCMPT) + (size_t)((b * 4 + g) * 64) * 256 + perm16(n);
        const float z = (n < 255) ? 1.f : 0.f;
#pragma unroll
        for (int r = 0; r < 16; ++r) { const int d = crow(r, hi); vt[(size_t)d * 256] = f2bf(c0[r] * z); vt[(size_t)(d + 32) * 256] = f2bf(c1[r] * z); }
    }
}

struct SlcTF { unsigned long long mymask, wu; int qpos, hi4; __device__ __forceinline__ int mode(int t) const { return ((wu >> t) & 1ull) ? 2 : 0; }
    __device__ __forceinline__ int lim_hi(int t) const { return ((mymask >> t) & 1ull) ? qpos - 64 * t - hi4 : -(1 << 30); } __device__ __forceinline__ int lim_lo(int t) const { return -(1 << 30); } };
struct SlcTFF { unsigned long long mymask, wu; int qpos, c, hi4; __device__ __forceinline__ int mode(int t) const { return ((wu >> t) & 1ull) ? (t == c ? 2 : 1) : 0; }
    __device__ __forceinline__ bool lanesel(int t) const { return (mymask >> t) & 1ull; }
    __device__ __forceinline__ int lim_hi(int t) const { return qpos - 64 * t - hi4; } __device__ __forceinline__ int lim_lo(int t) const { return -(1 << 30); } };
struct WinTF { int c, qpos, hi4; __device__ __forceinline__ int mode(int t) const { return (t == c || t == c - 8) ? 2 : 1; }
    __device__ __forceinline__ int lim_hi(int t) const { return qpos - 64 * t - hi4; } __device__ __forceinline__ int lim_lo(int t) const { return qpos - 511 - 64 * t - hi4; } };
template <bool FAST>
__device__ __forceinline__ void nsa_unit(const Params& P, LAS unsigned char* lds, int b, int g, int c, bool dry) {
    const int tid = threadIdx.x, lane = tid & 63, wave = tid >> 6, r32 = lane & 31, hi = lane >> 5;
    unsigned char* ws = P.ws;
    const int q0 = 64 * c, tk = r32 >> 2, hg = r32 & 3, tokl = 8 * wave + tk, qpos = q0 + tokl;
    bf16_t* qrow = (bf16_t*)(ws + WS_NQ) + (size_t)(b * SEQ + qpos) * 1024 + (g * 4 + hg) * 64;
    bf16x8 qf[4]; load_q(qrow, hi, qf);
    const float* ngp = (const float*)(ws + WS_NG) + (size_t)(b * SEQ + qpos) * 48 + (g * 4 + hg) * 3;
    const float gate0 = ngp[0], gate1 = ngp[1], gate2 = ngp[2];
    f32x16 yt[2]; yt[0] = (f32x16){}; yt[1] = (f32x16){};
    const int ntl = (4 * c + 2) / 64 + 1;
    LAS bf16_t* CK = (LAS bf16_t*)(lds + L_CK); LAS bf16_t* CV = (LAS bf16_t*)(lds + L_CV);
    LAS float* IMP = (LAS float*)(lds + L_IMP); LAS unsigned long long* SEL = (LAS unsigned long long*)(lds + L_SEL);
    {
        const bf16_t* kc = (const bf16_t*)(ws + WS_KCMP) + (size_t)((b * 4 + g) * 256) * 64; const bf16_t* vc = (const bf16_t*)(ws + WS_VCMPT) + (size_t)((b * 4 + g) * 64) * 256;
        u32x4 kr[4], vr[4]; const int srow = tid >> 3, sch = tid & 7;
#pragma unroll
        for (int it = 0; it < 4; ++it) if (it < ntl) { kr[it] = *(const u32x4*)(kc + (64 * it + srow) * 64 + sch * 8); vr[it] = *(const u32x4*)(vc + srow * 256 + (sch + 8 * it) * 8); }
#pragma unroll
        for (int it = 0; it < 4; ++it) if (it < ntl) { *(LAS u32x4*)(CK + (64 * it + srow) * CKROW + sch * 8) = kr[it]; *(LAS u32x4*)(CV + srow * CVROW + (sch + 8 * it) * 8) = vr[it]; }
    }
    __syncthreads();
    if constexpr (FAST) {
        const int nlim = ((qpos - 31) >> 4) - 4 * hi;
        f32x16 o[2]; o[0] = (f32x16){}; o[1] = (f32x16){};
        float lrow = 0.f, carry = 0.f; float ivq[4][8];
#pragma unroll
        for (int T = 0; T < 4; ++T) {
#pragma unroll
            for (int i = 0; i < 8; ++i) ivq[T][i] = 0.f;
            if (T < ntl) {
                f32x16 s[2]; qk_tile<CKROW>(CK + T * 64 * CKROW, qf, s, r32, hi);
#pragma unroll
                for (int kb = 0; kb < 2; ++kb)
#pragma unroll
                    for (int r = 0; r < 16; ++r) { const int kc_ = 32 * kb + (r & 3) + 8 * (r >> 2); const float e = EXP2(s[kb][r]); s[kb][r] = (kc_ > nlim - 64 * T) ? 0.f : e; }
#pragma unroll
                for (int kb = 0; kb < 2; ++kb)
#pragma unroll
                    for (int u = 0; u < 4; ++u) {
                        const float qs = (s[kb][4 * u] + s[kb][4 * u + 1]) + (s[kb][4 * u + 2] + s[kb][4 * u + 3]);
                        lrow += qs;
                        const float x = __shfl_xor(s[kb][4 * u + 3], 32);
                        ivq[T][kb * 4 + u] = qs + (hi ? x : carry); carry = x;
                    }
                pv_tile<64, CVROW>(CV + 64 * T, s, o, r32, hi);
            }
        }
        lrow += __shfl_xor(lrow, 32);
        const float invl = 1.0f / fmaxf(lrow, 1e-30f);
#pragma unroll
        for (int T = 0; T < 4; ++T)
            if (T < ntl) {
#pragma unroll
                for (int i = 0; i < 8; ++i) { float iv = ivq[T][i] * invl; iv += __shfl_xor(iv, 1); iv += __shfl_xor(iv, 2); if (hg == 0) IMP[tokl * 64 + 16 * T + 2 * i + hi] = iv; }
            }
        const float gs = gate0 * invl;
#pragma unroll
        for (int db = 0; db < 2; ++db) yt[db] = o[db] * gs;
    } else {
        const int nlim = ((qpos - 31) >> 4) - 4 * hi;
        float m = -1e30f, l = 0.f;
        for (int T = 0; T < ntl; ++T) {
            f32x16 s[2]; qk_tile<CKROW>(CK + T * 64 * CKROW, qf, s, r32, hi);
            float mx = -INFINITY;
#pragma unroll
            for (int kb = 0; kb < 2; ++kb)
#pragma unroll
                for (int r = 0; r < 16; ++r) { const int kc_ = 32 * kb + (r & 3) + 8 * (r >> 2); if (kc_ > nlim - 64 * T) s[kb][r] = -INFINITY; mx = fmaxf(mx, s[kb][r]); }
            mx = fmaxf(mx, __shfl_xor(mx, 32));
            const float mn = fmaxf(m, mx), alpha = EXP2(m - mn); m = mn; float rs = 0.f;
#pragma unroll
            for (int kb = 0; kb < 2; ++kb)
#pragma unroll
                for (int r = 0; r < 16; ++r) rs += EXP2(s[kb][r] - mn);
            l = l * alpha + rs;
        }
        l += __shfl_xor(l, 32);
        const float invl = 1.0f / fmaxf(l, 1e-30f);
        f32x16 o[2]; o[0] = (f32x16){}; o[1] = (f32x16){};
        float carry = 0.f;
        for (int T = 0; T < ntl; ++T) {
            f32x16 s[2]; qk_tile<CKROW>(CK + T * 64 * CKROW, qf, s, r32, hi);
#pragma unroll
            for (int kb = 0; kb < 2; ++kb)
#pragma unroll
                for (int r = 0; r < 16; ++r) { const int kc_ = 32 * kb + (r & 3) + 8 * (r >> 2); s[kb][r] = (kc_ > nlim - 64 * T) ? 0.f : EXP2(s[kb][r] - m) * invl; }
#pragma unroll
            for (int kb = 0; kb < 2; ++kb)
#pragma unroll
                for (int u = 0; u < 4; ++u) {
                    const float qs = (s[kb][4 * u] + s[kb][4 * u + 1]) + (s[kb][4 * u + 2] + s[kb][4 * u + 3]);
                    const float x = __shfl_xor(s[kb][4 * u + 3], 32);
                    float iv = qs + (hi ? x : carry); carry = x;
                    iv += __shfl_xor(iv, 1); iv += __shfl_xor(iv, 2);
                    if (hg == 0) IMP[tokl * 64 + 16 * T + 8 * kb + 2 * u + hi] = iv;
                }
            pv_tile<64, CVROW>(CV + 64 * T, s, o, r32, hi);
        }
#pragma unroll
        for (int db = 0; db < 2; ++db) yt[db] = o[db] * gate0;
    }
    __syncthreads();
    LAS float* yst = (LAS float*)(lds + L_CK) + tid;
#pragma unroll
    for (int db = 0; db < 2; ++db)
#pragma unroll
        for (int r = 0; r < 16; ++r) yst[(db * 16 + r) * NTHREADS] = yt[db][r];
    for (int i = 0; i < 8; ++i) {
        const int tl = 8 * wave + i; const int j = lane;
        const bool forced = (j == 0) || (j == c) || (j == c - 1);
        const float v = forced ? 1e4f : IMP[tl * 64 + j];
        const bool okj = (j <= c);
        const unsigned key = okj ? (__float_as_uint(v) + 1u) : 0u;
        unsigned thr = 0u;
        for (int bit = 31; bit >= 0; --bit) { const unsigned cand = thr | (1u << bit); if (__popcll(__ballot(key >= cand)) >= 16) thr = cand; }
        const unsigned long long gtm = __ballot(key > thr), eqm = __ballot(key == thr);
        const int need = 16 - __popcll(gtm);
        const bool selj = (key > thr) || (key == thr && __popcll(eqm & ((1ull << j) - 1ull)) < need);
        const unsigned long long msk = __ballot(selj && okj);
        if (lane == 0) SEL[tl] = msk;
    }
    __syncthreads();
    unsigned long long mymask = SEL[tokl], wu = 0ull;
#pragma unroll
    for (int i = 0; i < 8; ++i) wu |= SEL[8 * wave + i];
    {
        SlcTF tf; tf.mymask = mymask; tf.wu = wu; tf.qpos = qpos; tf.hi4 = 4 * hi;
        const unsigned long long tmask = (c == 63) ? ~0ull : ((1ull << (c + 1)) - 1ull);
        f32x16 o[2]; o[0] = (f32x16){}; o[1] = (f32x16){}; float m = -1e30f, l = 0.f;
        if (FAST) { SlcTFF tff; tff.mymask = mymask; tff.wu = wu; tff.qpos = qpos; tff.c = c; tff.hi4 = 4 * hi; f32x4 ls = {};
            attn_loop_fast<64, true, SlcTFF>(lds, (const bf16_t*)(ws + WS_KSL) + (size_t)b * SEQ * 256 + g * 64, 256, (const bf16_t*)(ws + WS_VSLT) + (size_t)((b * 4 + g) * 64) * SEQ, SEQ, tmask, qf, o, ls, tff); l = hsum4(ls); }
        else attn_loop<64, SlcTF>(lds, (const bf16_t*)(ws + WS_KSL) + (size_t)b * SEQ * 256 + g * 64, 256, (const bf16_t*)(ws + WS_VSLT) + (size_t)((b * 4 + g) * 64) * SEQ, SEQ, tmask, qf, o, m, l, tf);
        l += __shfl_xor(l, 32); const float sc = gate1 / fmaxf(l, 1e-30f);
#pragma unroll
        for (int db = 0; db < 2; ++db)
#pragma unroll
            for (int r = 0; r < 16; ++r) yst[(db * 16 + r) * NTHREADS] += o[db][r] * sc;
    }
    {
        WinTF tf; tf.c = c; tf.qpos = qpos; tf.hi4 = 4 * hi;
        const int tlo = c >= 8 ? c - 8 : 0;
        const unsigned long long hi_m = (c == 63) ? ~0ull : ((1ull << (c + 1)) - 1ull), tmask = hi_m & ~((1ull << tlo) - 1ull);
        f32x16 o[2]; o[0] = (f32x16){}; o[1] = (f32x16){}; float m = -1e30f, l = 0.f;
        if (FAST) { f32x4 ls = {}; attn_loop_fast<64, false, WinTF>(lds, (const bf16_t*)(ws + WS_KWN) + (size_t)b * SEQ * 256 + g * 64, 256, (const bf16_t*)(ws + WS_VWNT) + (size_t)((b * 4 + g) * 64) * SEQ, SEQ, tmask, qf, o, ls, tf); l = hsum4(ls); }
        else attn_loop<64, WinTF>(lds, (const bf16_t*)(ws + WS_KWN) + (size_t)b * SEQ * 256 + g * 64, 256, (const bf16_t*)(ws + WS_VWNT) + (size_t)((b * 4 + g) * 64) * SEQ, SEQ, tmask, qf, o, m, l, tf);
        l += __shfl_xor(l, 32); const float sc = gate2 / fmaxf(l, 1e-30f);
#pragma unroll
        for (int db = 0; db < 2; ++db)
#pragma unroll
            for (int r = 0; r < 16; ++r) yt[db][r] = yst[(db * 16 + r) * NTHREADS] + o[db][r] * sc;
    }
#pragma unroll
    for (int db = 0; db < 2; ++db)
#pragma unroll
        for (int u = 0; u < 4; ++u) { const int d = 32 * db + 8 * u + 4 * hi; u32x2 w; w.x = cvtpk(yt[db][4 * u], yt[db][4 * u + 1]); w.y = cvtpk(yt[db][4 * u + 2], yt[db][4 * u + 3]); if (!dry) *(u32x2*)(qrow + d) = w; }
}

#define XB_TMO      128
#define XB_XCNT(j)  (256  + 64 * (j))
#define XB_XSUB(j)  (1280 + 64 * (j))
#define XB_XGEN(j)  (2304 + 64 * (j))
#define XB_TOP      3328
#define XB_TOPGEN   3392
#define XCD_BAR_WORDS 3456
#define XB_SPIN_CAP (1u << 18)

__device__ __forceinline__ unsigned xb_ld(unsigned* p)              { return __hip_atomic_load(p, __ATOMIC_RELAXED, __HIP_MEMORY_SCOPE_AGENT); }
__device__ __forceinline__ unsigned xb_add(unsigned* p, unsigned v) { return __hip_atomic_fetch_add(p, v, __ATOMIC_RELAXED, __HIP_MEMORY_SCOPE_AGENT); }
__device__ __forceinline__ unsigned xb_xcc_id() { return (unsigned)__builtin_amdgcn_s_getreg((3 << 11) | 20) & 0xFu; }
#define XB_SPIN(cond, bar) do { unsigned _sp = 0; while (cond) { __builtin_amdgcn_s_sleep(1); \
    if ((++_sp & 255u) == 0u) { if (xb_ld(&(bar)[XB_TMO])) break; if (_sp > XB_SPIN_CAP) { atomicAdd(&(bar)[XB_TMO], 1u); break; } } } } while (0)

struct XcdBarrier {
    unsigned* bar; unsigned x;
    volatile LAS unsigned* st;
};

__device__ __forceinline__ XcdBarrier xcd_barrier_post(unsigned* bar, volatile LAS unsigned* st) {
    XcdBarrier b; b.bar = bar; b.x = xb_xcc_id(); b.st = st;
    if (threadIdx.x == 0) (void)xb_add(&bar[XB_XCNT(b.x)], 1u);
    return b;
}
__device__ __forceinline__ void xcd_barrier_complete(unsigned* bar, unsigned x, unsigned& nloc, unsigned& nx) {
    const unsigned G = gridDim.x * gridDim.y * gridDim.z;
    unsigned sum, cnt, mine, sp = 0u;
    for (;;) {
        sum = 0u; cnt = 0u; mine = 0u;
#pragma unroll
        for (unsigned j = 0; j < 16; ++j) { const unsigned c = xb_ld(&bar[XB_XCNT(j)]); sum += c; cnt += (c > 0u) ? 1u : 0u; mine = (j == x) ? c : mine; }
        if (sum == G) break;
        __builtin_amdgcn_s_sleep(1);
        if ((++sp & 255u) == 0u) { if (xb_ld(&bar[XB_TMO])) break; if (sp > XB_SPIN_CAP) { atomicAdd(&bar[XB_TMO], 1u); break; } }
    }
    nloc = mine > 0u ? mine : 1u; nx = cnt > 0u ? cnt : 1u;
}

__device__ __forceinline__ void xcd_barrier(const XcdBarrier& b) {
    asm volatile("s_waitcnt vmcnt(0)" ::: "memory");
    __syncthreads();
    if (threadIdx.x == 0) {
        unsigned* bar = b.bar;
        __builtin_amdgcn_s_waitcnt(0);
        unsigned nloc = b.st[0], nx = b.st[1];
        if (nloc == 0u) { xcd_barrier_complete(bar, b.x, nloc, nx); b.st[0] = nloc; b.st[1] = nx; }
        const unsigned old = xb_add(&bar[XB_XSUB(b.x)], 1u);
        const unsigned gen = old / nloc;
        if (old + 1u == (gen + 1u) * nloc) {
            __builtin_amdgcn_fence(__ATOMIC_RELEASE, "agent");
            asm volatile("s_waitcnt vmcnt(0)" ::: "memory");
            const unsigned og = xb_add(&bar[XB_TOP], 1u);
            const unsigned tg = og / nx;
            if (og + 1u == (tg + 1u) * nx) xb_add(&bar[XB_TOPGEN], 1u);
            else XB_SPIN(xb_ld(&bar[XB_TOPGEN]) == tg, bar);
            __builtin_amdgcn_fence(__ATOMIC_ACQUIRE, "agent");
            xb_add(&bar[XB_XGEN(b.x)], 1u);
            asm volatile("s_waitcnt vmcnt(0)" ::: "memory");
        } else {
            XB_SPIN(xb_ld(&bar[XB_XGEN(b.x)]) == gen, bar);
            __builtin_amdgcn_fence(__ATOMIC_ACQUIRE, "agent");
            asm volatile("s_waitcnt vmcnt(0)" ::: "memory");
        }
    }
    __syncthreads();
}

__device__ __forceinline__ int next_item(unsigned* counter, LAS int* slot) {
    __syncthreads();
    if (threadIdx.x == 0) *slot = (int)atomicAdd(counter, 1u);
    __syncthreads();
    return *slot;
}

__global__ void __launch_bounds__(NTHREADS) fwd_megakernel(Params P) {
    extern __shared__ __attribute__((aligned(16))) unsigned char lds_raw[];
    LAS unsigned char* lds = (LAS unsigned char*)lds_raw;
    cg::grid_group grid = cg::this_grid();
    const int G = gridDim.x, bx = blockIdx.x;
    const int vb = (G % 8 == 0) ? (bx % 8) * (G / 8) + bx / 8 : bx;
    unsigned char* ws = P.ws;
    unsigned* ctl = (unsigned*)(ws + WS_CTL);
    LAS int* slot = (LAS int*)(lds + L_SLOT);
    if (threadIdx.x < 8) ((LAS unsigned*)(lds + L_SLOT))[threadIdx.x] = 0u;
    __syncthreads();
    XcdBarrier xbar = xcd_barrier_post(ctl + CW_BAR, (volatile LAS unsigned*)(lds + L_SLOT + 16));
    const int lo = P.ph_lo, hi = P.ph_hi;
#ifdef PROBE_PHASE
    const unsigned long long t_start = __builtin_amdgcn_s_memrealtime(); unsigned long long t_probe = 0ull;
#define STAMP(k) do { if ((k) == PROBE_PHASE) t_probe = __builtin_amdgcn_s_memrealtime(); } while (0)
#else
#define STAMP(k) do { } while (0)
#endif
#ifndef PHMASK
#define PHMASK 0xff
#endif
#define IN(k) (((PHMASK >> (k)) & 1) && lo <= (k) && (k) < hi)
#define SEAM(k) do { if (IN(k) && IN((k) + 1)) { if (P.ph_lo < 0) grid.sync(); else xcd_barrier(xbar); } STAMP(k); } while (0)

    if (IN(0)) p0_prologue(P, lds, vb, G);
    SEAM(0);
    if (IN(1)) {
        pg8::Gemm g = pg8::make_gemm((const bf16_t*)(ws + WS_XN), (const bf16_t*)(ws + WS_WIN), MTOK, NPAD, 1024);
        pg8::StaticOrder S; S.init(MTOK, NPAD, G, bx);
        EpiProj E; E.ws = ws; E.gq = P.in[3]; E.gk = P.in[4]; E.gnq = P.in[10]; E.gnk = P.in[11]; E.mgp = (unsigned char*)P.out;
        pg8::gemm_phase<EpiProj, pg8::StaticOrder, true, true>((PG8_LAS unsigned char*)lds, g, S, E);
        for (;;) {
            const int it = next_item(ctl + 320, slot);
            if (it >= 704) break;
            late_weight_item(P, lds, it);
        }
    }
    SEAM(1);
    if (IN(2)) {
        float lam;
        bool fast;
        { const int lane = threadIdx.x & 63; const float a = wave_sum(P.in[5][lane] * P.in[6][lane]), b2 = wave_sum(P.in[7][lane] * P.in[8][lane]); lam = expf(a) - expf(b2) + 0.2f;
          float gq = fabsf(P.in[3][lane]), gk = fabsf(P.in[4][lane]);
#pragma unroll
          for (int o_ = 1; o_ < 64; o_ <<= 1) { gq = fmaxf(gq, __shfl_xor(gq, o_)); gk = fmaxf(gk, __shfl_xor(gk, o_)); }
          fast = (QSCALE * 64.f * gq * gk <= 40.f); }
        for (;;) {
            const int it = next_item(ctl + 128, slot);
            if (it >= 32) break;
            compress_unit(P, lds, it >> 4, it & 15);
        }
        for (;;) {
            const int it = next_item(ctl + 0, slot);
            if (it >= 512) break;
            const int qb = 15 - (it >> 5), bh = it & 31;
            if (fast) diff_unit<true>(P, lds, bh >> 3, bh & 7, qb, lam, P.dup != 0); else diff_unit<false>(P, lds, bh >> 3, bh & 7, qb, lam, P.dup != 0);
        }
    }
    SEAM(2);
    if (IN(3)) {
        bool fast;
        { const int lane = threadIdx.x & 63; float gq = fabsf(P.in[10][lane]), gk = fmaxf(fabsf(P.in[11][lane]), fmaxf(fabsf(P.in[11][64 + lane]), fabsf(P.in[11][128 + lane])));
#pragma unroll
          for (int o_ = 1; o_ < 64; o_ <<= 1) { gq = fmaxf(gq, __shfl_xor(gq, o_)); gk = fmaxf(gk, __shfl_xor(gk, o_)); }
          fast = (QSCALE * 64.f * gq * gk <= 40.f); }
        for (;;) {
            const int it = next_item(ctl + 64, slot);
            if (it >= 1024) break;
            const int c = 63 - (it >> 4), bg = it & 15;
            if (fast) nsa_unit<true>(P, lds, bg >> 2, bg & 3, c, P.dup != 0); else nsa_unit<false>(P, lds, bg >> 2, bg & 3, c, P.dup != 0);
        }
    }
    SEAM(3);
    if (IN(4)) {
        static_assert(WS_WPN == WS_WPD + (size_t)1024 * 1024 * 2 && WS_NQ > WS_DQ, "the two branch GEMMs are addressed as one virtual GEMM");
        TwoSched S; S.S.init(MTOK, 1024, G, bx);
        pg8::Gemm g = pg8::make_gemm((const bf16_t*)(ws + WS_DQ), (const bf16_t*)(ws + WS_WPD), MTOK, 2048, 1024);
        g.a_sh = 6; g.a_lo = (size_t)256 * 1024 * 2; g.a_hi = WS_NQ - WS_DQ;
        EpiMerge2 E{(const bf16_t*)P.out, (bf16_t*)(ws + WS_MIXED)};
        pg8::gemm_phase<EpiMerge2, TwoSched, true, true>((PG8_LAS unsigned char*)lds, g, S, E);
    }
    SEAM(4);
    if (IN(5)) {
        pg8::Gemm g = pg8::make_gemm((const bf16_t*)(ws + WS_MIXED), (const bf16_t*)(ws + WS_WOUT), MTOK, 1024, 1024);
        pg8::StaticOrder S; S.init(MTOK, 1024, G, bx);
        EpiRes1 E{P.in[0], P.out, (bf16_t*)(ws + WS_XB1), (float*)(ws + WS_PART)};
        pg8::gemm_phase<EpiRes1, pg8::StaticOrder, true, true>((PG8_LAS unsigned char*)lds, g, S, E);
    }
    SEAM(5);
    if (IN(6)) {
        pg8::Gemm g = pg8::make_gemm((const bf16_t*)(ws + WS_XB1), (const bf16_t*)(ws + WS_WUP), MTOK, DFF, 1024);
        pg8::StaticOrder S; S.init(MTOK, DFF, G, bx);
        EpiUp E{(const float*)(ws + WS_PART), (bf16_t*)(ws + WS_HB)};
        pg8::gemm_phase<EpiUp, pg8::StaticOrder, true, true>((PG8_LAS unsigned char*)lds, g, S, E);
    }
    SEAM(6);
    if (IN(7)) {
        pg8::Gemm g = pg8::make_gemm((const bf16_t*)(ws + WS_HB), (const bf16_t*)(ws + WS_WDN), MTOK, 1024, DFF);
        pg8::StaticOrder S; S.init(MTOK, 1024, G, bx);
        EpiRes2 E{P.out, 1.f, (const bf16_t*)(ws + WS_XB1)};
        pg8::gemm_phase<EpiRes2, pg8::StaticOrder, true, true>((PG8_LAS unsigned char*)lds, g, S, E);
    }
#ifdef PROBE_PHASE
    grid.sync();
    if (blockIdx.x == 0 && threadIdx.x == 0) P.out[0] = 1000.0f + (float)(t_probe - t_start) * 0.01f;
#endif
#undef IN
#undef SEAM
}

#ifndef PROBE_DUP
#define PROBE_DUP -1
#endif
extern "C" void kernel_launch(void* const* d_in, const int* in_sizes, int n_in, void* d_out, int out_size, void* d_ws, size_t ws_size, hipStream_t stream) {
    static int grid = 0;
    if (grid == 0) {
        if (n_in != 24 || out_size != MTOK * DM || ws_size < WS_END) { fprintf(stderr, "kernel_launch: unexpected shapes (n_in %d out %d ws %zu)\n", n_in, out_size, ws_size); grid = -1; return; }
        int dev = 0, cus = 0, per_cu = 0;
        hipGetDevice(&dev); hipDeviceGetAttribute(&cus, hipDeviceAttributeMultiprocessorCount, dev);
        if (hipFuncSetAttribute((const void*)fwd_megakernel, hipFuncAttributeMaxDynamicSharedMemorySize, LDS_BYTES) != hipSuccess) { fprintf(stderr, "kernel_launch: hipFuncSetAttribute failed\n"); grid = -1; return; }
        if (hipOccupancyMaxActiveBlocksPerMultiprocessor(&per_cu, (const void*)fwd_megakernel, NTHREADS, LDS_BYTES) != hipSuccess || per_cu < 1) { fprintf(stderr, "kernel_launch: occupancy query says %d\n", per_cu); per_cu = 1; }
        (void)hipGetLastError();
        grid = cus * 1;
        fprintf(stderr, "kernel_launch: grid %d (cus %d, per_cu %d)\n", grid, cus, per_cu);
    }
    if (grid < 0) return;
    hipMemsetAsync((char*)d_ws + WS_CTL, 0, CTL_BYTES, stream);
    Params p{};
    for (int i = 0; i < 24; ++i) p.in[i] = (const float*)d_in[i];
    p.out = (float*)d_out; p.ws = (unsigned char*)d_ws;
    for (int i = 0; i < 32; ++i) p.invfreq[i] = (double)powf(10000.0f, -(float)i / 32.0f);
    p.pad = 0;
    int plan[3][3] = {{0, 8, 0}, {0, 0, 0}, {0, 0, 0}}; int nl = 1;
    if (PROBE_DUP >= 0) { const int k = PROBE_DUP; const bool inplace = (k == 2 || k == 3 || k == 7); plan[0][0] = 0; plan[0][1] = k + (inplace ? 0 : 1); plan[0][2] = 0; plan[1][0] = k; plan[1][1] = k + 1; plan[1][2] = inplace ? 1 : 0; plan[2][0] = k + (inplace ? 0 : 1); plan[2][1] = 8; plan[2][2] = 0; nl = 3; }
    for (int li = 0; li < nl; ++li) {
        if (plan[li][0] >= plan[li][1]) continue;
        if (li > 0) hipMemsetAsync((char*)d_ws + WS_CTL, 0, CTL_BYTES, stream);
        p.ph_lo = plan[li][0]; p.ph_hi = plan[li][1]; p.dup = plan[li][2];
        void* args[] = {&p};
        hipError_t e = hipLaunchCooperativeKernel((const void*)fwd_megakernel, dim3(grid), dim3(NTHREADS), args, LDS_BYTES, stream);
        if (e != hipSuccess) fprintf(stderr, "kernel_launch: cooperative launch failed: %s (grid %d)\n", hipGetErrorString(e), grid);
    }
}
```
